# Optimizing an MI355X kernel written in HIP

```python
import math
import jax, jax.numpy as jnp
from jax import lax
import numpy as np

D_MODEL = 2048
BATCH = 1
SEQ = 16384
DEPTH = 2
DEC_BATCH = 32
DEC_SEQ = 64
PAST_LEN = 2048

CHUNK = 64
MIX_WIDTH = D_MODEL
SSD_HEAD_DIM = 64
SSD_WIDTH = MIX_WIDTH // 2
SSD_HEADS = SSD_WIDTH // SSD_HEAD_DIM
SSD_GROUPS = 2
SSD_STATE = 128
SSD_CONV = 4
SSD_BLOCK = CHUNK
SSD_CONV_DIM = SSD_WIDTH + 2 * SSD_GROUPS * SSD_STATE
DIFF_HD = 64
DIFF_VD = 2 * DIFF_HD
DIFF_WIDTH = MIX_WIDTH // 4
DIFF_HEADS = DIFF_WIDTH // DIFF_VD
ATTN_QBLOCK = 128
GLA_DK = 64
GLA_DV = 128
GLA_WIDTH = MIX_WIDTH // 4
GLA_HEADS = GLA_WIDTH // GLA_DV
GLA_GATE_RANK = 16
GLA_TAU = 16.0
GLA_BLOCK = 16
D_FF = 4 * D_MODEL
EPS = 1e-6

IN_SPLITS = (SSD_WIDTH, SSD_CONV_DIM, SSD_HEADS,
             DIFF_HEADS * 2 * DIFF_HD, DIFF_HEADS * 2 * DIFF_HD, DIFF_WIDTH,
             GLA_HEADS * GLA_DK, GLA_HEADS * GLA_DK, GLA_WIDTH, GLA_GATE_RANK, GLA_WIDTH)
IN_COLS = sum(IN_SPLITS)

kernel_name = 'hymba_ssd_diffattn_gla_stream_step'


def _rms(x):
    xf = x.astype(jnp.float32)
    return xf * lax.rsqrt(jnp.mean(xf * xf, axis=-1, keepdims=True) + EPS)


def _pad_time(a, pad):
    if pad == 0:
        return a
    widths = [(0, 0)] * a.ndim
    widths[1] = (0, pad)
    return jnp.pad(a, widths)


def _carry_chunks(h0, decay, states):
    def step(h, inp):
        d, s = inp
        return d * h + s, h
    h_last, h_in = lax.scan(step, h0, (jnp.moveaxis(decay, 1, 0), jnp.moveaxis(states, 1, 0)))
    return jnp.moveaxis(h_in, 0, 1), h_last


def _ssd_scan(x, dt, a, bm, cm, h0):
    bsz, L = x.shape[:2]
    hg = SSD_HEADS // SSD_GROUPS
    q = SSD_BLOCK
    pad = (-L) % q
    x, dt, bm, cm = (_pad_time(t, pad) for t in (x, dt, bm, cm))
    nc = (L + pad) // q
    x = x.reshape(bsz, nc, q, SSD_GROUPS, hg, SSD_HEAD_DIM)
    dt = dt.reshape(bsz, nc, q, SSD_GROUPS, hg)
    bm = bm.reshape(bsz, nc, q, SSD_GROUPS, SSD_STATE)
    cm = cm.reshape(bsz, nc, q, SSD_GROUPS, SSD_STATE)
    cs = jnp.cumsum(dt * a.reshape(SSD_GROUPS, hg), axis=2)
    xdt = x * dt[..., None]
    causal = jnp.tril(jnp.ones((q, q), bool))[:, :, None, None]
    seg = cs[:, :, :, None] - cs[:, :, None]
    lmat = jnp.exp(jnp.where(causal, seg, -jnp.inf))
    cb = jnp.einsum('bctgn,bcsgn->bctsg', cm, bm)
    y_diag = jnp.einsum('bctsgh,bcsghp->bctghp', cb[..., None] * lmat, xdt)
    xdt_end = xdt * jnp.exp(cs[:, :, -1:] - cs)[..., None]
    states = jnp.einsum('bcsgn,bcsghp->bcghpn', bm, xdt_end)
    h0g = h0.reshape(bsz, SSD_GROUPS, hg, SSD_HEAD_DIM, SSD_STATE)
    h_in, h_last = _carry_chunks(h0g, jnp.exp(cs[:, :, -1])[..., None, None], states)
    y_off = jnp.einsum('bctgn,bcghpn->bctghp', cm, h_in) * jnp.exp(cs)[..., None]
    y = (y_diag + y_off).reshape(bsz, nc * q, SSD_HEADS, SSD_HEAD_DIM)[:, :L]
    return y, h_last.reshape(bsz, SSD_HEADS, SSD_HEAD_DIM, SSD_STATE)


def _gla_scan(q, k, v, log_a, s0):
    bsz, L = q.shape[:2]
    c = GLA_BLOCK
    pad = (-L) % c
    q, k, v, log_a = (_pad_time(t, pad) for t in (q, k, v, log_a))
    nc = (L + pad) // c
    q = q.reshape(bsz, nc, c, GLA_HEADS, GLA_DK)
    k = k.reshape(bsz, nc, c, GLA_HEADS, GLA_DK)
    log_a = log_a.reshape(bsz, nc, c, GLA_HEADS, GLA_DK)
    v = v.reshape(bsz, nc, c, GLA_HEADS, GLA_DV)
    b = jnp.cumsum(log_a, axis=2)
    qt = q * jnp.exp(b)
    kt = k * jnp.exp(-b)
    causal = jnp.tril(jnp.ones((c, c), bool))
    att = jnp.where(causal, jnp.einsum('bcthk,bcshk->bchts', qt, kt), 0.0)
    o = jnp.einsum('bchts,bcshv->bcthv', att, v)
    states = jnp.einsum('bcshk,bcshv->bchkv', k * jnp.exp(b[:, :, -1:] - b), v)
    s_in, s_last = _carry_chunks(s0, jnp.exp(b[:, :, -1])[..., None], states)
    o = o + jnp.einsum('bcthk,bchkv->bcthv', qt, s_in)
    return o.reshape(bsz, nc * c, GLA_HEADS, GLA_DV)[:, :L], s_last


def _causal_conv(u, prev, w, bias):
    L = u.shape[1]
    full = jnp.concatenate([prev.astype(u.dtype), u], axis=1)
    y = bias + full[:, 0:L] * w[0]
    for j in range(1, SSD_CONV):
        y = y + full[:, j:j + L] * w[j]
    return jax.nn.silu(y), full[:, -(SSD_CONV - 1):]


def _diff_core(q, k, v, q_pos, k_pos, lam, slopes):
    s = jnp.einsum('bqhcd,bkhcd->bhcqk', q, k) * (DIFF_HD ** -0.5)
    dist = jnp.abs(q_pos[:, None] - k_pos[None, :]).astype(jnp.float32)
    s = s - slopes[None, :, None, None, None] * dist
    allowed = (k_pos[None, :] // CHUNK) <= (q_pos[:, None] // CHUNK)
    p = jax.nn.softmax(jnp.where(allowed, s, -jnp.inf), axis=-1)
    a = p[:, :, 0] - lam * p[:, :, 1]
    return jnp.einsum('bhqk,bkhv->bqhv', a, v)


def _diff_attention(q, k, v, q_pos, k_pos, lam, slopes):
    bsz, lq = q.shape[:2]
    if lq <= ATTN_QBLOCK:
        return _diff_core(q, k, v, q_pos, k_pos, lam, slopes)
    nb = lq // ATTN_QBLOCK
    qb = q.reshape(bsz, nb, ATTN_QBLOCK, DIFF_HEADS, 2, DIFF_HD).swapaxes(0, 1)
    pb = q_pos.reshape(nb, ATTN_QBLOCK)
    out = lax.map(lambda t: _diff_core(t[0], k, v, t[1], k_pos, lam, slopes), (qb, pb))
    return out.swapaxes(0, 1).reshape(bsz, lq, DIFF_HEADS, DIFF_VD)


def _layer(x, q_pos, k_past, v_past, conv_prev, h_prev, s_prev, layer_idx,
           norm1_g, w_in, ssd_conv_w, ssd_conv_b, ssd_dt_bias, ssd_a_log, ssd_d, ssd_norm_g,
           diff_qn_g, diff_kn_g, diff_lambda, diff_out_g, gla_wa2, gla_ba, gla_norm_g,
           w_out, norm2_g, w_mlp1, w_mlp2):
    f32 = jnp.float32
    bsz, L, _ = x.shape
    dty = x.dtype
    h = (_rms(x) * norm1_g.astype(f32)).astype(dty)
    proj = h @ w_in
    z, xbc, dt_raw, dq, dk, dv, gq, gk, gv, ga, gg = jnp.split(
        proj, np.cumsum(IN_SPLITS)[:-1].tolist(), axis=-1)

    xbc, conv_new = _causal_conv(xbc, conv_prev, ssd_conv_w, ssd_conv_b)
    xs, bm, cm = jnp.split(xbc, [SSD_WIDTH, SSD_WIDTH + SSD_GROUPS * SSD_STATE], axis=-1)
    xs_h = xs.astype(f32).reshape(bsz, L, SSD_HEADS, SSD_HEAD_DIM)
    dt = jax.nn.softplus(dt_raw.astype(f32) + ssd_dt_bias.astype(f32))
    a = -jnp.exp(ssd_a_log.astype(f32))
    y, h_new = _ssd_scan(xs_h, dt, a,
                         bm.astype(f32).reshape(bsz, L, SSD_GROUPS, SSD_STATE),
                         cm.astype(f32).reshape(bsz, L, SSD_GROUPS, SSD_STATE),
                         h_prev.astype(f32))
    y = y + ssd_d.astype(f32)[:, None] * xs_h
    y = y.reshape(bsz, L, SSD_WIDTH) * jax.nn.silu(z.astype(f32))
    y = _rms(y.reshape(bsz, L, SSD_GROUPS, SSD_WIDTH // SSD_GROUPS)).reshape(bsz, L, SSD_WIDTH)
    y = y * ssd_norm_g.astype(f32)

    q = _rms(dq.reshape(bsz, L, DIFF_HEADS, 2, DIFF_HD)) * diff_qn_g.astype(f32)
    k = _rms(dk.reshape(bsz, L, DIFF_HEADS, 2, DIFF_HD)) * diff_kn_g.astype(f32)
    k_rows = k.astype(dty).reshape(bsz, L, DIFF_HEADS, 2 * DIFF_HD)
    v_rows = dv.reshape(bsz, L, DIFF_HEADS, DIFF_VD)
    if k_past is None:
        k_all, v_all, k_pos = k_rows, v_rows, q_pos
    else:
        k_all = jnp.concatenate([k_past.astype(dty), k_rows], axis=1)
        v_all = jnp.concatenate([v_past.astype(dty), v_rows], axis=1)
        k_pos = jnp.arange(k_past.shape[1] + L)
    lam_init = 0.8 - 0.6 * math.exp(-0.3 * layer_idx)
    lq1, lk1, lq2, lk2 = diff_lambda.astype(f32)
    lam = jnp.exp(jnp.sum(lq1 * lk1)) - jnp.exp(jnp.sum(lq2 * lk2)) + lam_init
    slopes = jnp.exp2(-8.0 * jnp.arange(1, DIFF_HEADS + 1, dtype=f32) / DIFF_HEADS)
    o = _diff_attention(q, k_all.astype(f32).reshape(bsz, -1, DIFF_HEADS, 2, DIFF_HD),
                        v_all.astype(f32), q_pos, k_pos, lam, slopes)
    o = (_rms(o) * diff_out_g.astype(f32) * (1.0 - lam_init)).reshape(bsz, L, DIFF_WIDTH)

    gq_h = gq.astype(f32).reshape(bsz, L, GLA_HEADS, GLA_DK) * (GLA_DK ** -0.5)
    gk_h = gk.astype(f32).reshape(bsz, L, GLA_HEADS, GLA_DK)
    gv_h = gv.astype(f32).reshape(bsz, L, GLA_HEADS, GLA_DV)
    log_a = jax.nn.log_sigmoid((ga @ gla_wa2).astype(f32) + gla_ba.astype(f32)) / GLA_TAU
    o_g, s_new = _gla_scan(gq_h, gk_h, gv_h, log_a.reshape(bsz, L, GLA_HEADS, GLA_DK),
                           s_prev.astype(f32))
    o_g = (_rms(o_g) * gla_norm_g.astype(f32)).reshape(bsz, L, GLA_WIDTH) * jax.nn.silu(gg.astype(f32))

    x = x + jnp.concatenate([y, o, o_g], axis=-1).astype(dty) @ w_out
    h2 = (_rms(x) * norm2_g.astype(f32)).astype(dty)
    x = x + jnp.square(jax.nn.relu(h2 @ w_mlp1)) @ w_mlp2
    return x, k_rows, v_rows, conv_new, h_new.astype(dty), s_new.astype(dty)


def setup_inputs(seed: int = 0) -> dict:
    key = jax.random.key(seed)
    ks = jax.random.split(key, 32)
    f32 = jnp.float32
    nrm = lambda k, shape, s: jax.random.normal(k, shape, f32) * s
    dt0 = jnp.exp(jax.random.uniform(ks[9], (DEPTH, SSD_HEADS), f32) * (math.log(0.1) - math.log(1e-3)) + math.log(1e-3))
    return {
        'x_prompt': nrm(ks[0], (BATCH, SEQ, D_MODEL), 1.0),
        'x_sample': nrm(ks[1], (DEC_BATCH, DEC_SEQ, D_MODEL), 1.0),
        'cache_diff_k': nrm(ks[2], (DEPTH, DEC_BATCH, PAST_LEN, DIFF_HEADS, 2 * DIFF_HD), 1.0),
        'cache_diff_v': nrm(ks[3], (DEPTH, DEC_BATCH, PAST_LEN, DIFF_HEADS, DIFF_VD), 1.0),
        'state_ssd_conv': nrm(ks[4], (DEPTH, DEC_BATCH, SSD_CONV - 1, SSD_CONV_DIM), 1.0),
        'state_ssd': nrm(ks[5], (DEPTH, DEC_BATCH, SSD_HEADS, SSD_HEAD_DIM, SSD_STATE), 0.1),
        'state_gla': nrm(ks[6], (DEPTH, DEC_BATCH, GLA_HEADS, GLA_DK, GLA_DV), 0.5),
        'norm1_g': 1.0 + nrm(ks[7], (DEPTH, D_MODEL), 0.02),
        'w_in': nrm(ks[8], (DEPTH, D_MODEL, IN_COLS), D_MODEL ** -0.5),
        'ssd_conv_w': nrm(ks[10], (DEPTH, SSD_CONV, SSD_CONV_DIM), SSD_CONV ** -0.5),
        'ssd_conv_b': nrm(ks[11], (DEPTH, SSD_CONV_DIM), 0.01),
        'ssd_dt_bias': dt0 + jnp.log(-jnp.expm1(-dt0)),
        'ssd_a_log': jnp.log(jax.random.uniform(ks[12], (DEPTH, SSD_HEADS), f32, 1.0, 16.0)),
        'ssd_d': 1.0 + nrm(ks[13], (DEPTH, SSD_HEADS), 0.1),
        'ssd_norm_g': 1.0 + nrm(ks[14], (DEPTH, SSD_WIDTH), 0.02),
        'diff_qn_g': 1.0 + nrm(ks[15], (DEPTH, DIFF_HD), 0.02),
        'diff_kn_g': 1.0 + nrm(ks[16], (DEPTH, DIFF_HD), 0.02),
        'diff_lambda': nrm(ks[17], (DEPTH, 4, DIFF_HD), 0.1),
        'diff_out_g': 1.0 + nrm(ks[18], (DEPTH, DIFF_VD), 0.02),
        'gla_wa2': nrm(ks[19], (DEPTH, GLA_GATE_RANK, GLA_HEADS * GLA_DK), GLA_GATE_RANK ** -0.5),
        'gla_ba': nrm(ks[20], (DEPTH, GLA_HEADS * GLA_DK), 0.01),
        'gla_norm_g': 1.0 + nrm(ks[21], (DEPTH, GLA_DV), 0.02),
        'w_out': nrm(ks[22], (DEPTH, MIX_WIDTH, D_MODEL), MIX_WIDTH ** -0.5),
        'norm2_g': 1.0 + nrm(ks[23], (DEPTH, D_MODEL), 0.02),
        'w_mlp1': nrm(ks[24], (DEPTH, D_MODEL, D_FF), D_MODEL ** -0.5),
        'w_mlp2': nrm(ks[25], (DEPTH, D_FF, D_MODEL), D_FF ** -0.5),
    }


def reference(x_prompt, x_sample, cache_diff_k, cache_diff_v, state_ssd_conv, state_ssd, state_gla,
              norm1_g, w_in, ssd_conv_w, ssd_conv_b, ssd_dt_bias, ssd_a_log, ssd_d, ssd_norm_g,
              diff_qn_g, diff_kn_g, diff_lambda, diff_out_g, gla_wa2, gla_ba, gla_norm_g,
              w_out, norm2_g, w_mlp1, w_mlp2):
    def params(l):
        return (norm1_g[l], w_in[l], ssd_conv_w[l], ssd_conv_b[l], ssd_dt_bias[l], ssd_a_log[l],
                ssd_d[l], ssd_norm_g[l], diff_qn_g[l], diff_kn_g[l], diff_lambda[l], diff_out_g[l],
                gla_wa2[l], gla_ba[l], gla_norm_g[l], w_out[l], norm2_g[l], w_mlp1[l], w_mlp2[l])

    bp, lp = x_prompt.shape[:2]
    dty = x_prompt.dtype
    pos_p = jnp.arange(lp)
    conv0 = jnp.zeros((bp, SSD_CONV - 1, SSD_CONV_DIM), dty)
    h0 = jnp.zeros((bp, SSD_HEADS, SSD_HEAD_DIM, SSD_STATE), dty)
    s0 = jnp.zeros((bp, GLA_HEADS, GLA_DK, GLA_DV), dty)
    y_p = x_prompt
    outs_p = []
    for l in range(DEPTH):
        y_p, *st = _layer(y_p, pos_p, None, None, conv0, h0, s0, l, *params(l))
        outs_p.append(st)
    kp, vp, cp, hp, sp = (jnp.stack(f) for f in zip(*outs_p))

    ls = x_sample.shape[1]
    pos_s = cache_diff_k.shape[2] + jnp.arange(ls)
    y_s = x_sample
    outs_s = []
    for l in range(DEPTH):
        y_s, *st = _layer(y_s, pos_s, cache_diff_k[l], cache_diff_v[l], state_ssd_conv[l],
                          state_ssd[l], state_gla[l], l, *params(l))
        outs_s.append(st)
    k_s, v_s, c_s, h_s, s_s = (jnp.stack(f) for f in zip(*outs_s))

    return (y_p, y_s, kp, vp, cp, hp, sp, k_s, v_s, c_s, h_s, s_s)
```

```cpp
#include <hip/hip_runtime.h>
#include <cstdio>
#include <cstdint>
namespace pg8 {
#define PG8_LAS __attribute__((address_space(3)))
typedef unsigned short bf16_t;
typedef short bf16x8 __attribute__((ext_vector_type(8)));
typedef float f32x4 __attribute__((ext_vector_type(4)));
typedef unsigned u32x4 __attribute__((ext_vector_type(4)));
constexpr int BM = 256, BK = 64, HALF = 128, HTB = HALF * BK * 2  , STAGE_BYTES = 8 * HTB, NXCD = 8, WGM = 8;

__host__ __device__ __forceinline__ int lds_byte(int r, int c) { const int st = (r >> 4) * 2 + (c >> 5), rr = r & 15, cc = c & 31, ob = rr * 64 + cc * 2; return st * 1024 + (ob ^ (((ob >> 9) & 1) << 5)); }
__host__ __device__ __forceinline__ void stage_rc(int b, int& R, int& C) { const int st = b / 1024, sb = b % 1024, swz = sb ^ (((sb >> 9) & 1) << 5); R = (st >> 1) * 16 + swz / 64; C = (st & 1) * 32 + (swz % 64) / 2; }
__host__ __device__ __forceinline__ int perm32(int rho) { const int n = rho >> 4, i = rho & 15; return 8 * (i >> 2) + 4 * n + (i & 3); }

struct Unit { int pm, pn; };
struct Gemm { const bf16_t* A; const bf16_t* Bt; int M, N, K; };

struct StaticOrder {
    int nM, nN, nwg, G, c;
    __host__ __device__ void init(int M, int N, int G_, int c_) { nM = M / BM; nN = N / BM; nwg = nM * nN; G = G_; c = c_; }
    __host__ __device__ bool next(int i, Unit& u) const {
        const long L = (long)i * G + c; if (L >= nwg) return false;
        int wgid = (int)L; { const int q = nwg / NXCD, r = nwg % NXCD, xcd = wgid % NXCD, off = wgid / NXCD; wgid = (xcd < r ? xcd * (q + 1) : r * (q + 1) + (xcd - r) * q) + off; }
        const int nig = WGM * nN, gid = wgid / nig, fm = gid * WGM, gsz = (nM - fm) < WGM ? (nM - fm) : WGM;
        u.pm = fm + ((wgid % nig) % gsz); u.pn = (wgid % nig) / gsz; return true;
    }
    __device__ __forceinline__ void a_ready(const Unit&) const {}
    __device__ __forceinline__ void done(const Unit&) const {}
};

__device__ __forceinline__ unsigned cvt_pk_bf16(float lo, float hi) { unsigned r; asm volatile("v_cvt_pk_bf16_f32 %0, %1, %2" : "=v"(r) : "v"(lo), "v"(hi)); return r; }
typedef float f32x2 __attribute__((ext_vector_type(2)));
template <class Epi, class Sched, bool ALIGN_EPI = false, bool SP2 = false>
__device__ __forceinline__ void gemm_phase(PG8_LAS unsigned char* lds, const Gemm g, const Sched& S, const Epi& E) {
    const int tid = threadIdx.x, wid = __builtin_amdgcn_readfirstlane(tid >> 6), lane = tid & 63, wr = wid >> 2, wc = wid & 3, fr = lane & 15, fq = lane >> 4;
    const int K = g.K, nt = K / BK;
    unsigned voffA[2], voffB[2];
#pragma unroll
    for (int i = 0; i < 2; ++i) { int R, C; stage_rc(tid * 16 + i * 8192, R, C); const int Rb = Epi::PERM ? ((R & ~31) + perm32(R & 31)) : R;
        voffA[i] = (unsigned)(R * K + C) * 2u; voffB[i] = (unsigned)(Rb * K + C) * 2u; }
    const size_t kstep = (size_t)(BK * 2);
    const size_t hstep = (size_t)HALF * K * 2;
    const size_t tstep = 2 * hstep;
    const unsigned ldsw = (unsigned)wid * 1024u;
    const int aoff = lds_byte(wr * 64 + fr, fq * 8), boff = lds_byte(wc * 32 + fr, fq * 8);
#define PG8_SA(b, h) (((b) * 2 + (h)) * HTB)
#define PG8_SB(b, h) ((4 + (b) * 2 + (h)) * HTB)
#define PG8_STAGE(bufoff, gbase, voff) do { _Pragma("unroll") for (int _i = 0; _i < 2; ++_i) \
        __builtin_amdgcn_global_load_lds((const unsigned*)((const char*)(gbase) + (voff)[_i]), (PG8_LAS unsigned*)(lds + (bufoff) + ldsw + _i * 8192), 16, 0, 0); } while (0)
#define PG8_LDA(dst, b, h) do { _Pragma("unroll") for (int m = 0; m < 4; ++m) _Pragma("unroll") for (int k = 0; k < 2; ++k) dst[m][k] = *(const PG8_LAS bf16x8*)(lds + PG8_SA(b, h) + aoff + m * 2048 + k * 1024); } while (0)
#define PG8_LDB(dst, b, h) do { _Pragma("unroll") for (int n = 0; n < 2; ++n) _Pragma("unroll") for (int k = 0; k < 2; ++k) dst[n][k] = *(const PG8_LAS bf16x8*)(lds + PG8_SB(b, h) + boff + n * 2048 + k * 1024); } while (0)
#define PG8_MMA(ai, bj, At, Bt) do { __builtin_amdgcn_s_setprio(1); _Pragma("unroll") for (int m = 0; m < 4; ++m) _Pragma("unroll") for (int n = 0; n < 2; ++n) _Pragma("unroll") for (int k = 0; k < 2; ++k) \
        acc[ai][bj][m][n] = __builtin_amdgcn_mfma_f32_16x16x32_bf16(Bt[n][k], At[m][k], acc[ai][bj][m][n], 0, 0, 0); __builtin_amdgcn_s_setprio(0); } while (0)
#define PG8_WAIT_V(n) asm volatile("s_waitcnt vmcnt(" #n ")" ::: "memory")
#define PG8_WAIT_L(n) asm volatile("s_waitcnt lgkmcnt(" #n ")" ::: "memory")
#define PG8_BAR __builtin_amdgcn_s_barrier()
#define PG8_SCHED __builtin_amdgcn_sched_barrier(0)
    Unit cur, nxt; int ui = 0;
    if (!S.next(0, cur)) return;
    f32x4 acc[2][2][4][2];
#pragma unroll
    for (int a = 0; a < 2; ++a)
#pragma unroll
        for (int b = 0; b < 2; ++b)
#pragma unroll
            for (int m = 0; m < 4; ++m)
#pragma unroll
                for (int n = 0; n < 2; ++n) acc[a][b][m][n] = (f32x4){0.f, 0.f, 0.f, 0.f};
    bf16x8 At[4][2], B0[2][2], B1[2][2];
    const char* cA = (const char*)g.A + (size_t)cur.pm * tstep; const char* cB = (const char*)g.Bt + (size_t)cur.pn * tstep;
    S.a_ready(cur);
    if constexpr (SP2) {
        PG8_STAGE(PG8_SB(0, 0), cB, voffB); PG8_STAGE(PG8_SB(0, 1), cB + hstep, voffB); PG8_STAGE(PG8_SA(0, 0), cA, voffA); PG8_STAGE(PG8_SA(0, 1), cA + hstep, voffA);
        if (wr == 1) PG8_BAR;
        PG8_WAIT_V(2); PG8_BAR;
        PG8_STAGE(PG8_SB(1, 0), cB + kstep, voffB); PG8_STAGE(PG8_SA(1, 0), cA + kstep, voffA); PG8_STAGE(PG8_SB(1, 1), cB + hstep + kstep, voffB);
        PG8_WAIT_V(6); PG8_BAR;
    } else {
        PG8_STAGE(PG8_SB(0, 0), cB, voffB); PG8_STAGE(PG8_SA(0, 0), cA, voffA); PG8_STAGE(PG8_SB(0, 1), cB + hstep, voffB); PG8_STAGE(PG8_SA(0, 1), cA + hstep, voffA);
        if (wr == 1) PG8_BAR;
        PG8_WAIT_V(4); PG8_BAR;
        PG8_STAGE(PG8_SB(1, 0), cB + kstep, voffB); PG8_STAGE(PG8_SA(1, 0), cA + kstep, voffA); PG8_STAGE(PG8_SB(1, 1), cB + hstep + kstep, voffB);
        PG8_WAIT_V(6); PG8_BAR;
    }
    for (;;) {
        const bool has_next = S.next(ui + 1, nxt);
        const char* nA = has_next ? (const char*)g.A + (size_t)nxt.pm * tstep : cA; const char* nB = has_next ? (const char*)g.Bt + (size_t)nxt.pn * tstep : cB;
        for (int t = 0; t < nt; t += 2) {
            const bool last = (t == nt - 2);
            const char* a1 = cA + (size_t)(t + 1) * kstep;
            const char* a2 = last ? nA : cA + (size_t)(t + 2) * kstep; const char* b2 = last ? nB : cB + (size_t)(t + 2) * kstep;
            const char* a3 = a2 + kstep; const char* b3 = b2 + kstep;
            if (last && has_next) S.a_ready(nxt);
            if constexpr (SP2) {
            PG8_LDB(B0, 0, 0); PG8_LDB(B1, 0, 1); PG8_SCHED; PG8_LDA(At, 0, 0); PG8_STAGE(PG8_SA(1, 1), a1 + hstep, voffA);
            PG8_WAIT_V(8); PG8_WAIT_L(0); PG8_BAR; PG8_MMA(0, 0, At, B0); PG8_MMA(0, 1, At, B1); PG8_BAR; PG8_SCHED;
            PG8_LDA(At, 0, 1); PG8_STAGE(PG8_SB(0, 0), b2, voffB); PG8_STAGE(PG8_SB(0, 1), b2 + hstep, voffB); PG8_STAGE(PG8_SA(0, 0), a2, voffA);
            PG8_WAIT_V(8); PG8_WAIT_L(0); PG8_BAR; PG8_MMA(1, 0, At, B0); PG8_MMA(1, 1, At, B1); PG8_BAR; PG8_SCHED;
            PG8_LDB(B0, 1, 0); PG8_LDB(B1, 1, 1); PG8_SCHED; PG8_LDA(At, 1, 0); PG8_STAGE(PG8_SA(0, 1), a2 + hstep, voffA);
            PG8_WAIT_V(8); PG8_WAIT_L(0); PG8_BAR; PG8_MMA(0, 0, At, B0); PG8_MMA(0, 1, At, B1); PG8_BAR; PG8_SCHED;
            PG8_LDA(At, 1, 1); PG8_STAGE(PG8_SB(1, 0), b3, voffB); PG8_STAGE(PG8_SB(1, 1), b3 + hstep, voffB); PG8_STAGE(PG8_SA(1, 0), a3, voffA);
            PG8_WAIT_V(8); PG8_WAIT_L(0); PG8_BAR; PG8_MMA(1, 0, At, B0); PG8_MMA(1, 1, At, B1); PG8_BAR; PG8_SCHED;
            } else {
            PG8_LDB(B0, 0, 0); PG8_SCHED; PG8_LDA(At, 0, 0); PG8_STAGE(PG8_SA(1, 1), a1 + hstep, voffA);
            PG8_WAIT_L(8); PG8_BAR; PG8_WAIT_L(0); PG8_MMA(0, 0, At, B0); PG8_BAR; PG8_SCHED;
            PG8_LDB(B1, 0, 1); PG8_STAGE(PG8_SB(0, 0), b2, voffB);
            PG8_BAR; PG8_WAIT_L(0); PG8_MMA(0, 1, At, B1); PG8_BAR;
            PG8_LDA(At, 0, 1); PG8_STAGE(PG8_SA(0, 0), a2, voffA);
            PG8_BAR; PG8_WAIT_L(0); PG8_MMA(1, 0, At, B0); PG8_BAR; PG8_SCHED;
            PG8_STAGE(PG8_SB(0, 1), b2 + hstep, voffB);
            PG8_WAIT_V(6); PG8_BAR; PG8_MMA(1, 1, At, B1); PG8_BAR;
            PG8_LDB(B0, 1, 0); PG8_SCHED; PG8_LDA(At, 1, 0); PG8_STAGE(PG8_SA(0, 1), a2 + hstep, voffA);
            PG8_WAIT_L(8); PG8_BAR; PG8_WAIT_L(0); PG8_MMA(0, 0, At, B0); PG8_BAR; PG8_SCHED;
            PG8_LDB(B1, 1, 1); PG8_STAGE(PG8_SB(1, 0), b3, voffB);
            PG8_BAR; PG8_WAIT_L(0); PG8_MMA(0, 1, At, B1); PG8_BAR;
            PG8_LDA(At, 1, 1); PG8_STAGE(PG8_SA(1, 0), a3, voffA);
            PG8_BAR; PG8_WAIT_L(0); PG8_MMA(1, 0, At, B0); PG8_BAR; PG8_SCHED;
            PG8_STAGE(PG8_SB(1, 1), b3 + hstep, voffB);
            PG8_WAIT_V(6); PG8_BAR; PG8_MMA(1, 1, At, B1); PG8_BAR;
            }
        }
        if constexpr (ALIGN_EPI) { if (wr == 0) PG8_BAR; }
        if constexpr (!Epi::AFTER_DRAIN) { E(acc, cur, wr, wc, fr, fq); S.done(cur); }
        if (!has_next) break;
#pragma unroll
        for (int a = 0; a < 2; ++a)
#pragma unroll
            for (int b = 0; b < 2; ++b)
#pragma unroll
                for (int m = 0; m < 4; ++m)
#pragma unroll
                    for (int n = 0; n < 2; ++n) acc[a][b][m][n] = (f32x4){0.f, 0.f, 0.f, 0.f};
        cur = nxt; cA = nA; cB = nB; ++ui;
        if constexpr (ALIGN_EPI) { if (wr == 1) PG8_BAR; }
    }
    PG8_WAIT_V(0);
    if constexpr (!ALIGN_EPI) { if (wr == 0) PG8_BAR; }
    PG8_BAR;
    if constexpr (Epi::AFTER_DRAIN) { E.fused(acc, cur, wr, wc, fr, fq, lds, wid, lane); S.done(cur); }
#undef PG8_SA
#undef PG8_SB
#undef PG8_STAGE
#undef PG8_LDA
#undef PG8_LDB
#undef PG8_MMA
#undef PG8_WAIT_V
#undef PG8_WAIT_L
#undef PG8_BAR
#undef PG8_SCHED
}
}
constexpr int DM = 2048, SEQ = 16384, DEPTH = 2, DB = 32, DS = 64, PAST = 2048;
constexpr int NROW = SEQ + DB * DS;
constexpr int SSD_H = 16, SSD_P = 64, SSD_N = 128, CONV_DIM = 1536;
constexpr int NPJ = 5632, NPAD = 5888, DFF = 8192, IN_COLS = 5664;
constexpr float EPS = 1e-6f;
constexpr int C_Z = 0, C_XBC = 1024, C_DQ = 2560, C_DK = 3072, C_DV = 3584, C_GQ = 4096, C_GK = 4352, C_GV = 4608, C_GG = 5120;
constexpr size_t O_Y = 0, O_KP = 37748736, O_VP = 54525952, O_CP = 71303168, O_HP = 71312384, O_SP = 71574528, O_KS = 71640064, O_VS = 73737216,
                 O_CS = 75834368, O_HS = 76129280, O_SS = 84517888, O_END = 86615040;
constexpr size_t MiB = 1u << 20;
constexpr size_t WS_CTL = 0, WS_WIN = 1 * MiB, WS_WOUT = 47 * MiB, WS_W1 = 63 * MiB, WS_W2 = 127 * MiB, WS_H = 191 * MiB, WS_MIX = 263 * MiB,
                 WS_PROJ = 335 * MiB, WS_XC = 533 * MiB, WS_HID = 335 * MiB, WS_YSSD = 641 * MiB, WS_OGLA = 713 * MiB, WS_OATT = 749 * MiB,
                 WS_QN = 785 * MiB, WS_KN = 803 * MiB, WS_LOGA = 821 * MiB, WS_DTGA = 839 * MiB, WS_DT = 842 * MiB, WS_END = 844 * MiB;
typedef unsigned short bf16;
typedef float f32x4 __attribute__((ext_vector_type(4)));
typedef unsigned u32x4 __attribute__((ext_vector_type(4)));
typedef unsigned u32x2 __attribute__((ext_vector_type(2)));
__device__ __forceinline__ unsigned f2bf(float f) { unsigned u = __builtin_bit_cast(unsigned, f); return (u + 0x7fffu + ((u >> 16) & 1u)) >> 16; }
__device__ __forceinline__ unsigned pk2(float lo, float hi) { return f2bf(lo) | (f2bf(hi) << 16); }
__device__ __forceinline__ float bf2f(bf16 b) { return __builtin_bit_cast(float, (unsigned)b << 16); }
__device__ __forceinline__ float silu_f(float x) { return x / (1.f + __expf(-x)); }
__device__ __forceinline__ float softplus_f(float x) { return x > 20.f ? x : log1pf(expf(x)); }
__device__ __forceinline__ float logsigmoid_f(float x) { return fminf(x, 0.f) - log1pf(expf(-fabsf(x))); }

namespace pg8 {
struct EpiInProj {
    static constexpr bool PERM = true, AFTER_DRAIN = false;
    bf16_t* P; float* T;
    __device__ __forceinline__ void operator()(const f32x4 (&acc)[2][2][4][2], const Unit& u, int wr, int wc, int fr, int fq) const {
        const int row0 = u.pm * BM + wr * 64 + fr;
        if (u.pn < 22) {
            const int col0 = u.pn * BM + wc * 32 + 8 * fq;
#pragma unroll
            for (int ai = 0; ai < 2; ++ai)
#pragma unroll
                for (int m = 0; m < 4; ++m) { bf16_t* rowp = P + (size_t)(row0 + ai * HALF + m * 16) * NPJ + col0;
#pragma unroll
                    for (int bj = 0; bj < 2; ++bj) { const f32x4 v0 = acc[ai][bj][m][0], v1 = acc[ai][bj][m][1];
                        u32x4 w; w.x = cvt_pk_bf16(v0[0], v0[1]); w.y = cvt_pk_bf16(v0[2], v0[3]); w.z = cvt_pk_bf16(v1[0], v1[1]); w.w = cvt_pk_bf16(v1[2], v1[3]);
                        *(u32x4*)(rowp + bj * HALF) = w; } }
        } else if (wc == 0) {
#pragma unroll
            for (int ai = 0; ai < 2; ++ai)
#pragma unroll
                for (int m = 0; m < 4; ++m) { float* rp = T + (size_t)(row0 + ai * HALF + m * 16) * 32 + 8 * fq;
                    *(f32x4*)(rp) = acc[ai][0][m][0]; *(f32x4*)(rp + 4) = acc[ai][0][m][1]; }
        }
    }
};
struct EpiResid {
    static constexpr bool PERM = false, AFTER_DRAIN = false;
    const float* xa; const float* xb; float* out;
    __device__ __forceinline__ void operator()(const f32x4 (&acc)[2][2][4][2], const Unit& u, int wr, int wc, int fr, int fq) const {
        const int col0 = u.pn * BM + wc * 32 + 4 * fq;
#pragma unroll
        for (int ai = 0; ai < 2; ++ai)
#pragma unroll
            for (int m = 0; m < 4; ++m) { const int r = u.pm * BM + ai * HALF + wr * 64 + m * 16 + fr;
                const float* b = (r < SEQ ? xa + (size_t)r * DM : xb + (size_t)(r - SEQ) * DM) + col0; float* o = out + (size_t)r * DM + col0;
#pragma unroll
                for (int bj = 0; bj < 2; ++bj)
#pragma unroll
                    for (int n = 0; n < 2; ++n) *(f32x4*)(o + bj * HALF + n * 16) = *(const f32x4*)(b + bj * HALF + n * 16) + acc[ai][bj][m][n]; }
    }
};
struct EpiRelu2 {
    static constexpr bool PERM = true, AFTER_DRAIN = false;
    bf16_t* O; long ldc;
    __device__ __forceinline__ void operator()(const f32x4 (&acc)[2][2][4][2], const Unit& u, int wr, int wc, int fr, int fq) const {
        const int row0 = u.pm * BM + wr * 64 + fr, col0 = u.pn * BM + wc * 32 + 8 * fq;
#pragma unroll
        for (int ai = 0; ai < 2; ++ai)
#pragma unroll
            for (int m = 0; m < 4; ++m) { bf16_t* rowp = O + (size_t)(row0 + ai * HALF + m * 16) * ldc + col0;
#pragma unroll
                for (int bj = 0; bj < 2; ++bj) { f32x4 v0 = acc[ai][bj][m][0], v1 = acc[ai][bj][m][1];
#pragma unroll
                    for (int j = 0; j < 4; ++j) { const float a = fmaxf(v0[j], 0.f), b = fmaxf(v1[j], 0.f); v0[j] = a * a; v1[j] = b * b; }
                    u32x4 w; w.x = cvt_pk_bf16(v0[0], v0[1]); w.y = cvt_pk_bf16(v0[2], v0[3]); w.z = cvt_pk_bf16(v1[0], v1[1]); w.w = cvt_pk_bf16(v1[2], v1[3]);
                    *(u32x4*)(rowp + bj * HALF) = w; } }
    }
};
}
struct GemmArgs { const bf16* A; const bf16* Bt; int M, N, K, pad; };
template <class Epi> __global__ void __launch_bounds__(512, 2) gemm_kernel(GemmArgs ga, Epi E) {
    extern __shared__ __attribute__((aligned(16))) unsigned char lds[];
    pg8::Gemm g{ga.A, ga.Bt, ga.M, ga.N, ga.K};
    pg8::StaticOrder S; S.init(ga.M, ga.N, (int)gridDim.x, (int)blockIdx.x);
    pg8::gemm_phase<Epi, pg8::StaticOrder, true, true>((PG8_LAS unsigned char*)lds, g, S, E);
}
__device__ __forceinline__ int win_orig_col(int n) {
    if (n < 2560) return n;
    if (n < 5120) return n + 16;
    if (n < 5632) return n + 32;
    if (n < 5648) return 2560 + (n - 5632);
    if (n < 5664) return 5136 + (n - 5648);
    return -1;
}
__global__ void __launch_bounds__(256) transpose_w_kernel(const float* __restrict__ W, int K, int N, bf16* __restrict__ WT, int Nout, int mode) {
    __shared__ float scr_all[4][64 * 33];
    const int lane = threadIdx.x & 63, wave = threadIdx.x >> 6; float* scr = scr_all[wave];
    const int nblk = Nout / 32, nitems = (K / 64) * nblk;
    for (int item = blockIdx.x * 4 + wave; item < nitems; item += gridDim.x * 4) {
        const int kb = item / nblk, nb = item % nblk, k0 = 64 * kb, n0 = 32 * nb;
        const int ncol = n0 + (lane & 31); const int oc = mode ? win_orig_col(ncol) : ncol;
#pragma unroll 8
        for (int i = 0; i < 32; ++i) { const int kk = 2 * i + (lane >> 5); scr[kk * 33 + (lane & 31)] = oc >= 0 ? W[(size_t)(k0 + kk) * N + oc] : 0.f; }
        __builtin_amdgcn_s_waitcnt(0xC07F); __builtin_amdgcn_wave_barrier();
        const int c = lane & 7;
#pragma unroll
        for (int j = 0; j < 4; ++j) { const int n = (lane >> 3) + 8 * j; const float* s = scr + (8 * c) * 33 + n;
            u32x4 o; o.x = pk2(s[0 * 33], s[1 * 33]); o.y = pk2(s[2 * 33], s[3 * 33]); o.z = pk2(s[4 * 33], s[5 * 33]); o.w = pk2(s[6 * 33], s[7 * 33]);
            *(u32x4*)(WT + (size_t)(n0 + n) * K + k0 + 8 * c) = o; }
        __builtin_amdgcn_s_waitcnt(0xC07F); __builtin_amdgcn_wave_barrier();
    }
}
__global__ void scalars_kernel(const float* __restrict__ diff_lambda, float* ctlf) {
    const int l = threadIdx.x; if (l >= DEPTH) return;
    const float* p = diff_lambda + l * 256; float s1 = 0.f, s2 = 0.f;
    for (int i = 0; i < 64; ++i) { s1 += p[i] * p[64 + i]; s2 += p[128 + i] * p[192 + i]; }
    ctlf[l] = expf(s1) - expf(s2) + (0.8f - 0.6f * expf(-0.3f * (float)l));
}
__device__ __forceinline__ float wave_sum(float v) {
#pragma unroll
    for (int o = 1; o < 64; o <<= 1) v += __shfl_xor(v, o);
    return v;
}
__global__ void __launch_bounds__(256) rmsnorm_kernel(const float* __restrict__ xa, const float* __restrict__ xb, const float* __restrict__ g, bf16* __restrict__ H) {
    const int lane = threadIdx.x & 63, row = blockIdx.x * 4 + (threadIdx.x >> 6);
    const float* x = row < SEQ ? xa + (size_t)row * DM : xb + (size_t)(row - SEQ) * DM;
    f32x4 v[8]; float s = 0.f;
#pragma unroll
    for (int j = 0; j < 8; ++j) { v[j] = ((const f32x4*)x)[lane + 64 * j]; s += (v[j].x * v[j].x + v[j].y * v[j].y) + (v[j].z * v[j].z + v[j].w * v[j].w); }
    const float r = 1.0f / sqrtf(wave_sum(s) * (1.f / DM) + EPS);
#pragma unroll
    for (int j = 0; j < 8; ++j) { const f32x4 gv = ((const f32x4*)g)[lane + 64 * j]; u32x2 o; o.x = pk2(v[j].x * r * gv.x, v[j].y * r * gv.y); o.y = pk2(v[j].z * r * gv.z, v[j].w * r * gv.w);
        ((u32x2*)(H + (size_t)row * DM))[lane + 64 * j] = o; }
}
struct PrepArgs { const bf16* proj; const float* dtga; const float* conv_state; const float* conv_w; const float* conv_b; const float* dt_bias; const float* wa2; const float* ba;
                  const float* qn_g; const float* kn_g; float* xc; float* dt; float* loga; bf16* qn; bf16* kn; float* out; int layer, pad; };
__global__ void __launch_bounds__(256) prep_kernel(PrepArgs a) {
    const int row = blockIdx.x, tid = threadIdx.x, l = a.layer;
    const bool isS = row >= SEQ; const int b = isS ? (row - SEQ) >> 6 : 0, t = isS ? (row - SEQ) & 63 : row, L = isS ? DS : SEQ;
    const bf16* pr = a.proj + (size_t)row * NPJ;
    for (int c = tid; c < CONV_DIM; c += 256) {
        float acc = a.conv_b[l * CONV_DIM + c]; float ucur = 0.f;
#pragma unroll
        for (int j = 0; j < 4; ++j) { const int tt = t - 3 + j; float u;
            if (tt >= 0) u = bf2f(a.proj[(size_t)(row - 3 + j) * NPJ + C_XBC + c]);
            else if (isS) u = a.conv_state[((size_t)(l * DB + b) * 3 + (3 + tt)) * CONV_DIM + c];
            else u = 0.f;
            acc += u * a.conv_w[(l * 4 + j) * CONV_DIM + c]; if (j == 3) ucur = u; }
        a.xc[(size_t)row * CONV_DIM + c] = silu_f(acc);
        if (t >= L - 3) { const int idx = t - (L - 3);
            if (isS) a.out[O_CS + ((size_t)(l * DB + b) * 3 + idx) * CONV_DIM + c] = ucur; else a.out[O_CP + (size_t)(l * 3 + idx) * CONV_DIM + c] = ucur; }
    }
    if (tid < 16) a.dt[(size_t)row * 16 + tid] = softplus_f(a.dtga[(size_t)row * 32 + tid] + a.dt_bias[l * 16 + tid]);
    { float x = a.ba[l * 256 + tid];
#pragma unroll
      for (int r = 0; r < 16; ++r) x += a.dtga[(size_t)row * 32 + 16 + r] * a.wa2[(size_t)(l * 16 + r) * 256 + tid];
      a.loga[(size_t)row * 256 + tid] = logsigmoid_f(x) * (1.f / 16.f); }
    { const int i0 = 2 * tid, d = i0 & 63;
      const float q0 = bf2f(pr[C_DQ + i0]), q1 = bf2f(pr[C_DQ + i0 + 1]), k0 = bf2f(pr[C_DK + i0]), k1 = bf2f(pr[C_DK + i0 + 1]);
      float sq = q0 * q0 + q1 * q1, sk = k0 * k0 + k1 * k1;
#pragma unroll
      for (int o = 1; o < 32; o <<= 1) { sq += __shfl_xor(sq, o); sk += __shfl_xor(sk, o); }
      const float rq = 1.0f / sqrtf(sq * (1.f / 64.f) + EPS), rk = 1.0f / sqrtf(sk * (1.f / 64.f) + EPS);
      const float qa = q0 * rq * a.qn_g[l * 64 + d], qb = q1 * rq * a.qn_g[l * 64 + d + 1], ka = k0 * rk * a.kn_g[l * 64 + d], kb = k1 * rk * a.kn_g[l * 64 + d + 1];
      *(unsigned*)(a.qn + (size_t)row * 512 + i0) = pk2(qa, qb); *(unsigned*)(a.kn + (size_t)row * 512 + i0) = pk2(ka, kb);
      const size_t ko = isS ? O_KS + ((size_t)(l * DB + b) * DS + t) * 512 + i0 : O_KP + ((size_t)l * SEQ + t) * 512 + i0;
      const size_t vo = isS ? O_VS + ((size_t)(l * DB + b) * DS + t) * 512 + i0 : O_VP + ((size_t)l * SEQ + t) * 512 + i0;
      a.out[ko] = ka; a.out[ko + 1] = kb; a.out[vo] = bf2f(pr[C_DV + i0]); a.out[vo + 1] = bf2f(pr[C_DV + i0 + 1]); }
}
struct SsdArgs { const float* xc; const float* dt; const float* state; const float* a_log; const float* dpar; float* yssd; float* out; int layer, pad; };
__global__ void __launch_bounds__(256) ssd_naive_kernel(SsdArgs a) {
    const int tid = threadIdx.x, ln = tid & 31, l = a.layer; int bid = blockIdx.x, b = -1, base = 0, L = SEQ;
    if (bid >= 128) { bid -= 128; b = bid / 128; bid %= 128; base = SEQ + b * DS; L = DS; }
    const int h = bid >> 3, p = (bid & 7) * 8 + (tid >> 5), g = h >> 3;
    const float A = -expf(a.a_log[l * 16 + h]), D = a.dpar[l * 16 + h];
    float hs[4];
#pragma unroll
    for (int j = 0; j < 4; ++j) hs[j] = b >= 0 ? a.state[(((size_t)(l * DB + b) * 16 + h) * 64 + p) * 128 + ln + 32 * j] : 0.f;
#pragma unroll 4
    for (int t = 0; t < L; ++t) { const size_t row = base + t; const float* xr = a.xc + row * CONV_DIM;
        const float dtv = a.dt[row * 16 + h], xv = xr[h * 64 + p], da = expf(dtv * A), dx = dtv * xv; float y = 0.f;
#pragma unroll
        for (int j = 0; j < 4; ++j) { hs[j] = da * hs[j] + dx * xr[1024 + g * 128 + ln + 32 * j]; y += xr[1280 + g * 128 + ln + 32 * j] * hs[j]; }
#pragma unroll
        for (int o = 1; o < 32; o <<= 1) y += __shfl_xor(y, o);
        if (ln == 0) a.yssd[row * 1024 + h * 64 + p] = y + D * xv; }
#pragma unroll
    for (int j = 0; j < 4; ++j) { const size_t o = b >= 0 ? O_HS + (((size_t)(l * DB + b) * 16 + h) * 64 + p) * 128 + ln + 32 * j : O_HP + (((size_t)l * 16 + h) * 64 + p) * 128 + ln + 32 * j; a.out[o] = hs[j]; }
}
struct GlaArgs { const bf16* proj; const float* loga; const float* state; float* ogla; float* out; int layer, pad; };
__global__ void __launch_bounds__(256) gla_naive_kernel(GlaArgs a) {
    const int tid = threadIdx.x, ln = tid & 31, l = a.layer; int bid = blockIdx.x, b = -1, base = 0, L = SEQ;
    if (bid >= 64) { bid -= 64; b = bid / 64; bid %= 64; base = SEQ + b * DS; L = DS; }
    const int h = bid >> 4, v = (bid & 15) * 8 + (tid >> 5);
    float S[2];
#pragma unroll
    for (int j = 0; j < 2; ++j) S[j] = b >= 0 ? a.state[(((size_t)(l * DB + b) * 4 + h) * 64 + ln + 32 * j) * 128 + v] : 0.f;
#pragma unroll 4
    for (int t = 0; t < L; ++t) { const size_t row = base + t; const bf16* pr = a.proj + row * NPJ; const float vv = bf2f(pr[C_GV + h * 128 + v]); float o = 0.f;
#pragma unroll
        for (int j = 0; j < 2; ++j) { const int k = ln + 32 * j; const float al = expf(a.loga[row * 256 + h * 64 + k]);
            S[j] = al * S[j] + bf2f(pr[C_GK + h * 64 + k]) * vv; o += bf2f(pr[C_GQ + h * 64 + k]) * 0.125f * S[j]; }
#pragma unroll
        for (int o2 = 1; o2 < 32; o2 <<= 1) o += __shfl_xor(o, o2);
        if (ln == 0) a.ogla[row * 512 + h * 128 + v] = o; }
#pragma unroll
    for (int j = 0; j < 2; ++j) { const int k = ln + 32 * j; const size_t o = b >= 0 ? O_SS + (((size_t)(l * DB + b) * 4 + h) * 64 + k) * 128 + v : O_SP + (((size_t)l * 4 + h) * 64 + k) * 128 + v; a.out[o] = S[j]; }
}
struct AttArgs { const bf16* qn; const bf16* kn; const bf16* proj; const float* ck; const float* cv; const float* ctlf; float* oatt; int layer, pad; };
__global__ void __launch_bounds__(256) attn_naive_kernel(AttArgs a) {
    const int tid = threadIdx.x, sl = tid & 3, qi = tid >> 2, l = a.layer, h = blockIdx.x & 3; int c = blockIdx.x >> 2;
    int b = -1, rbase = 0, nkeys, qpos, kpos0 = 0;
    if (c < 256) { c = 255 - c; nkeys = 64 * (c + 1); qpos = 64 * c + qi; rbase = 0; }
    else { b = c - 256; nkeys = DS; rbase = SEQ + b * DS; qpos = PAST + qi; kpos0 = PAST; c = 0; }
    const size_t qrow = (size_t)rbase + (b >= 0 ? qi : qpos);
    const float slope = exp2f(-2.f * (float)(h + 1)), lam = a.ctlf[l];
    float q1[16], q2[16];
#pragma unroll
    for (int i = 0; i < 16; ++i) { q1[i] = bf2f(a.qn[qrow * 512 + h * 128 + sl * 16 + i]) * 0.125f; q2[i] = bf2f(a.qn[qrow * 512 + h * 128 + 64 + sl * 16 + i]) * 0.125f; }
    float m1 = -INFINITY, m2 = -INFINITY, l1 = 0.f, l2 = 0.f, O1[32], O2[32];
#pragma unroll
    for (int i = 0; i < 32; ++i) { O1[i] = 0.f; O2[i] = 0.f; }
#define ATT_STEP(K1, K2, V, kp) do { float d1 = 0.f, d2 = 0.f; \
        _Pragma("unroll") for (int i = 0; i < 16; ++i) { d1 += q1[i] * K1(i); d2 += q2[i] * K2(i); } \
        d1 += __shfl_xor(d1, 1); d1 += __shfl_xor(d1, 2); d2 += __shfl_xor(d2, 1); d2 += __shfl_xor(d2, 2); \
        const float bias = slope * fabsf((float)(qpos - (kp))); const float s1 = d1 - bias, s2 = d2 - bias; \
        if (s1 > m1) { const float cr = __expf(m1 - s1); l1 *= cr; _Pragma("unroll") for (int i = 0; i < 32; ++i) O1[i] *= cr; m1 = s1; } \
        if (s2 > m2) { const float cr = __expf(m2 - s2); l2 *= cr; _Pragma("unroll") for (int i = 0; i < 32; ++i) O2[i] *= cr; m2 = s2; } \
        const float p1 = __expf(s1 - m1), p2 = __expf(s2 - m2); l1 += p1; l2 += p2; \
        _Pragma("unroll") for (int i = 0; i < 32; ++i) { const float vv = V(i); O1[i] += p1 * vv; O2[i] += p2 * vv; } } while (0)
    if (b >= 0) {
        const float* ck = a.ck + ((size_t)(l * DB + b) * PAST) * 512 + h * 128; const float* cv = a.cv + ((size_t)(l * DB + b) * PAST) * 512 + h * 128;
        for (int kp = 0; kp < PAST; ++kp) { const float* kr = ck + (size_t)kp * 512; const float* vr = cv + (size_t)kp * 512 + sl * 32;
#define K1F(i) kr[sl * 16 + i]
#define K2F(i) kr[64 + sl * 16 + i]
#define VF(i) vr[i]
            ATT_STEP(K1F, K2F, VF, kp); }
    }
    for (int kk = 0; kk < nkeys; ++kk) { const size_t krow = (size_t)rbase + kk; const bf16* kr = a.kn + krow * 512 + h * 128; const bf16* vr = a.proj + krow * NPJ + C_DV + h * 128 + sl * 32;
#define K1B(i) bf2f(kr[sl * 16 + i])
#define K2B(i) bf2f(kr[64 + sl * 16 + i])
#define VB(i) bf2f(vr[i])
        ATT_STEP(K1B, K2B, VB, kpos0 + kk); }
    const float r1 = 1.f / l1, r2 = lam / l2;
#pragma unroll
    for (int i = 0; i < 32; ++i) a.oatt[qrow * 512 + h * 128 + sl * 32 + i] = O1[i] * r1 - O2[i] * r2;
}
struct MixArgs { const bf16* proj; const float* yssd; const float* oatt; const float* ogla; const float* ssd_norm_g; const float* diff_out_g; const float* gla_norm_g; bf16* mix; int layer, pad; };
__global__ void __launch_bounds__(256) mixfin_kernel(MixArgs a) {
    __shared__ float red[4];
    const int row = blockIdx.x, tid = threadIdx.x, l = a.layer, wave = tid >> 6; const bf16* pr = a.proj + (size_t)row * NPJ; bf16* mr = a.mix + (size_t)row * DM;
    { const int i0 = 4 * tid; float y[4]; float ss = 0.f;
#pragma unroll
      for (int j = 0; j < 4; ++j) { y[j] = a.yssd[(size_t)row * 1024 + i0 + j] * silu_f(bf2f(pr[C_Z + i0 + j])); ss += y[j] * y[j]; }
      ss = wave_sum(ss); if ((tid & 63) == 0) red[wave] = ss; __syncthreads();
      const float tot = (wave < 2) ? red[0] + red[1] : red[2] + red[3]; const float r = 1.0f / sqrtf(tot * (1.f / 512.f) + EPS);
      u32x2 o; o.x = pk2(y[0] * r * a.ssd_norm_g[l * 1024 + i0], y[1] * r * a.ssd_norm_g[l * 1024 + i0 + 1]); o.y = pk2(y[2] * r * a.ssd_norm_g[l * 1024 + i0 + 2], y[3] * r * a.ssd_norm_g[l * 1024 + i0 + 3]);
      *(u32x2*)(mr + i0) = o; }
    { const int i0 = 2 * tid, d = i0 & 127; const float lam_init = 0.8f - 0.6f * expf(-0.3f * (float)l);
      const float o0 = a.oatt[(size_t)row * 512 + i0], o1 = a.oatt[(size_t)row * 512 + i0 + 1]; const float ss = wave_sum(o0 * o0 + o1 * o1);
      const float r = (1.0f / sqrtf(ss * (1.f / 128.f) + EPS)) * (1.f - lam_init);
      *(unsigned*)(mr + 1024 + i0) = pk2(o0 * r * a.diff_out_g[l * 128 + d], o1 * r * a.diff_out_g[l * 128 + d + 1]); }
    { const int i0 = 2 * tid, d = i0 & 127;
      const float o0 = a.ogla[(size_t)row * 512 + i0], o1 = a.ogla[(size_t)row * 512 + i0 + 1]; const float ss = wave_sum(o0 * o0 + o1 * o1);
      const float r = 1.0f / sqrtf(ss * (1.f / 128.f) + EPS);
      *(unsigned*)(mr + 1536 + i0) = pk2(o0 * r * a.gla_norm_g[l * 128 + d] * silu_f(bf2f(pr[C_GG + i0])), o1 * r * a.gla_norm_g[l * 128 + d + 1] * silu_f(bf2f(pr[C_GG + i0 + 1]))); }
}
template <class Epi> static void launch_gemm(const bf16* A, const bf16* Bt, int M, int N, int K, const Epi& E, hipStream_t stream) {
    static bool attr_done = false;
    if (!attr_done) { (void)hipFuncSetAttribute((const void*)gemm_kernel<Epi>, hipFuncAttributeMaxDynamicSharedMemorySize, pg8::STAGE_BYTES); attr_done = true; }
    GemmArgs ga{}; ga.A = A; ga.Bt = Bt; ga.M = M; ga.N = N; ga.K = K; ga.pad = 0;
    hipLaunchKernelGGL(gemm_kernel<Epi>, dim3(256), dim3(512), pg8::STAGE_BYTES, stream, ga, E);
}
extern "C" void kernel_launch(void* const* d_in, const int* in_sizes, int n_in, void* d_out, int out_size, void* d_ws, size_t ws_size, hipStream_t stream) {
    if (n_in != 26 || out_size != (int)O_END || ws_size < WS_END) { fprintf(stderr, "kernel_launch: unexpected shapes (n_in %d out %d ws %zu)\n", n_in, out_size, ws_size); return; }
    const float* const* in = (const float* const*)d_in;
    const float *x_prompt = in[0], *x_sample = in[1], *cache_k = in[2], *cache_v = in[3], *st_conv = in[4], *st_ssd = in[5], *st_gla = in[6], *norm1_g = in[7], *w_in = in[8],
                *conv_w = in[9], *conv_b = in[10], *dt_bias = in[11], *a_log = in[12], *ssd_d = in[13], *ssd_norm_g = in[14], *qn_g = in[15], *kn_g = in[16], *dlam = in[17],
                *dout_g = in[18], *wa2 = in[19], *gba = in[20], *gla_norm_g = in[21], *w_out = in[22], *norm2_g = in[23], *w1 = in[24], *w2 = in[25];
    float* out = (float*)d_out; unsigned char* ws = (unsigned char*)d_ws;
    float* ctlf = (float*)(ws + WS_CTL);
    bf16 *WIN = (bf16*)(ws + WS_WIN), *WOUT = (bf16*)(ws + WS_WOUT), *W1 = (bf16*)(ws + WS_W1), *W2 = (bf16*)(ws + WS_W2), *H = (bf16*)(ws + WS_H), *MIX = (bf16*)(ws + WS_MIX),
         *PROJ = (bf16*)(ws + WS_PROJ), *HID = (bf16*)(ws + WS_HID), *QN = (bf16*)(ws + WS_QN), *KN = (bf16*)(ws + WS_KN);
    float *XC = (float*)(ws + WS_XC), *YSSD = (float*)(ws + WS_YSSD), *OGLA = (float*)(ws + WS_OGLA), *OATT = (float*)(ws + WS_OATT), *LOGA = (float*)(ws + WS_LOGA),
          *DTGA = (float*)(ws + WS_DTGA), *DT = (float*)(ws + WS_DT);
    for (int l = 0; l < DEPTH; ++l) {
        hipLaunchKernelGGL(transpose_w_kernel, dim3(1024), dim3(256), 0, stream, w_in + (size_t)l * DM * IN_COLS, DM, IN_COLS, WIN + (size_t)l * NPAD * DM, NPAD, 1);
        hipLaunchKernelGGL(transpose_w_kernel, dim3(1024), dim3(256), 0, stream, w_out + (size_t)l * DM * DM, DM, DM, WOUT + (size_t)l * DM * DM, DM, 0);
        hipLaunchKernelGGL(transpose_w_kernel, dim3(1024), dim3(256), 0, stream, w1 + (size_t)l * DM * DFF, DM, DFF, W1 + (size_t)l * DFF * DM, DFF, 0);
        hipLaunchKernelGGL(transpose_w_kernel, dim3(1024), dim3(256), 0, stream, w2 + (size_t)l * DFF * DM, DFF, DM, W2 + (size_t)l * DM * DFF, DM, 0);
    }
    hipLaunchKernelGGL(scalars_kernel, dim3(1), dim3(64), 0, stream, dlam, ctlf);
    for (int l = 0; l < DEPTH; ++l) {
        const float* xa = l == 0 ? x_prompt : out; const float* xb = l == 0 ? x_sample : out + (size_t)SEQ * DM;
        hipLaunchKernelGGL(rmsnorm_kernel, dim3(NROW / 4), dim3(256), 0, stream, xa, xb, norm1_g + l * DM, H);
        launch_gemm(H, WIN + (size_t)l * NPAD * DM, NROW, NPAD, DM, pg8::EpiInProj{PROJ, DTGA}, stream);
        PrepArgs pa{}; pa.proj = PROJ; pa.dtga = DTGA; pa.conv_state = st_conv; pa.conv_w = conv_w; pa.conv_b = conv_b; pa.dt_bias = dt_bias; pa.wa2 = wa2; pa.ba = gba; pa.qn_g = qn_g; pa.kn_g = kn_g;
        pa.xc = XC; pa.dt = DT; pa.loga = LOGA; pa.qn = QN; pa.kn = KN; pa.out = out; pa.layer = l; pa.pad = 0;
        hipLaunchKernelGGL(prep_kernel, dim3(NROW), dim3(256), 0, stream, pa);
        SsdArgs sa{}; sa.xc = XC; sa.dt = DT; sa.state = st_ssd; sa.a_log = a_log; sa.dpar = ssd_d; sa.yssd = YSSD; sa.out = out; sa.layer = l; sa.pad = 0;
        hipLaunchKernelGGL(ssd_naive_kernel, dim3(128 + DB * 128), dim3(256), 0, stream, sa);
        GlaArgs ga{}; ga.proj = PROJ; ga.loga = LOGA; ga.state = st_gla; ga.ogla = OGLA; ga.out = out; ga.layer = l; ga.pad = 0;
        hipLaunchKernelGGL(gla_naive_kernel, dim3(64 + DB * 64), dim3(256), 0, stream, ga);
        AttArgs aa{}; aa.qn = QN; aa.kn = KN; aa.proj = PROJ; aa.ck = cache_k; aa.cv = cache_v; aa.ctlf = ctlf; aa.oatt = OATT; aa.layer = l; aa.pad = 0;
        hipLaunchKernelGGL(attn_naive_kernel, dim3(288 * 4), dim3(256), 0, stream, aa);
        MixArgs ma{}; ma.proj = PROJ; ma.yssd = YSSD; ma.oatt = OATT; ma.ogla = OGLA; ma.ssd_norm_g = ssd_norm_g; ma.diff_out_g = dout_g; ma.gla_norm_g = gla_norm_g; ma.mix = MIX; ma.layer = l; ma.pad = 0;
        hipLaunchKernelGGL(mixfin_kernel, dim3(NROW), dim3(256), 0, stream, ma);
        launch_gemm(MIX, WOUT + (size_t)l * DM * DM, NROW, DM, DM, pg8::EpiResid{xa, xb, out}, stream);
        hipLaunchKernelGGL(rmsnorm_kernel, dim3(NROW / 4), dim3(256), 0, stream, (const float*)out, (const float*)(out + (size_t)SEQ * DM), norm2_g + l * DM, H);
        launch_gemm(H, W1 + (size_t)l * DFF * DM, NROW, DFF, DM, pg8::EpiRelu2{HID, (long)DFF}, stream);
        launch_gemm(HID, W2 + (size_t)l * DM * DFF, NROW, DM, DFF, pg8::EpiResid{out, out + (size_t)SEQ * DM, out}, stream);
    }
}
```

```cpp
#include <hip/hip_runtime.h>
#include <cstdio>
#include <cstdint>
namespace pg8 {
#define PG8_LAS __attribute__((address_space(3)))
typedef unsigned short bf16_t;
typedef short bf16x8 __attribute__((ext_vector_type(8)));
typedef float f32x4 __attribute__((ext_vector_type(4)));
typedef unsigned u32x4 __attribute__((ext_vector_type(4)));
constexpr int BM = 256, BK = 64, HALF = 128, HTB = HALF * BK * 2  , STAGE_BYTES = 8 * HTB, NXCD = 8, WGM = 8;

__host__ __device__ __forceinline__ int lds_byte(int r, int c) { const int st = (r >> 4) * 2 + (c >> 5), rr = r & 15, cc = c & 31, ob = rr * 64 + cc * 2; return st * 1024 + (ob ^ (((ob >> 9) & 1) << 5)); }
__host__ __device__ __forceinline__ void stage_rc(int b, int& R, int& C) { const int st = b / 1024, sb = b % 1024, swz = sb ^ (((sb >> 9) & 1) << 5); R = (st >> 1) * 16 + swz / 64; C = (st & 1) * 32 + (swz % 64) / 2; }
__host__ __device__ __forceinline__ int perm32(int rho) { const int n = rho >> 4, i = rho & 15; return 8 * (i >> 2) + 4 * n + (i & 3); }

struct Unit { int pm, pn, k0, nt, ns, sl, ti; };
struct Gemm { const bf16_t* A; const bf16_t* Bt; int M, N, K; };

struct StaticOrder {
    int nM, nN, nwg, G, c, K, R, T, Sn, wgm; float* slabs; unsigned* cnt;
    __host__ __device__ __forceinline__ void init(int M, int N, int G_, int c_, int K_ = 0, float* slabs_ = nullptr, unsigned* cnt_ = nullptr) { nM = M / BM; nN = N / BM; nwg = nM * nN; G = G_; c = c_; K = K_; slabs = slabs_; cnt = cnt_;
        R = nwg / G; T = nwg - R * G; Sn = 1; wgm = 4;
        if (T > 0 && slabs_) { Sn = G / T; while (Sn > 1 && ((K / Sn) % 128 != 0 || K / Sn < 256)) --Sn; }
        if (!slabs_ || Sn <= 1) { Sn = 1; } }
    __host__ __device__ __forceinline__ void tile(int L, Unit& u) const {
        int wgid = L; { const int q = nwg / NXCD, r = nwg % NXCD, xcd = wgid % NXCD, off = wgid / NXCD; wgid = (xcd < r ? xcd * (q + 1) : r * (q + 1) + (xcd - r) * q) + off; }
        const int nig = wgm * nN, gid = wgid / nig, fm = gid * wgm, gsz = (nM - fm) < wgm ? (nM - fm) : wgm;
        u.pm = fm + ((wgid % nig) % gsz); u.pn = (wgid % nig) / gsz; }
    __host__ __device__ __forceinline__ bool next(int i, Unit& u) const {
        u.k0 = 0; u.nt = K / BK; u.ns = 1; u.sl = 0; u.ti = 0;
        if (Sn > 1 && i >= R) { if (i > R || c >= T * Sn) return false; u.ti = c % T; u.sl = c / T; u.ns = Sn; u.nt = K / BK / Sn; u.k0 = u.sl * (K / Sn); tile(R * G + u.ti, u); return true; }
        const long L = (long)i * G + c; if (L >= nwg) return false;
        tile((int)L, u); return true;
    }
    __device__ __forceinline__ void a_ready(const Unit&) const {}
    __device__ __forceinline__ void done(const Unit&) const {}
};

__device__ __forceinline__ unsigned cvt_pk_bf16(float lo, float hi) { unsigned r; asm volatile("v_cvt_pk_bf16_f32 %0, %1, %2" : "=v"(r) : "v"(lo), "v"(hi)); return r; }
typedef float f32x2 __attribute__((ext_vector_type(2)));
template <class Epi, class Sched, bool ALIGN_EPI = false, bool SP2 = false>
__device__ __forceinline__ void gemm_phase(PG8_LAS unsigned char* lds, const Gemm g, const Sched& S, const Epi& E, int tid_in) {
    int tid_ = tid_in; asm volatile("" : "+v"(tid_));
    const int tid = tid_, wid = __builtin_amdgcn_readfirstlane(tid >> 6), lane = tid & 63, wr = wid >> 2, wc = wid & 3, fr = lane & 15, fq = lane >> 4;
    const int K = g.K;
    unsigned voffA[2], voffB[2];
#pragma unroll
    for (int i = 0; i < 2; ++i) { int R, C; stage_rc(tid * 16 + i * 8192, R, C); const int Rb = Epi::PERM ? ((R & ~31) + perm32(R & 31)) : R;
        voffA[i] = (unsigned)(R * K + C) * 2u; voffB[i] = (unsigned)(Rb * K + C) * 2u; }
    const size_t kstep = (size_t)(BK * 2);
    const size_t hstep = (size_t)HALF * K * 2;
    const size_t tstep = 2 * hstep;
    const unsigned ldsw = (unsigned)wid * 1024u;
    const int aoff = lds_byte(wr * 64 + fr, fq * 8), boff = lds_byte(wc * 32 + fr, fq * 8);
#define PG8_SA(b, h) (((b) * 2 + (h)) * HTB)
#define PG8_SB(b, h) ((4 + (b) * 2 + (h)) * HTB)
#define PG8_STAGE(bufoff, gbase, voff) do { _Pragma("unroll") for (int _i = 0; _i < 2; ++_i) \
        __builtin_amdgcn_global_load_lds((const unsigned*)((const char*)(gbase) + (voff)[_i]), (PG8_LAS unsigned*)(lds + (bufoff) + ldsw + _i * 8192), 16, 0, 0); } while (0)
#define PG8_LDA(dst, b, h) do { _Pragma("unroll") for (int m = 0; m < 4; ++m) _Pragma("unroll") for (int k = 0; k < 2; ++k) dst[m][k] = *(const PG8_LAS bf16x8*)(lds + PG8_SA(b, h) + aoff + m * 2048 + k * 1024); } while (0)
#define PG8_LDB(dst, b, h) do { _Pragma("unroll") for (int n = 0; n < 2; ++n) _Pragma("unroll") for (int k = 0; k < 2; ++k) dst[n][k] = *(const PG8_LAS bf16x8*)(lds + PG8_SB(b, h) + boff + n * 2048 + k * 1024); } while (0)
#define PG8_MMA(ai, bj, At, Bt) do { __builtin_amdgcn_s_setprio(1); _Pragma("unroll") for (int m = 0; m < 4; ++m) _Pragma("unroll") for (int n = 0; n < 2; ++n) _Pragma("unroll") for (int k = 0; k < 2; ++k) \
        acc[ai][bj][m][n] = __builtin_amdgcn_mfma_f32_16x16x32_bf16(Bt[n][k], At[m][k], acc[ai][bj][m][n], 0, 0, 0); __builtin_amdgcn_s_setprio(0); } while (0)
#define PG8_WAIT_V(n) asm volatile("s_waitcnt vmcnt(" #n ")" ::: "memory")
#define PG8_WAIT_L(n) asm volatile("s_waitcnt lgkmcnt(" #n ")" ::: "memory")
#define PG8_BAR __builtin_amdgcn_s_barrier()
#define PG8_SCHED __builtin_amdgcn_sched_barrier(0)
    Unit cur, nxt; int ui = 0;
    if (!S.next(0, cur)) return;
    f32x4 acc[2][2][4][2];
#pragma unroll
    for (int a = 0; a < 2; ++a)
#pragma unroll
        for (int b = 0; b < 2; ++b)
#pragma unroll
            for (int m = 0; m < 4; ++m)
#pragma unroll
                for (int n = 0; n < 2; ++n) acc[a][b][m][n] = (f32x4){0.f, 0.f, 0.f, 0.f};
    bf16x8 At[4][2], B0[2][2], B1[2][2];
    const char* cA = (const char*)g.A + (size_t)cur.pm * tstep + (size_t)cur.k0 * 2; const char* cB = (const char*)g.Bt + (size_t)cur.pn * tstep + (size_t)cur.k0 * 2;
    S.a_ready(cur);
    if constexpr (SP2) {
        PG8_STAGE(PG8_SB(0, 0), cB, voffB); PG8_STAGE(PG8_SB(0, 1), cB + hstep, voffB); PG8_STAGE(PG8_SA(0, 0), cA, voffA); PG8_STAGE(PG8_SA(0, 1), cA + hstep, voffA);
        if (wr == 1) PG8_BAR;
        PG8_WAIT_V(2); PG8_BAR;
        PG8_STAGE(PG8_SB(1, 0), cB + kstep, voffB); PG8_STAGE(PG8_SA(1, 0), cA + kstep, voffA); PG8_STAGE(PG8_SB(1, 1), cB + hstep + kstep, voffB);
        PG8_WAIT_V(6); PG8_BAR;
    } else {
        PG8_STAGE(PG8_SB(0, 0), cB, voffB); PG8_STAGE(PG8_SA(0, 0), cA, voffA); PG8_STAGE(PG8_SB(0, 1), cB + hstep, voffB); PG8_STAGE(PG8_SA(0, 1), cA + hstep, voffA);
        if (wr == 1) PG8_BAR;
        PG8_WAIT_V(4); PG8_BAR;
        PG8_STAGE(PG8_SB(1, 0), cB + kstep, voffB); PG8_STAGE(PG8_SA(1, 0), cA + kstep, voffA); PG8_STAGE(PG8_SB(1, 1), cB + hstep + kstep, voffB);
        PG8_WAIT_V(6); PG8_BAR;
    }
    for (;;) {
        const bool has_next = S.next(ui + 1, nxt);
        const char* nA = has_next ? (const char*)g.A + (size_t)nxt.pm * tstep + (size_t)nxt.k0 * 2 : cA; const char* nB = has_next ? (const char*)g.Bt + (size_t)nxt.pn * tstep + (size_t)nxt.k0 * 2 : cB;
        const int nt = cur.nt;
        for (int t = 0; t < nt; t += 2) {
            const bool last = (t == nt - 2);
            const char* a1 = cA + (size_t)(t + 1) * kstep;
            const char* a2 = last ? nA : cA + (size_t)(t + 2) * kstep; const char* b2 = last ? nB : cB + (size_t)(t + 2) * kstep;
            const char* a3 = a2 + kstep; const char* b3 = b2 + kstep;
            if (last && has_next) S.a_ready(nxt);
            if constexpr (SP2) {
            PG8_LDB(B0, 0, 0); PG8_LDB(B1, 0, 1); PG8_SCHED; PG8_LDA(At, 0, 0); PG8_STAGE(PG8_SA(1, 1), a1 + hstep, voffA);
            PG8_WAIT_V(8); PG8_WAIT_L(0); PG8_BAR; PG8_MMA(0, 0, At, B0); PG8_MMA(0, 1, At, B1); PG8_BAR; PG8_SCHED;
            PG8_LDA(At, 0, 1); PG8_STAGE(PG8_SB(0, 0), b2, voffB); PG8_STAGE(PG8_SB(0, 1), b2 + hstep, voffB); PG8_STAGE(PG8_SA(0, 0), a2, voffA);
            PG8_WAIT_V(8); PG8_WAIT_L(0); PG8_BAR; PG8_MMA(1, 0, At, B0); PG8_MMA(1, 1, At, B1); PG8_BAR; PG8_SCHED;
            PG8_LDB(B0, 1, 0); PG8_LDB(B1, 1, 1); PG8_SCHED; PG8_LDA(At, 1, 0); PG8_STAGE(PG8_SA(0, 1), a2 + hstep, voffA);
            PG8_WAIT_V(8); PG8_WAIT_L(0); PG8_BAR; PG8_MMA(0, 0, At, B0); PG8_MMA(0, 1, At, B1); PG8_BAR; PG8_SCHED;
            PG8_LDA(At, 1, 1); PG8_STAGE(PG8_SB(1, 0), b3, voffB); PG8_STAGE(PG8_SB(1, 1), b3 + hstep, voffB); PG8_STAGE(PG8_SA(1, 0), a3, voffA);
            PG8_WAIT_V(8); PG8_WAIT_L(0); PG8_BAR; PG8_MMA(1, 0, At, B0); PG8_MMA(1, 1, At, B1); PG8_BAR; PG8_SCHED;
            } else {
            PG8_LDB(B0, 0, 0); PG8_SCHED; PG8_LDA(At, 0, 0); PG8_STAGE(PG8_SA(1, 1), a1 + hstep, voffA);
            PG8_WAIT_L(8); PG8_BAR; PG8_WAIT_L(0); PG8_MMA(0, 0, At, B0); PG8_BAR; PG8_SCHED;
            PG8_LDB(B1, 0, 1); PG8_STAGE(PG8_SB(0, 0), b2, voffB);
            PG8_BAR; PG8_WAIT_L(0); PG8_MMA(0, 1, At, B1); PG8_BAR;
            PG8_LDA(At, 0, 1); PG8_STAGE(PG8_SA(0, 0), a2, voffA);
            PG8_BAR; PG8_WAIT_L(0); PG8_MMA(1, 0, At, B0); PG8_BAR; PG8_SCHED;
            PG8_STAGE(PG8_SB(0, 1), b2 + hstep, voffB);
            PG8_WAIT_V(6); PG8_BAR; PG8_MMA(1, 1, At, B1); PG8_BAR;
            PG8_LDB(B0, 1, 0); PG8_SCHED; PG8_LDA(At, 1, 0); PG8_STAGE(PG8_SA(0, 1), a2 + hstep, voffA);
            PG8_WAIT_L(8); PG8_BAR; PG8_WAIT_L(0); PG8_MMA(0, 0, At, B0); PG8_BAR; PG8_SCHED;
            PG8_LDB(B1, 1, 1); PG8_STAGE(PG8_SB(1, 0), b3, voffB);
            PG8_BAR; PG8_WAIT_L(0); PG8_MMA(0, 1, At, B1); PG8_BAR;
            PG8_LDA(At, 1, 1); PG8_STAGE(PG8_SA(1, 0), a3, voffA);
            PG8_BAR; PG8_WAIT_L(0); PG8_MMA(1, 0, At, B0); PG8_BAR; PG8_SCHED;
            PG8_STAGE(PG8_SB(1, 1), b3 + hstep, voffB);
            PG8_WAIT_V(6); PG8_BAR; PG8_MMA(1, 1, At, B1); PG8_BAR;
            }
        }
        if constexpr (ALIGN_EPI) { if (wr == 0) PG8_BAR; }
        if constexpr (!Epi::AFTER_DRAIN) { if (cur.ns == 1) { E(acc, cur, wr, wc, fr, fq); S.done(cur); } }
        if (!has_next) break;
#pragma unroll
        for (int a = 0; a < 2; ++a)
#pragma unroll
            for (int b = 0; b < 2; ++b)
#pragma unroll
                for (int m = 0; m < 4; ++m)
#pragma unroll
                    for (int n = 0; n < 2; ++n) acc[a][b][m][n] = (f32x4){0.f, 0.f, 0.f, 0.f};
        cur = nxt; cA = nA; cB = nB; ++ui;
        if constexpr (ALIGN_EPI) { if (wr == 1) PG8_BAR; }
    }
    PG8_WAIT_V(0);
    if constexpr (!ALIGN_EPI) { if (wr == 0) PG8_BAR; }
    PG8_BAR;
    if constexpr (Epi::AFTER_DRAIN) { E.fused(acc, cur, wr, wc, fr, fq, lds, wid, lane); S.done(cur); }
    else if (cur.ns > 1) {
        float* slab = S.slabs + ((size_t)cur.ti * cur.ns + cur.sl) * (BM * BM);
        { const __amdgpu_buffer_rsrc_t rsrc = __builtin_amdgcn_make_buffer_rsrc(slab, 0, BM * BM * 4, 0x00020000);
#pragma unroll
          for (int a = 0; a < 2; ++a)
#pragma unroll
              for (int b = 0; b < 2; ++b)
#pragma unroll
                  for (int m = 0; m < 4; ++m)
#pragma unroll
                      for (int n = 0; n < 2; ++n) __builtin_amdgcn_raw_buffer_store_b128(__builtin_bit_cast(u32x4, acc[a][b][m][n]), rsrc, ((((a * 2 + b) * 4 + m) * 2 + n) * 512 + tid) * 16, 0, 16); }
        asm volatile("s_waitcnt vmcnt(0)" ::: "memory"); __syncthreads();
        volatile PG8_LAS unsigned* flag = (volatile PG8_LAS unsigned*)lds;
        if (tid == 0) { flag[0] = __hip_atomic_fetch_add(S.cnt + 64 * cur.ti, 1u, __ATOMIC_RELAXED, __HIP_MEMORY_SCOPE_AGENT); }
        __syncthreads();
        const bool lastarr = flag[0] == (unsigned)(cur.ns - 1);
        if (lastarr) {
            if (tid == 0) { __builtin_amdgcn_fence(__ATOMIC_ACQUIRE, "agent"); asm volatile("s_waitcnt vmcnt(0)" ::: "memory"); }
            __syncthreads();
            for (int s2 = 0; s2 < cur.ns; ++s2) if (s2 != cur.sl) { const float* os = S.slabs + ((size_t)cur.ti * cur.ns + s2) * (BM * BM);
#pragma unroll
                for (int ab = 0; ab < 4; ++ab) { f32x4 t[4][2];
#pragma unroll
                    for (int m = 0; m < 4; ++m)
#pragma unroll
                        for (int n = 0; n < 2; ++n) t[m][n] = *(const f32x4*)(os + (unsigned)((((ab * 4 + m) * 2 + n) * 512 + tid) * 4));
                    __builtin_amdgcn_sched_barrier(0);
#pragma unroll
                    for (int m = 0; m < 4; ++m)
#pragma unroll
                        for (int n = 0; n < 2; ++n) acc[ab >> 1][ab & 1][m][n] += t[m][n];
                    __builtin_amdgcn_sched_barrier(0); } }
            E(acc, cur, wr, wc, fr, fq); S.done(cur);
        }
        __syncthreads();
    }
#undef PG8_SA
#undef PG8_SB
#undef PG8_STAGE
#undef PG8_LDA
#undef PG8_LDB
#undef PG8_MMA
#undef PG8_WAIT_V
#undef PG8_WAIT_L
#undef PG8_BAR
#undef PG8_SCHED
}
}
constexpr int DM = 2048, SEQ = 16384, DEPTH = 2, DB = 32, DS = 64, PAST = 2048;
constexpr int NROW = SEQ + DB * DS;
constexpr int SSD_H = 16, SSD_P = 64, SSD_N = 128, CONV_DIM = 1536;
constexpr int NPJ = 5632, NPAD = 5888, DFF = 8192, IN_COLS = 5664;
constexpr float EPS = 1e-6f;
constexpr int C_Z = 0, C_XBC = 1024, C_DQ = 2560, C_DK = 3072, C_DV = 3584, C_GQ = 4096, C_GK = 4352, C_GV = 4608, C_GG = 5120;
constexpr size_t O_Y = 0, O_KP = 37748736, O_VP = 54525952, O_CP = 71303168, O_HP = 71312384, O_SP = 71574528, O_KS = 71640064, O_VS = 73737216,
                 O_CS = 75834368, O_HS = 76129280, O_SS = 84517888, O_END = 86615040;
constexpr size_t MiB = 1u << 20;
constexpr size_t WS_CTL = 0, WS_WIN = 1 * MiB, WS_WOUT = 47 * MiB, WS_W1 = 63 * MiB, WS_W2 = 127 * MiB, WS_H = 191 * MiB, WS_MIX = 263 * MiB,
                 WS_PROJ = 335 * MiB, WS_HID = 335 * MiB  , WS_SSTATE = 533 * MiB, WS_HIN = 677 * MiB, WS_KP = 749 * MiB, WS_VP = 765 * MiB,
                 WS_QN = 785 * MiB, WS_GSTATE = 821 * MiB, WS_DTGA = 857 * MiB, WS_SDECAY = 860 * MiB, WS_KC = 861 * MiB, WS_VC = 927 * MiB, WS_GHIN = 993 * MiB, WS_GDECAY = 1011 * MiB, WS_APART = 1012 * MiB, WS_SUMSQ = 1054 * MiB, WS_END = 1056 * MiB;
typedef unsigned short bf16;
typedef float f32x4 __attribute__((ext_vector_type(4)));
typedef unsigned u32x4 __attribute__((ext_vector_type(4)));
typedef unsigned u32x2 __attribute__((ext_vector_type(2)));
__device__ __forceinline__ unsigned f2bf(float f) { unsigned u = __builtin_bit_cast(unsigned, f); return (u + 0x7fffu + ((u >> 16) & 1u)) >> 16; }
__device__ __forceinline__ unsigned pk2(float lo, float hi) { return f2bf(lo) | (f2bf(hi) << 16); }
__device__ __forceinline__ float bf2f(bf16 b) { return __builtin_bit_cast(float, (unsigned)b << 16); }
__device__ __forceinline__ float silu_f(float x) { return x * __builtin_amdgcn_rcpf(1.f + __expf(-x)); }
__device__ __forceinline__ float softplus_f(float x) { return x > 15.f ? x : __logf(1.f + __expf(x)); }
__device__ __forceinline__ float logsigmoid_f(float x) { return fminf(x, 0.f) - __logf(1.f + __expf(-fabsf(x))); }

#define GAS __attribute__((address_space(1)))
#define LAS __attribute__((address_space(3)))
typedef GAS unsigned gu32;
#define RLX_AGENT __ATOMIC_RELAXED, __HIP_MEMORY_SCOPE_AGENT
__device__ __forceinline__ int opaque_s(int x) { asm volatile("" : "+s"(x)); return x; }
__device__ __forceinline__ int opaque_v(int x) { asm volatile("" : "+v"(x)); return x; }
__device__ __forceinline__ float swz_xor16(float v) { return __builtin_bit_cast(float, __builtin_amdgcn_ds_swizzle(__builtin_bit_cast(int, v), 0x401F)); }
__device__ __forceinline__ float swz_xor8(float v)  { return __builtin_bit_cast(float, __builtin_amdgcn_ds_swizzle(__builtin_bit_cast(int, v), 0x201F)); }
__device__ __forceinline__ float swz_xor4(float v)  { return __builtin_bit_cast(float, __builtin_amdgcn_ds_swizzle(__builtin_bit_cast(int, v), 0x101F)); }
__device__ __forceinline__ float dpp_xor2(float v)  { return __builtin_bit_cast(float, __builtin_amdgcn_mov_dpp(__builtin_bit_cast(int, v), 0x4E, 0xf, 0xf, true)); }
__device__ __forceinline__ float dpp_xor1(float v)  { return __builtin_bit_cast(float, __builtin_amdgcn_mov_dpp(__builtin_bit_cast(int, v), 0xB1, 0xf, 0xf, true)); }
__device__ __forceinline__ float half_sum(float v) {
    v += dpp_xor1(v); v += dpp_xor2(v); v += swz_xor4(v); v += swz_xor8(v); v += swz_xor16(v); return v; }
__device__ __forceinline__ float wave_sum(float v) {
    v = half_sum(v); auto rr = __builtin_amdgcn_permlane32_swap(__float_as_uint(v), __float_as_uint(v), false, false); return __uint_as_float(rr[0]) + __uint_as_float(rr[1]); }
__device__ __forceinline__ int lane_id() { int l; asm volatile("v_mbcnt_lo_u32_b32 %0, -1, 0\n\tv_mbcnt_hi_u32_b32 %0, -1, %0" : "=v"(l)); return l; }
__device__ __forceinline__ float half_max(float v) {
    v = fmaxf(v, dpp_xor1(v)); v = fmaxf(v, dpp_xor2(v)); v = fmaxf(v, swz_xor4(v)); v = fmaxf(v, swz_xor8(v)); v = fmaxf(v, swz_xor16(v)); return v; }
__device__ __forceinline__ float wave_max(float v) {
    v = half_max(v); auto rr = __builtin_amdgcn_permlane32_swap(__float_as_uint(v), __float_as_uint(v), false, false); return fmaxf(__uint_as_float(rr[0]), __uint_as_float(rr[1])); }
__device__ __forceinline__ float rbf(float x) { return __builtin_bit_cast(float, ((__builtin_bit_cast(unsigned, x) + 0x7fffu + ((__builtin_bit_cast(unsigned, x) >> 16) & 1u)) & 0xffff0000u)); }

__device__ __forceinline__ void lds_barrier() { asm volatile("s_waitcnt lgkmcnt(0)\n\ts_barrier" ::: "memory"); }
#define XB_TMO      128
#define XB_XCNT(j)  (256  + 64 * (j))
#define XB_XSUB(j)  (1280 + 64 * (j))
#define XB_XGEN(j)  (2304 + 64 * (j))
#define XB_TOP      3328
#define XB_TOPGEN   3392
#define XCD_BAR_WORDS 3456
#define XB_SPIN_CAP (1u << 23)

__device__ __forceinline__ unsigned xb_ld(unsigned* p)              { return __hip_atomic_load(p, __ATOMIC_RELAXED, __HIP_MEMORY_SCOPE_AGENT); }
__device__ __forceinline__ unsigned xb_add(unsigned* p, unsigned v) { return __hip_atomic_fetch_add(p, v, __ATOMIC_RELAXED, __HIP_MEMORY_SCOPE_AGENT); }
__device__ __forceinline__ unsigned xb_xcc_id() { return (unsigned)__builtin_amdgcn_s_getreg((3 << 11) | 20) & 0xFu; }
#define XB_SPIN(cond, bar) do { unsigned _sp = 0; while (cond) { __builtin_amdgcn_s_sleep(1); \
    if ((++_sp & 255u) == 0u) { if (xb_ld(&(bar)[XB_TMO])) break; if (_sp > XB_SPIN_CAP) { atomicAdd(&(bar)[XB_TMO], 1u); break; } } } } while (0)

struct XcdBarrier {
    unsigned* bar; unsigned x;
    volatile LAS unsigned* st;
};

__device__ __forceinline__ XcdBarrier xcd_barrier_post(unsigned* bar, volatile LAS unsigned* st) {
    XcdBarrier b; b.bar = bar; b.x = xb_xcc_id(); b.st = st;
    if (threadIdx.x == 0) (void)xb_add(&bar[XB_XCNT(b.x)], 1u);
    return b;
}
__device__ __forceinline__ void xcd_barrier_complete(unsigned* bar, unsigned x, unsigned& nloc, unsigned& nx) {
    const unsigned G = gridDim.x * gridDim.y * gridDim.z;
    unsigned sum, cnt, mine, sp = 0u;
    for (;;) {
        sum = 0u; cnt = 0u; mine = 0u;
#pragma unroll
        for (unsigned j = 0; j < 16; ++j) { const unsigned c = xb_ld(&bar[XB_XCNT(j)]); sum += c; cnt += (c > 0u) ? 1u : 0u; mine = (j == x) ? c : mine; }
        if (sum == G) break;
        __builtin_amdgcn_s_sleep(1);
        if ((++sp & 255u) == 0u) { if (xb_ld(&bar[XB_TMO])) break; if (sp > XB_SPIN_CAP) { atomicAdd(&bar[XB_TMO], 1u); break; } }
    }
    nloc = mine > 0u ? mine : 1u; nx = cnt > 0u ? cnt : 1u;
}

__device__ __forceinline__ void xcd_barrier(const XcdBarrier& b) {
    asm volatile("s_waitcnt vmcnt(0)" ::: "memory");
    __syncthreads();
    if (threadIdx.x == 0) {
        unsigned* bar = b.bar;
        __builtin_amdgcn_s_waitcnt(0);
        unsigned nloc = b.st[0], nx = b.st[1];
        if (nloc == 0u) { xcd_barrier_complete(bar, b.x, nloc, nx); b.st[0] = nloc; b.st[1] = nx; }
        const unsigned old = xb_add(&bar[XB_XSUB(b.x)], 1u);
        const unsigned gen = old / nloc;
        if (old + 1u == (gen + 1u) * nloc) {
            __builtin_amdgcn_fence(__ATOMIC_RELEASE, "agent");
            asm volatile("s_waitcnt vmcnt(0)" ::: "memory");
            const unsigned og = xb_add(&bar[XB_TOP], 1u);
            const unsigned tg = og / nx;
            if (og + 1u == (tg + 1u) * nx) xb_add(&bar[XB_TOPGEN], 1u);
            else XB_SPIN(xb_ld(&bar[XB_TOPGEN]) == tg, bar);
            __builtin_amdgcn_fence(__ATOMIC_ACQUIRE, "agent");
            xb_add(&bar[XB_XGEN(b.x)], 1u);
            asm volatile("s_waitcnt vmcnt(0)" ::: "memory");
        } else {
            XB_SPIN(xb_ld(&bar[XB_XGEN(b.x)]) == gen, bar);
            __builtin_amdgcn_fence(__ATOMIC_ACQUIRE, "agent");
            asm volatile("s_waitcnt vmcnt(0)" ::: "memory");
        }
    }
    __syncthreads();
}
namespace pg8 {
__device__ __forceinline__ float row_rstd(const float* ss, int row) { return __builtin_amdgcn_rsqf(ss[row] * (1.f / DM) + EPS); }
struct EpiInProj {
    static constexpr bool PERM = true, AFTER_DRAIN = false;
    bf16_t* P; float* T; const float* ss;
    __device__ __forceinline__ void operator()(const f32x4 (&acc)[2][2][4][2], const Unit& u, int wr, int wc, int fr, int fq) const {
        const int row0 = u.pm * BM + wr * 64 + fr;
        float rsv[2][4];
#pragma unroll
        for (int ai = 0; ai < 2; ++ai)
#pragma unroll
            for (int m = 0; m < 4; ++m) rsv[ai][m] = ss[row0 + ai * HALF + m * 16];
#pragma unroll
        for (int ai = 0; ai < 2; ++ai)
#pragma unroll
            for (int m = 0; m < 4; ++m) rsv[ai][m] = __builtin_amdgcn_rsqf(rsv[ai][m] * (1.f / DM) + EPS);
        if (u.pn < 22) {
            const int col0 = u.pn * BM + wc * 32 + 8 * fq;
#pragma unroll
            for (int ai = 0; ai < 2; ++ai)
#pragma unroll
                for (int m = 0; m < 4; ++m) { const int row = row0 + ai * HALF + m * 16; bf16_t* rowp = P + (size_t)row * NPJ + col0; const float rs = rsv[ai][m];
#pragma unroll
                    for (int bj = 0; bj < 2; ++bj) { const f32x4 v0 = acc[ai][bj][m][0] * rs, v1 = acc[ai][bj][m][1] * rs;
                        u32x4 w; w.x = cvt_pk_bf16(v0[0], v0[1]); w.y = cvt_pk_bf16(v0[2], v0[3]); w.z = cvt_pk_bf16(v1[0], v1[1]); w.w = cvt_pk_bf16(v1[2], v1[3]);
                        *(u32x4*)(rowp + bj * HALF) = w; } }
        } else if (wc == 0) {
#pragma unroll
            for (int ai = 0; ai < 2; ++ai)
#pragma unroll
                for (int m = 0; m < 4; ++m) { const int row = row0 + ai * HALF + m * 16; float* rp = T + (size_t)row * 32 + 8 * fq; const float rs = rsv[ai][m];
                    *(f32x4*)(rp) = acc[ai][0][m][0] * rs; *(f32x4*)(rp + 4) = acc[ai][0][m][1] * rs; }
        }
    }
};
struct EpiResid {
    static constexpr bool PERM = true, AFTER_DRAIN = false;
    const float* xa; const float* xb; const bf16_t* xin; float* out; bf16_t* xbf; float* ssq; const float* ss2;
    __device__ __forceinline__ void operator()(const f32x4 (&acc)[2][2][4][2], const Unit& u, int wr, int wc, int fr, int fq) const {
        const int col0 = u.pn * BM + wc * 32 + 8 * fq, rbase = u.pm * BM + wr * 64 + fr;
        float r2v[2][4];
#pragma unroll
        for (int ai = 0; ai < 2; ++ai)
#pragma unroll
            for (int m = 0; m < 4; ++m) r2v[ai][m] = ss2 ? ss2[rbase + ai * HALF + m * 16] : 0.f;
        if (xin) {
#pragma unroll
            for (int ai = 0; ai < 2; ++ai) { u32x4 bw[1][4][2];
#pragma unroll
                for (int m = 0; m < 4; ++m)
#pragma unroll
                    for (int bj = 0; bj < 2; ++bj) bw[0][m][bj] = *(const u32x4*)(xin + (size_t)(rbase + ai * HALF + m * 16) * DM + col0 + bj * HALF);
#pragma unroll
                for (int m = 0; m < 4; ++m) { const int r = rbase + ai * HALF + m * 16; float sq = 0.f;
                    const float r2 = ss2 ? __builtin_amdgcn_rcpf(r2v[ai][m] * (1.f / DM) + EPS) : 1.f;
#pragma unroll
                    for (int bj = 0; bj < 2; ++bj) { const size_t eo = (size_t)r * DM + col0 + bj * HALF; f32x4 v0, v1; const u32x4 w = bw[0][m][bj];
                        v0[0] = __uint_as_float(w.x << 16); v0[1] = __uint_as_float(w.x & 0xffff0000u); v0[2] = __uint_as_float(w.y << 16); v0[3] = __uint_as_float(w.y & 0xffff0000u);
                        v1[0] = __uint_as_float(w.z << 16); v1[1] = __uint_as_float(w.z & 0xffff0000u); v1[2] = __uint_as_float(w.w << 16); v1[3] = __uint_as_float(w.w & 0xffff0000u);
                        v0 += acc[ai][bj][m][0] * r2; v1 += acc[ai][bj][m][1] * r2;
                        if (out) { *(f32x4*)(out + eo) = v0; *(f32x4*)(out + eo + 4) = v1; }
                        if (xbf) { u32x4 o; o.x = cvt_pk_bf16(v0[0], v0[1]); o.y = cvt_pk_bf16(v0[2], v0[3]); o.z = cvt_pk_bf16(v1[0], v1[1]); o.w = cvt_pk_bf16(v1[2], v1[3]); *(u32x4*)(xbf + eo) = o;
                            sq += ((v0[0] * v0[0] + v0[1] * v0[1]) + (v0[2] * v0[2] + v0[3] * v0[3])) + ((v1[0] * v1[0] + v1[1] * v1[1]) + (v1[2] * v1[2] + v1[3] * v1[3])); } }
                    if (xbf) { sq += swz_xor16(sq); { auto rr = __builtin_amdgcn_permlane32_swap(__float_as_uint(sq), __float_as_uint(sq), false, false); sq = __uint_as_float(rr[0]) + __uint_as_float(rr[1]); }
                        if (fq == 0) atomicAdd(ssq + r, sq); } } }
            return; }
#pragma unroll
        for (int am = 0; am < 4; ++am) { const int ai = am >> 1;
            f32x4 bf[4][2][2];
#pragma unroll
            for (int m = 2 * (am & 1); m < 2 * (am & 1) + 2; ++m) { const int r = rbase + ai * HALF + m * 16; const float* b = (r < SEQ ? xa + (size_t)r * DM : xb + (size_t)(r - SEQ) * DM) + col0;
#pragma unroll
                for (int bj = 0; bj < 2; ++bj) { bf[m][bj][0] = *(const f32x4*)(b + bj * HALF); bf[m][bj][1] = *(const f32x4*)(b + bj * HALF + 4); } }
#pragma unroll
            for (int m = 2 * (am & 1); m < 2 * (am & 1) + 2; ++m) { const int r = rbase + ai * HALF + m * 16; float sq = 0.f;
                const float r2 = ss2 ? __builtin_amdgcn_rcpf(r2v[ai][m] * (1.f / DM) + EPS) : 1.f;
#pragma unroll
                for (int bj = 0; bj < 2; ++bj) { const size_t eo = (size_t)r * DM + col0 + bj * HALF;
                    const f32x4 v0 = bf[m][bj][0] + acc[ai][bj][m][0] * r2, v1 = bf[m][bj][1] + acc[ai][bj][m][1] * r2;
                    if (out) { *(f32x4*)(out + eo) = v0; *(f32x4*)(out + eo + 4) = v1; }
                    if (xbf) { u32x4 o; o.x = cvt_pk_bf16(v0[0], v0[1]); o.y = cvt_pk_bf16(v0[2], v0[3]); o.z = cvt_pk_bf16(v1[0], v1[1]); o.w = cvt_pk_bf16(v1[2], v1[3]); *(u32x4*)(xbf + eo) = o;
                        sq += ((v0[0] * v0[0] + v0[1] * v0[1]) + (v0[2] * v0[2] + v0[3] * v0[3])) + ((v1[0] * v1[0] + v1[1] * v1[1]) + (v1[2] * v1[2] + v1[3] * v1[3])); } }
                if (xbf) { sq += swz_xor16(sq); { auto rr = __builtin_amdgcn_permlane32_swap(__float_as_uint(sq), __float_as_uint(sq), false, false); sq = __uint_as_float(rr[0]) + __uint_as_float(rr[1]); }
                    if (fq == 0) atomicAdd(ssq + r, sq); } } }
    }
};
struct EpiRelu2 {
    static constexpr bool PERM = true, AFTER_DRAIN = false;
    bf16_t* O; long ldc;
    __device__ __forceinline__ void operator()(const f32x4 (&acc)[2][2][4][2], const Unit& u, int wr, int wc, int fr, int fq) const {
        const int row0 = u.pm * BM + wr * 64 + fr, col0 = u.pn * BM + wc * 32 + 8 * fq;
#pragma unroll
        for (int ai = 0; ai < 2; ++ai)
#pragma unroll
            for (int m = 0; m < 4; ++m) { bf16_t* rowp = O + (size_t)(row0 + ai * HALF + m * 16) * ldc + col0;
#pragma unroll
                for (int bj = 0; bj < 2; ++bj) { f32x4 v0 = acc[ai][bj][m][0], v1 = acc[ai][bj][m][1];
#pragma unroll
                    for (int j = 0; j < 4; ++j) { const float a = fmaxf(v0[j], 0.f), b = fmaxf(v1[j], 0.f); v0[j] = a * a; v1[j] = b * b; }
                    u32x4 w; w.x = cvt_pk_bf16(v0[0], v0[1]); w.y = cvt_pk_bf16(v0[2], v0[3]); w.z = cvt_pk_bf16(v1[0], v1[1]); w.w = cvt_pk_bf16(v1[2], v1[3]);
                    *(u32x4*)(rowp + bj * HALF) = w; } }
    }
};
}
namespace att {
typedef short bf16x8 __attribute__((ext_vector_type(8)));
typedef short s16x4 __attribute__((ext_vector_type(4)));
typedef float f32x16 __attribute__((ext_vector_type(16)));
typedef short v4i16_t __attribute__((ext_vector_type(4)));
typedef LAS const unsigned char* lds_cptr;
constexpr int SLOT = 32768, K_OFF = 0, V_OFF = 16384, NSLOT = 4, WS_OFF = NSLOT * SLOT + 1024  , LDS_NEED = WS_OFF + 8 * 256 + 16;
constexpr int PART_FLOATS = 8 * 64 * 64 + 8 * 128;
constexpr float LOG2E = 1.4426950408889634f, QSCALE = 0.125f * LOG2E, THR = 8.0f;
__device__ __forceinline__ int crow(int r, int hi) { return (r & 3) + 8 * (r >> 2) + 4 * hi; }
__device__ __forceinline__ void glds16(const void* gsrc, unsigned lds_dst) { unsigned keep;
    asm volatile("s_mov_b32 %0, m0\n\ts_mov_b32 m0, %2\n\ts_nop 0\n\tglobal_load_lds_dwordx4 %1, off\n\ts_mov_b32 m0, %0" : "=&s"(keep) : "v"(gsrc), "s"(lds_dst) : "memory"); }
__device__ __forceinline__ unsigned cvtpk(float lo, float hi) { typedef float f2 __attribute__((ext_vector_type(2))); typedef __bf16 b2 __attribute__((ext_vector_type(2)));
    f2 v = {lo, hi}; b2 b = __builtin_convertvector(v, b2); return __builtin_bit_cast(unsigned, b); }
__device__ __forceinline__ s16x4 vtr(lds_cptr p) { return __builtin_bit_cast(s16x4, __builtin_amdgcn_ds_read_tr16_b64_v4i16((LAS v4i16_t*)p)); }
#define ATT_MFMA(a, b, c) __builtin_amdgcn_mfma_f32_32x32x16_bf16(a, b, c, 0, 0, 0)
__device__ __forceinline__ int tile_lo(int h, int chunkA, float bound) {
    const float slope2_ = exp2f(-2.f * (float)(h + 1)) * LOG2E, dth = (2.f * bound + THR + 160.f) / slope2_; const float qmin = 64.f * (float)chunkA;
    const float cl = ceilf((qmin - 63.f - dth) * (1.f / 64.f)); int c_lo = cl > 0.f ? (int)cl : 0; if (c_lo > chunkA) c_lo = chunkA; return c_lo;
}
__device__ __forceinline__ void convert_slice(const float* __restrict__ ck, const float* __restrict__ cv, bf16* __restrict__ kc, bf16* __restrict__ vc, int h, int c_lo, int tid) {
    const int tid_o = opaque_v(tid), sub = tid_o & 15, p0 = tid_o >> 4;
    const float* sk = ck + (size_t)h * 128 + sub * 8; const float* sv = cv + (size_t)h * 128 + sub * 8; bf16* dk = kc + (size_t)h * 128 + sub * 8; bf16* dv = vc + (size_t)h * 128 + sub * 8;
#pragma unroll 4
    for (int pos = 64 * c_lo + p0; pos < PAST; pos += 32) {
        const f32x4 a0 = *(const f32x4*)(sk + (size_t)pos * 512), a1 = *(const f32x4*)(sk + (size_t)pos * 512 + 4), b0 = *(const f32x4*)(sv + (size_t)pos * 512), b1 = *(const f32x4*)(sv + (size_t)pos * 512 + 4);
        u32x4 o; o.x = pk2(a0.x, a0.y); o.y = pk2(a0.z, a0.w); o.z = pk2(a1.x, a1.y); o.w = pk2(a1.z, a1.w); *(u32x4*)(dk + (size_t)pos * 512) = o;
        o.x = pk2(b0.x, b0.y); o.y = pk2(b0.z, b0.w); o.z = pk2(b1.x, b1.y); o.w = pk2(b1.z, b1.w); *(u32x4*)(dv + (size_t)pos * 512) = o; }
    asm volatile("s_waitcnt vmcnt(0)" ::: "memory"); __syncthreads();
    if (tid == 0) { __builtin_amdgcn_fence(__ATOMIC_ACQUIRE, "agent"); asm volatile("s_waitcnt vmcnt(0)" ::: "memory"); }
    __syncthreads();
}
struct Unit { const bf16* K; const bf16* V; int qrow0, chunkA, chunkB, h, nseg, seg, pidx, pad; };
struct Tensors { const bf16* QN; bf16* MIX; const float* out_g; float* part; unsigned* segcnt; float lam, lam_init_c, bound, kmax; };

__device__ __forceinline__ void attn_unit(const Unit& u, const Tensors& T, LAS unsigned char* shm, int tid_in) {
    const int tid = opaque_v(tid_in);
    const int lane = tid & 63, r32 = lane & 31, hi = lane >> 5, wid = __builtin_amdgcn_readfirstlane(tid >> 6), g = wid & 3, mp = wid >> 2;
    const int myChunk = g < 2 ? u.chunkA : u.chunkB, c_hi = u.chunkA > u.chunkB ? u.chunkA : u.chunkB, qi = 32 * (g & 1) + r32, h = u.h;
    const bool active = myChunk >= 0;
    int c_lo = tile_lo(u.h, u.chunkA, T.bound);
    int c_top = c_hi;
    if (u.nseg == 2) { const int c_mid = c_lo + ((c_hi - c_lo) >> 1); if (u.seg == 0) c_lo = c_mid + 1; else c_top = c_mid; }
    const unsigned lds0 = (unsigned)(uintptr_t)shm;
    LAS float* wsf = (LAS float*)(shm + WS_OFF) + wid * 64;
    const float slope2 = exp2f(-2.f * (float)(h + 1)) * LOG2E;
    const bf16* ksrc = u.K + (size_t)lane * 512 + h * 128 + wid * 8;
    const bf16* vsrc = u.V + (size_t)(16 * (wid & 3) + (lane >> 2)) * 512 + h * 128 + (wid >> 2) * 32 + (lane & 3) * 8;
#define ATT_DMA(tile, slot) do { const size_t to_ = (size_t)(tile) * 64 * 512; const unsigned sb_ = lds0 + (slot) * SLOT; \
        glds16(ksrc + to_, (unsigned)__builtin_amdgcn_readfirstlane(sb_ + K_OFF + wid * 1024)); glds16(ksrc + to_ + 64, (unsigned)__builtin_amdgcn_readfirstlane(sb_ + K_OFF + 8192 + wid * 1024)); \
        glds16(vsrc + to_, (unsigned)__builtin_amdgcn_readfirstlane(sb_ + V_OFF + (wid >> 2) * 4096 + (wid & 3) * 1024)); \
        glds16(vsrc + to_ + 64, (unsigned)__builtin_amdgcn_readfirstlane(sb_ + V_OFF + ((wid >> 2) + 2) * 4096 + (wid & 3) * 1024)); } while (0)
    ATT_DMA(c_top, 0);
    bf16x8 qr[4];
#pragma unroll
    for (int d0 = 0; d0 < 4; ++d0) qr[d0] = active ? *(const bf16x8*)(T.QN + (size_t)(u.qrow0 + 32 * g + r32) * 512 + h * 128 + mp * 64 + d0 * 16 + hi * 8) : (bf16x8){0, 0, 0, 0, 0, 0, 0, 0};
#pragma unroll
    for (int d0 = 0; d0 < 4; ++d0) asm volatile("" : "+v"(qr[d0]));
    f32x16 o[4];
#pragma unroll
    for (int d = 0; d < 4; ++d) o[d] = (f32x16){0.f, 0.f, 0.f, 0.f, 0.f, 0.f, 0.f, 0.f, 0.f, 0.f, 0.f, 0.f, 0.f, 0.f, 0.f, 0.f};
    const bool fixedref = T.bound < 40.f;
    float mhat = 0.f, l_reg = 0.f; bool first = true;
    if (fixedref) { float nq = 0.f;
#pragma unroll
        for (int d0 = 0; d0 < 4; ++d0)
#pragma unroll
            for (int e = 0; e < 8; ++e) { const float v = bf2f((bf16)qr[d0][e]); nq += v * v; }
        { auto rr = __builtin_amdgcn_permlane32_swap(__float_as_uint(nq), __float_as_uint(nq), false, false); nq = __uint_as_float(rr[0]) + __uint_as_float(rr[1]); }
        mhat = sqrtf(nq) * T.kmax * 1.01f + 0.01f; first = false; }
    const lds_cptr shm3 = (lds_cptr)shm;
    const int vlane = ((lane >> 4) & 1) * 32 + (lane & 3) * 8 + (4 * hi + ((lane & 15) >> 2)) * 64;
    const int n = c_top - c_lo + 1;
    bf16x8 pa[4];
#define ATT_SGB(mask, cnt) __builtin_amdgcn_sched_group_barrier(mask, cnt, 0)
#define ATT_SB() __builtin_amdgcn_sched_barrier(0)
#define ATT_VLD(I, B) do { vlo[B] = vtr(vp_ + ((I) >> 2) * 4096 + ((I) & 3) * 1024); vhi[B] = vtr(vp_ + ((I) >> 2) * 4096 + ((I) & 3) * 1024 + 512); } while (0)
#define ATT_PV_HEAD(SL) const lds_cptr vp_ = shm3 + opaque_s((SL) * SLOT) + V_OFF + vlane; s16x4 vlo[3], vhi[3]; ATT_VLD(0, 0); ATT_VLD(1, 1)
#define ATT_PV_STEP(I) do { if ((I) + 2 < 16) ATT_VLD((I) + 2, ((I) + 2) % 3); \
            const bf16x8 vf = {vlo[(I) % 3][0], vlo[(I) % 3][1], vlo[(I) % 3][2], vlo[(I) % 3][3], vhi[(I) % 3][0], vhi[(I) % 3][1], vhi[(I) % 3][2], vhi[(I) % 3][3]}; \
            o[(I) >> 2] = ATT_MFMA(pa[(I) & 3], vf, o[(I) >> 2]); } while (0)
#define ATT_STEP_BARRIER(I) do { if ((I) + 2 < n) asm volatile("s_waitcnt vmcnt(4) lgkmcnt(0)\n\ts_barrier" ::: "memory");     \
        else asm volatile("s_waitcnt vmcnt(0) lgkmcnt(0)\n\ts_barrier" ::: "memory");     \
        if ((I) + 3 < n) ATT_DMA(c_top - ((I) + 3), ((I) + 3) & 3); } while (0)
#define ATT_PACK(P0, P1) do { typedef unsigned u4 __attribute__((ext_vector_type(4))); \
        const u4 w0 = {cvtpk(P0[0], P0[1]), cvtpk(P0[2], P0[3]), cvtpk(P0[4], P0[5]), cvtpk(P0[6], P0[7])}, w1 = {cvtpk(P0[8], P0[9]), cvtpk(P0[10], P0[11]), cvtpk(P0[12], P0[13]), cvtpk(P0[14], P0[15])}; \
        const u4 w2 = {cvtpk(P1[0], P1[1]), cvtpk(P1[2], P1[3]), cvtpk(P1[4], P1[5]), cvtpk(P1[6], P1[7])}, w3 = {cvtpk(P1[8], P1[9]), cvtpk(P1[10], P1[11]), cvtpk(P1[12], P1[13]), cvtpk(P1[14], P1[15])}; \
        pa[0] = __builtin_bit_cast(bf16x8, w0); pa[1] = __builtin_bit_cast(bf16x8, w1); pa[2] = __builtin_bit_cast(bf16x8, w2); pa[3] = __builtin_bit_cast(bf16x8, w3); } while (0)
    if (n > 1) ATT_DMA(c_top - 1, 1);
    if (n > 2) ATT_DMA(c_top - 2, 2);
    const int nslow = (!fixedref || n <= 3) ? n : ((n & 1) ? 3 : 2);
    int i = 0;
    for (; i < nslow; ++i) {
        const int c = c_top - i, slot = i & 3;
        ATT_STEP_BARRIER(i);
        if (active && c <= myChunk) {
            const lds_cptr kp = shm3 + slot * SLOT + K_OFF + mp * 8192 + hi * 1024 + r32 * 16;
            f32x16 p0, p1;
            if (c == myChunk) {
#pragma unroll
                for (int r = 0; r < 16; ++r) { const float dq_ = (float)(qi - 4 * hi) - (float)((r & 3) + 8 * (r >> 2)); p0[r] = __builtin_fmaf(-slope2, fabsf(dq_), -mhat); p1[r] = __builtin_fmaf(-slope2, fabsf(dq_ - 32.f), -mhat); }
            } else { const float base = -mhat - slope2 * (float)(64 * (myChunk - c) + qi - 4 * hi), base1 = base + 32.f * slope2;
#pragma unroll
                for (int r = 0; r < 16; ++r) { const float kc_ = (float)((r & 3) + 8 * (r >> 2)); p0[r] = __builtin_fmaf(slope2, kc_, base); p1[r] = __builtin_fmaf(slope2, kc_, base1); } }
#pragma unroll
            for (int d0 = 0; d0 < 4; ++d0) { const bf16x8 k0 = *(const LAS bf16x8*)(kp + d0 * 2048), k1 = *(const LAS bf16x8*)(kp + d0 * 2048 + 512);
                p0 = ATT_MFMA(k0, qr[d0], p0); p1 = ATT_MFMA(k1, qr[d0], p1); }
            if (!fixedref) {
            float rm = fmaxf(p0[0], p1[0]);
#pragma unroll
            for (int r = 1; r < 16; ++r) rm = fmaxf(rm, fmaxf(p0[r], p1[r]));
            { auto rr = __builtin_amdgcn_permlane32_swap(__float_as_uint(rm), __float_as_uint(rm), false, false); rm = fmaxf(__uint_as_float(rr[0]), __uint_as_float(rr[1])); }
            if (first || __any(rm > THR)) {
                const float dl = first ? rm : fmaxf(rm, 0.f); mhat += dl;
#pragma unroll
                for (int r = 0; r < 16; ++r) { p0[r] -= dl; p1[r] -= dl; }
                if (!first) { const float f = __builtin_amdgcn_exp2f(-dl); l_reg *= f; if (hi == 0) wsf[r32] = f;
                    asm volatile("s_waitcnt lgkmcnt(0)" ::: "memory");
#pragma unroll
                    for (int r = 0; r < 16; ++r) { const float fr_ = wsf[crow(r, hi)];
#pragma unroll
                        for (int d = 0; d < 4; ++d) o[d][r] *= fr_; } }
                first = false;
            }
            }
            float sacc = 0.f;
#pragma unroll
            for (int r = 0; r < 16; ++r) { p0[r] = __builtin_amdgcn_exp2f(p0[r]); p1[r] = __builtin_amdgcn_exp2f(p1[r]); sacc += p0[r] + p1[r]; }
            l_reg += sacc;
            { typedef unsigned u4 __attribute__((ext_vector_type(4)));
              u4 w0 = {cvtpk(p0[0], p0[1]), cvtpk(p0[2], p0[3]), cvtpk(p0[4], p0[5]), cvtpk(p0[6], p0[7])}, w1 = {cvtpk(p0[8], p0[9]), cvtpk(p0[10], p0[11]), cvtpk(p0[12], p0[13]), cvtpk(p0[14], p0[15])};
              u4 w2 = {cvtpk(p1[0], p1[1]), cvtpk(p1[2], p1[3]), cvtpk(p1[4], p1[5]), cvtpk(p1[6], p1[7])}, w3 = {cvtpk(p1[8], p1[9]), cvtpk(p1[10], p1[11]), cvtpk(p1[12], p1[13]), cvtpk(p1[14], p1[15])};
              pa[0] = __builtin_bit_cast(bf16x8, w0); pa[1] = __builtin_bit_cast(bf16x8, w1); pa[2] = __builtin_bit_cast(bf16x8, w2); pa[3] = __builtin_bit_cast(bf16x8, w3); }
            { ATT_PV_HEAD(slot);
#pragma unroll
              for (int i_ = 0; i_ < 16; ++i_) { ATT_PV_STEP(i_); __builtin_amdgcn_sched_barrier(0); } }
        }
    }
    if (nslow < n) {
        f32x16 a0, a1, b0, b1;
        const float bq = -mhat - slope2 * (float)(64 * myChunk + qi - 4 * hi);
#define ATT_CINIT(P0, P1, CC) do { const float base_ = bq + slope2 * (float)(64 * (CC)), base1_ = base_ + 32.f * slope2; \
        _Pragma("unroll") for (int r = 0; r < 16; ++r) { const float kc_ = (float)((r & 3) + 8 * (r >> 2)); P0[r] = __builtin_fmaf(slope2, kc_, base_); P1[r] = __builtin_fmaf(slope2, kc_, base1_); } } while (0)
#define ATT_QK(P0, P1, SL) do { const lds_cptr kp_ = shm3 + opaque_s((SL) * SLOT) + K_OFF + mp * 8192 + hi * 1024 + r32 * 16; bf16x8 kfa[4], kfb[4]; \
        _Pragma("unroll") for (int d0 = 0; d0 < 4; ++d0) { kfa[d0] = *(const LAS bf16x8*)(kp_ + d0 * 2048); kfb[d0] = *(const LAS bf16x8*)(kp_ + d0 * 2048 + 512); } \
        _Pragma("unroll") for (int d0 = 0; d0 < 4; ++d0) { P0 = ATT_MFMA(kfa[d0], qr[d0], P0); P1 = ATT_MFMA(kfb[d0], qr[d0], P1); } } while (0)
#define ATT_EXP(P0, P1) do { _Pragma("unroll") for (int r = 0; r < 16; ++r) { P0[r] = __builtin_amdgcn_exp2f(P0[r]); P1[r] = __builtin_amdgcn_exp2f(P1[r]); } } while (0)
#define ATT_ROWSUM(P0, P1) do { float s0_ = 0.f, s1_ = 0.f; _Pragma("unroll") for (int r = 0; r < 16; ++r) { s0_ += P0[r]; s1_ += P1[r]; } l_reg += s0_ + s1_; } while (0)
#define ATT_PIN(x) asm volatile("" : "+v"(x))
#define ATT_FAST_STEP(I, PU0, PU1, WU0, WU1) do { ATT_STEP_BARRIER(I); if (active) { \
            const lds_cptr kp_ = shm3 + opaque_s((((I) + 1) & 3) * SLOT) + K_OFF + mp * 8192 + hi * 1024 + r32 * 16; bf16x8 kf[8]; \
            _Pragma("unroll") for (int d0 = 0; d0 < 4; ++d0) { kf[2 * d0] = *(const LAS bf16x8*)(kp_ + d0 * 2048); kf[2 * d0 + 1] = *(const LAS bf16x8*)(kp_ + d0 * 2048 + 512); } \
            float s0_ = 0.f, s1_ = 0.f; typedef unsigned u4_ __attribute__((ext_vector_type(4))); u4_ pw0, pw1, pw2, pw3; ATT_SB(); \
            WU0 = ATT_MFMA(kf[0], qr[0], WU0); s0_ += PU0[0]; s1_ += PU0[1]; s0_ += PU0[2]; s1_ += PU0[3]; pw0[0] = cvtpk(PU0[0], PU0[1]); pw0[1] = cvtpk(PU0[2], PU0[3]); ATT_PIN(s0_); ATT_PIN(s1_); ATT_PIN(pw0); ATT_SB(); \
            WU1 = ATT_MFMA(kf[1], qr[0], WU1); s0_ += PU0[4]; s1_ += PU0[5]; s0_ += PU0[6]; s1_ += PU0[7]; pw0[2] = cvtpk(PU0[4], PU0[5]); pw0[3] = cvtpk(PU0[6], PU0[7]); ATT_PIN(s0_); ATT_PIN(s1_); ATT_PIN(pw0); ATT_SB(); \
            WU0 = ATT_MFMA(kf[2], qr[1], WU0); s0_ += PU0[8]; s1_ += PU0[9]; s0_ += PU0[10]; s1_ += PU0[11]; pw1[0] = cvtpk(PU0[8], PU0[9]); pw1[1] = cvtpk(PU0[10], PU0[11]); ATT_PIN(s0_); ATT_PIN(s1_); ATT_PIN(pw1); ATT_SB(); \
            WU1 = ATT_MFMA(kf[3], qr[1], WU1); s0_ += PU0[12]; s1_ += PU0[13]; s0_ += PU0[14]; s1_ += PU0[15]; pw1[2] = cvtpk(PU0[12], PU0[13]); pw1[3] = cvtpk(PU0[14], PU0[15]); ATT_PIN(s0_); ATT_PIN(s1_); ATT_PIN(pw1); ATT_SB(); \
            WU0 = ATT_MFMA(kf[4], qr[2], WU0); s0_ += PU1[0]; s1_ += PU1[1]; s0_ += PU1[2]; s1_ += PU1[3]; pw2[0] = cvtpk(PU1[0], PU1[1]); pw2[1] = cvtpk(PU1[2], PU1[3]); ATT_PIN(s0_); ATT_PIN(s1_); ATT_PIN(pw2); ATT_SB(); \
            WU1 = ATT_MFMA(kf[5], qr[2], WU1); s0_ += PU1[4]; s1_ += PU1[5]; s0_ += PU1[6]; s1_ += PU1[7]; pw2[2] = cvtpk(PU1[4], PU1[5]); pw2[3] = cvtpk(PU1[6], PU1[7]); ATT_PIN(s0_); ATT_PIN(s1_); ATT_PIN(pw2); ATT_SB(); \
            WU0 = ATT_MFMA(kf[6], qr[3], WU0); s0_ += PU1[8]; s1_ += PU1[9]; s0_ += PU1[10]; s1_ += PU1[11]; pw3[0] = cvtpk(PU1[8], PU1[9]); pw3[1] = cvtpk(PU1[10], PU1[11]); ATT_PIN(s0_); ATT_PIN(s1_); ATT_PIN(pw3); ATT_SB(); \
            WU1 = ATT_MFMA(kf[7], qr[3], WU1); s0_ += PU1[12]; s1_ += PU1[13]; s0_ += PU1[14]; s1_ += PU1[15]; pw3[2] = cvtpk(PU1[12], PU1[13]); pw3[3] = cvtpk(PU1[14], PU1[15]); ATT_PIN(s0_); ATT_PIN(s1_); ATT_PIN(pw3); ATT_SB(); \
            l_reg += s0_ + s1_; pa[0] = __builtin_bit_cast(bf16x8, pw0); pa[1] = __builtin_bit_cast(bf16x8, pw1); pa[2] = __builtin_bit_cast(bf16x8, pw2); pa[3] = __builtin_bit_cast(bf16x8, pw3); \
            const float cb_ = bq + slope2 * (float)(64 * (c_top - ((I) + 2))), cb1_ = cb_ + 32.f * slope2; \
            ATT_PV_HEAD((I) & 3); ATT_SB(); \
            ATT_PV_STEP(0); WU0[0] = __builtin_amdgcn_exp2f(WU0[0]); WU0[1] = __builtin_amdgcn_exp2f(WU0[1]); PU0[0] = __builtin_fmaf(slope2, 0.f, cb_); PU0[1] = __builtin_fmaf(slope2, 1.f, cb_); ATT_PIN(WU0); ATT_PIN(PU0); ATT_SB(); \
            ATT_PV_STEP(1); WU0[2] = __builtin_amdgcn_exp2f(WU0[2]); WU0[3] = __builtin_amdgcn_exp2f(WU0[3]); PU0[2] = __builtin_fmaf(slope2, 2.f, cb_); PU0[3] = __builtin_fmaf(slope2, 3.f, cb_); ATT_PIN(WU0); ATT_PIN(PU0); ATT_SB(); \
            ATT_PV_STEP(2); WU0[4] = __builtin_amdgcn_exp2f(WU0[4]); WU0[5] = __builtin_amdgcn_exp2f(WU0[5]); PU0[4] = __builtin_fmaf(slope2, 8.f, cb_); PU0[5] = __builtin_fmaf(slope2, 9.f, cb_); ATT_PIN(WU0); ATT_PIN(PU0); ATT_SB(); \
            ATT_PV_STEP(3); WU0[6] = __builtin_amdgcn_exp2f(WU0[6]); WU0[7] = __builtin_amdgcn_exp2f(WU0[7]); PU0[6] = __builtin_fmaf(slope2, 10.f, cb_); PU0[7] = __builtin_fmaf(slope2, 11.f, cb_); ATT_PIN(WU0); ATT_PIN(PU0); ATT_SB(); \
            ATT_PV_STEP(4); WU0[8] = __builtin_amdgcn_exp2f(WU0[8]); WU0[9] = __builtin_amdgcn_exp2f(WU0[9]); PU0[8] = __builtin_fmaf(slope2, 16.f, cb_); PU0[9] = __builtin_fmaf(slope2, 17.f, cb_); ATT_PIN(WU0); ATT_PIN(PU0); ATT_SB(); \
            ATT_PV_STEP(5); WU0[10] = __builtin_amdgcn_exp2f(WU0[10]); WU0[11] = __builtin_amdgcn_exp2f(WU0[11]); PU0[10] = __builtin_fmaf(slope2, 18.f, cb_); PU0[11] = __builtin_fmaf(slope2, 19.f, cb_); ATT_PIN(WU0); ATT_PIN(PU0); ATT_SB(); \
            ATT_PV_STEP(6); WU0[12] = __builtin_amdgcn_exp2f(WU0[12]); WU0[13] = __builtin_amdgcn_exp2f(WU0[13]); PU0[12] = __builtin_fmaf(slope2, 24.f, cb_); PU0[13] = __builtin_fmaf(slope2, 25.f, cb_); ATT_PIN(WU0); ATT_PIN(PU0); ATT_SB(); \
            ATT_PV_STEP(7); WU0[14] = __builtin_amdgcn_exp2f(WU0[14]); WU0[15] = __builtin_amdgcn_exp2f(WU0[15]); PU0[14] = __builtin_fmaf(slope2, 26.f, cb_); PU0[15] = __builtin_fmaf(slope2, 27.f, cb_); ATT_PIN(WU0); ATT_PIN(PU0); ATT_SB(); \
            ATT_PV_STEP(8); WU1[0] = __builtin_amdgcn_exp2f(WU1[0]); WU1[1] = __builtin_amdgcn_exp2f(WU1[1]); PU1[0] = __builtin_fmaf(slope2, 0.f, cb1_); PU1[1] = __builtin_fmaf(slope2, 1.f, cb1_); ATT_PIN(WU1); ATT_PIN(PU1); ATT_SB(); \
            ATT_PV_STEP(9); WU1[2] = __builtin_amdgcn_exp2f(WU1[2]); WU1[3] = __builtin_amdgcn_exp2f(WU1[3]); PU1[2] = __builtin_fmaf(slope2, 2.f, cb1_); PU1[3] = __builtin_fmaf(slope2, 3.f, cb1_); ATT_PIN(WU1); ATT_PIN(PU1); ATT_SB(); \
            ATT_PV_STEP(10); WU1[4] = __builtin_amdgcn_exp2f(WU1[4]); WU1[5] = __builtin_amdgcn_exp2f(WU1[5]); PU1[4] = __builtin_fmaf(slope2, 8.f, cb1_); PU1[5] = __builtin_fmaf(slope2, 9.f, cb1_); ATT_PIN(WU1); ATT_PIN(PU1); ATT_SB(); \
            ATT_PV_STEP(11); WU1[6] = __builtin_amdgcn_exp2f(WU1[6]); WU1[7] = __builtin_amdgcn_exp2f(WU1[7]); PU1[6] = __builtin_fmaf(slope2, 10.f, cb1_); PU1[7] = __builtin_fmaf(slope2, 11.f, cb1_); ATT_PIN(WU1); ATT_PIN(PU1); ATT_SB(); \
            ATT_PV_STEP(12); WU1[8] = __builtin_amdgcn_exp2f(WU1[8]); WU1[9] = __builtin_amdgcn_exp2f(WU1[9]); PU1[8] = __builtin_fmaf(slope2, 16.f, cb1_); PU1[9] = __builtin_fmaf(slope2, 17.f, cb1_); ATT_PIN(WU1); ATT_PIN(PU1); ATT_SB(); \
            ATT_PV_STEP(13); WU1[10] = __builtin_amdgcn_exp2f(WU1[10]); WU1[11] = __builtin_amdgcn_exp2f(WU1[11]); PU1[10] = __builtin_fmaf(slope2, 18.f, cb1_); PU1[11] = __builtin_fmaf(slope2, 19.f, cb1_); ATT_PIN(WU1); ATT_PIN(PU1); ATT_SB(); \
            ATT_PV_STEP(14); WU1[12] = __builtin_amdgcn_exp2f(WU1[12]); WU1[13] = __builtin_amdgcn_exp2f(WU1[13]); PU1[12] = __builtin_fmaf(slope2, 24.f, cb1_); PU1[13] = __builtin_fmaf(slope2, 25.f, cb1_); ATT_PIN(WU1); ATT_PIN(PU1); ATT_SB(); \
            ATT_PV_STEP(15); WU1[14] = __builtin_amdgcn_exp2f(WU1[14]); WU1[15] = __builtin_amdgcn_exp2f(WU1[15]); PU1[14] = __builtin_fmaf(slope2, 26.f, cb1_); PU1[15] = __builtin_fmaf(slope2, 27.f, cb1_); ATT_PIN(WU1); ATT_PIN(PU1); ATT_SB(); \
        } } while (0)
        if (active) { ATT_CINIT(a0, a1, c_top - i); ATT_QK(a0, a1, i & 3); ATT_EXP(a0, a1); ATT_CINIT(b0, b1, c_top - (i + 1)); }
        ATT_FAST_STEP(i, a0, a1, b0, b1); ++i;
        for (; i + 1 < n; ) { ATT_FAST_STEP(i, b0, b1, a0, a1); ++i; ATT_FAST_STEP(i, a0, a1, b0, b1); ++i; }
        ATT_STEP_BARRIER(i);
        if (active) { ATT_ROWSUM(b0, b1); ATT_PACK(b0, b1);
            { ATT_PV_HEAD(i & 3);
#pragma unroll
              for (int i_ = 0; i_ < 16; ++i_) { ATT_PV_STEP(i_); __builtin_amdgcn_sched_barrier(0); } } }
#undef ATT_FAST_STEP
#undef ATT_PIN
#undef ATT_ROWSUM
#undef ATT_EXP
#undef ATT_QK
#undef ATT_CINIT
    }
#undef ATT_PACK
#undef ATT_STEP_BARRIER
#undef ATT_PV_STEP
#undef ATT_PV_HEAD
#undef ATT_VLD
#undef ATT_SGB
#undef ATT_SB
    { auto rr = __builtin_amdgcn_permlane32_swap(__float_as_uint(l_reg), __float_as_uint(l_reg), false, false); l_reg = __uint_as_float(rr[0]) + __uint_as_float(rr[1]); }
    if (u.nseg == 2) {
        if (first) mhat = -1e30f;
        float* pb = T.part + (size_t)(u.pidx * 2 + u.seg) * PART_FLOATS;
#pragma unroll
        for (int r = 0; r < 16; ++r)
#pragma unroll
            for (int dq = 0; dq < 4; ++dq) pb[(unsigned)(((wid * 16 + r) * 4 + dq) * 64 + lane)] = o[dq][r];
        pb[(unsigned)(32768 + wid * 128 + lane)] = mhat; pb[(unsigned)(32768 + wid * 128 + 64 + lane)] = l_reg;
        volatile LAS unsigned* sw = (volatile LAS unsigned*)(shm + WS_OFF + 8 * 256);
        asm volatile("s_waitcnt vmcnt(0)" ::: "memory"); __syncthreads();
        if (tid == 0) { __builtin_amdgcn_fence(__ATOMIC_RELEASE, "agent"); asm volatile("s_waitcnt vmcnt(0)" ::: "memory");
            sw[0] = __hip_atomic_fetch_add(T.segcnt + 64 * u.pidx, 1u, __ATOMIC_RELAXED, __HIP_MEMORY_SCOPE_AGENT); }
        __syncthreads();
        const bool last = sw[0] == 1u;
        __syncthreads();
        if (!last) return;
        if (tid == 0) { __builtin_amdgcn_fence(__ATOMIC_ACQUIRE, "agent"); asm volatile("s_waitcnt vmcnt(0)" ::: "memory"); }
        __syncthreads();
        const float* ob = T.part + (size_t)(u.pidx * 2 + (1 - u.seg)) * PART_FLOATS;
        const float m_o = ob[(unsigned)(32768 + wid * 128 + lane)], l_o = ob[(unsigned)(32768 + wid * 128 + 64 + lane)];
        const float M = fmaxf(mhat, m_o), fs = __builtin_amdgcn_exp2f(mhat - M), fo = __builtin_amdgcn_exp2f(m_o - M);
        l_reg = l_reg * fs + l_o * fo; mhat = M;
        if (hi == 0) { wsf[r32] = fs; wsf[32 + r32] = fo; }
        asm volatile("s_waitcnt lgkmcnt(0)" ::: "memory");
#pragma unroll
        for (int r = 0; r < 16; ++r) { const float a_ = wsf[crow(r, hi)], b_ = wsf[32 + crow(r, hi)];
#pragma unroll
            for (int dq = 0; dq < 4; ++dq) o[dq][r] = o[dq][r] * a_ + ob[(unsigned)(((wid * 16 + r) * 4 + dq) * 64 + lane)] * b_; }
        asm volatile("s_waitcnt lgkmcnt(0)" ::: "memory");
    }
    if (hi == 0) wsf[32 + r32] = active ? 1.0f / l_reg : 0.f;
    asm volatile("s_waitcnt lgkmcnt(0)\n\ts_barrier" ::: "memory");
    float rli[16];
#pragma unroll
    for (int r = 0; r < 16; ++r) rli[r] = wsf[32 + crow(r, hi)];
    LAS float* stg = (LAS float*)shm + g * 32 * 128;
    if (mp == 1) {
#pragma unroll
        for (int r = 0; r < 16; ++r)
#pragma unroll
            for (int dq = 0; dq < 4; ++dq) stg[crow(r, hi) * 128 + dq * 32 + r32] = T.lam * o[dq][r] * rli[r];
    }
    asm volatile("s_waitcnt lgkmcnt(0)\n\ts_barrier" ::: "memory");
    if (mp == 0 && active) {
        float gn[4];
#pragma unroll
        for (int dq = 0; dq < 4; ++dq) gn[dq] = T.out_g[dq * 32 + r32] * T.lam_init_c;
#pragma unroll
        for (int r = 0; r < 16; ++r) { float ss = 0.f;
#pragma unroll
            for (int dq = 0; dq < 4; ++dq) { const float v = o[dq][r] * rli[r] - stg[crow(r, hi) * 128 + dq * 32 + r32]; o[dq][r] = v; ss += v * v; }
            ss = half_sum(ss);
            const float rn = 1.0f / sqrtf(ss * (1.f / 128.f) + EPS);
            bf16* mrow = T.MIX + (size_t)(u.qrow0 + 32 * g + crow(r, hi)) * DM + 1024 + h * 128 + r32;
#pragma unroll
            for (int dq = 0; dq < 4; ++dq) mrow[dq * 32] = (bf16)f2bf(o[dq][r] * rn * gn[dq]); }
    }
    asm volatile("s_waitcnt lgkmcnt(0)\n\ts_barrier" ::: "memory");
#undef ATT_DMA
}
}
constexpr int ATT_NITEMS = 800, ATT_NSPLIT = 160;
__device__ const unsigned att_items[ATT_NITEMS] = {1305598,1309694,1297398,1301494,1289198,1293294,1280998,1285094,1272798,1276894,1264598,1268694,1256398,1260494,1248198,1252294,1239998,1244094,1231798,1235894,1223598,1227694,1215398,1219494,1207198,1211294,1198998,1203094,1190798,1194894,1182598,1186694,1174398,1178494,1166198,1170294,1157998,1162094,1149798,1153894,1141598,1145694,1133398,1137494,1125198,1129294,1116998,1121094,1108798,1112894,1100598,1104694,1092398,1096494,1084198,1088294,1075998,1080094,1067798,1071894,1059598,1063694,1051398,1055494,380,382,1043198,1047294,1034998,1039094,372,374,1026798,1030894,1018598,1022694,364,366,1010398,1014494,1002198,1006294,356,358,993998,998094,985798,989894,348,350,977598,981694,969398,973494,340,342,961198,965294,952998,957094,332,334,944798,948894,936598,940694,324,326,928398,932494,920198,924294,316,318,911998,916094,903798,907894,308,310,895598,899694,887398,891494,300,302,879198,883294,870998,875094,292,294,862798,866894,854598,858694,284,286,846398,850494,838198,842294,276,278,829998,834094,821798,825894,166436,170532,174636,178732,182836,186932,191036,195132,199236,203332,207436,211532,215636,219732,223836,227932,232036,236132,240236,244332,248436,252532,256636,260732,264836,268932,273036,277132,281236,285332,289436,293532,297636,301732,305836,309932,314036,318132,322236,326332,330436,334532,338636,342732,346836,350932,355036,359132,363236,367332,371436,375532,379636,383732,387836,391932,396036,400132,404236,408332,412436,416532,420636,424732,428836,432932,437036,441132,445236,449332,453436,457532,461636,465732,469836,473932,478036,482132,486236,490332,494436,498532,502636,506732,510836,514932,519036,523132,527236,531332,535436,539532,543636,547732,551836,555932,560036,564132,568236,572332,576436,580532,584636,588732,592836,596932,601036,605132,609236,613332,617436,621532,625636,629732,633836,637932,642036,646132,650236,654332,268,158236,162332,270,813598,817694,150036,154132,805398,809494,260,141836,145932,262,797198,801294,133636,137732,788998,793094,252,125436,129532,254,780798,784894,117236,121332,772598,776694,244,109036,113132,246,764398,768494,100836,104932,756198,760294,236,92636,96732,238,747998,752094,84436,88532,739798,743894,228,76236,80332,230,731598,735694,68036,72132,723398,727494,220,59836,63932,222,715198,719294,51636,55732,706998,711094,212,43436,47532,214,698798,702894,35236,39332,690598,694694,204,27036,31132,206,682398,686494,18836,22932,674198,678294,196,10636,14732,198,665998,670094,2436,6532,657798,661894,188,190,180,182,172,174,164,166,156,158,148,150,138,146,154,162,170,178,186,194,202,210,218,226,234,242,250,258,266,274,282,290,298,306,314,322,330,338,346,354,362,370,378,386,394,402,410,418,426,434,442,450,458,466,474,482,490,498,506,514,522,530,538,546,554,562,570,578,586,594,602,610,618,626,634,642,650,658,666,674,682,690,698,706,714,722,730,738,746,754,762,770,778,786,794,802,810,818,826,834,842,850,858,866,874,882,890,898,906,914,922,930,938,946,954,962,970,978,986,994,1002,1010,1018,140,142,130,132,134,122,124,126,114,116,118,106,108,110,3,5,7,11,13,15,19,21,23,27,29,31,35,37,39,43,45,47,51,53,55,59,61,63,67,69,71,75,77,79,83,85,87,91,93,95,99,101,103,107,109,111,115,117,119,123,125,127,131,133,135,139,141,143,147,149,151,155,157,159,163,165,167,171,173,175,179,181,183,187,189,191,195,197,199,203,205,207,211,213,215,219,221,223,227,229,231,235,237,239,243,245,247,251,253,255,98,100,102,90,92,94,82,84,86,74,76,78,66,68,70,58,60,62,50,52,54,42,44,46,40,48,56,64,72,80,88,96,104,112,120,128,136,144,152,160,168,176,184,192,200,208,216,224,232,240,248,256,264,272,280,288,296,304,312,320,328,336,344,352,360,368,376,384,392,400,408,416,424,432,440,448,456,464,472,480,488,496,504,512,520,528,536,544,552,560,568,576,584,592,600,608,616,624,632,640,648,656,664,672,680,688,696,704,712,720,728,736,744,752,760,768,776,784,792,800,808,816,824,832,840,848,856,864,872,880,888,896,904,912,920,928,936,944,952,960,968,976,984,992,1000,1008,1016,32,34,36,38,24,26,28,30,1,9,17,25,33,41,49,57,65,73,81,89,97,105,113,121,129,137,145,153,161,169,177,185,193,201,209,217,225,233,241,249,16,18,20,22,8,10,12,14,0,2,4,6};
namespace ssdc {
using att::bf16x8; using att::s16x4; using att::f32x16; using att::lds_cptr; using att::vtr; using att::cvtpk; using att::crow;
constexpr int L_XS = 0, L_B = 65536, L_C = 81920, L_DT = 98304, L_CS = 100352, L_RED = 102400, L_ECS = 104448, L_RDT = 106496, LDS_NEED = 108544;
struct Args { const bf16* proj; const float* dtga; const float* dt_bias; const float* conv_state; const float* conv_w; const float* conv_b; const float* a_log; const float* dpar; const float* norm_g;
              bf16* states; float* decay; const bf16* hin; bf16* mix; int layer, pad; };
__device__ __forceinline__ void conv8(const Args& a, const bf16* pbase  , int s, int t, bool isS, int b, int col, const float (&w)[4][8], const float (&bias)[8], float (&y)[8]) {
#pragma unroll
    for (int e = 0; e < 8; ++e) y[e] = bias[e];
    if (!isS) {
        bf16x8 v[4];
#pragma unroll
        for (int j = 0; j < 4; ++j) v[j] = *(const bf16x8*)(pbase + (unsigned)(((t - 3 + j) >= 0 ? s + j : 3) * NPJ + col));
#pragma unroll
        for (int j = 0; j < 4; ++j) { const float m = (t - 3 + j) >= 0 ? 1.f : 0.f;
#pragma unroll
            for (int e = 0; e < 8; ++e) y[e] += (bf2f((bf16)v[j][e]) * m) * w[j][e]; }
#pragma unroll
        for (int e = 0; e < 8; ++e) y[e] = silu_f(y[e]);
        return; }
#pragma unroll
    for (int j = 0; j < 4; ++j) { const int tt = t - 3 + j; float u[8];
        if (tt >= 0) { const bf16x8 v = *(const bf16x8*)(pbase + (unsigned)((s + j) * NPJ + col));
#pragma unroll
            for (int e = 0; e < 8; ++e) u[e] = bf2f((bf16)v[e]); }
        else if (isS) { const float* cs = a.conv_state + ((size_t)(a.layer * DB + b) * 3 + (3 + tt)) * CONV_DIM + col;
#pragma unroll
            for (int e = 0; e < 8; ++e) u[e] = cs[e]; }
        else {
#pragma unroll
            for (int e = 0; e < 8; ++e) u[e] = 0.f; }
#pragma unroll
        for (int e = 0; e < 8; ++e) y[e] += u[e] * w[j][e]; }
#pragma unroll
    for (int e = 0; e < 8; ++e) y[e] = silu_f(y[e]);
}
__device__ __forceinline__ void conv8_load(const bf16* pbase, int s, int t, int col, bf16x8 (&v)[4]) {
#pragma unroll
    for (int j = 0; j < 4; ++j) v[j] = *(const bf16x8*)(pbase + (unsigned)(((t - 3 + j) >= 0 ? s + j : 3) * NPJ + col));
}
__device__ __forceinline__ void conv8_calc(const bf16x8 (&v)[4], int t, const float (&w)[4][8], const float (&bias)[8], float (&y)[8]) {
#pragma unroll
    for (int e = 0; e < 8; ++e) y[e] = bias[e];
#pragma unroll
    for (int j = 0; j < 4; ++j) { const float m = (t - 3 + j) >= 0 ? 1.f : 0.f;
#pragma unroll
        for (int e = 0; e < 8; ++e) y[e] += (bf2f((bf16)v[j][e]) * m) * w[j][e]; }
#pragma unroll
    for (int e = 0; e < 8; ++e) y[e] = silu_f(y[e]);
}
__device__ __forceinline__ void load_w8(const Args& a, int col, float (&w)[4][8], float (&bias)[8]) {
#pragma unroll
    for (int j = 0; j < 4; ++j)
#pragma unroll
        for (int e = 0; e < 8; ++e) w[j][e] = a.conv_w[(size_t)(a.layer * 4 + j) * CONV_DIM + col + e];
#pragma unroll
    for (int e = 0; e < 8; ++e) bias[e] = a.conv_b[(size_t)a.layer * CONV_DIM + col + e];
}
__device__ __forceinline__ u32x4 pack8(const float (&y)[8]) { u32x4 o; o.x = pk2(y[0], y[1]); o.y = pk2(y[2], y[3]); o.z = pk2(y[4], y[5]); o.w = pk2(y[6], y[7]); return o; }
template <bool PRE> __device__ __forceinline__ void stage_s(const Args& a, int chunk, int g, LAS unsigned char* shm, int tid_) {
    int tid = opaque_v(tid_);
    const bool isS = chunk >= SEQ / 64; const int b = isS ? chunk - SEQ / 64 : 0, row0 = chunk * 64, t0 = isS ? 0 : row0;
    LAS float* dtab = (LAS float*)(shm + L_DT); LAS float* cstab = (LAS float*)(shm + L_CS);
    const bf16* pbase = a.proj + ((long)row0 - 3) * NPJ + C_XBC;
    { const int s = tid >> 3, h8 = tid & 7; dtab[s * 8 + h8] = softplus_f(a.dtga[(size_t)(row0 + s) * 32 + g * 8 + h8] + a.dt_bias[a.layer * 16 + g * 8 + h8]); }
    __syncthreads();
    { const int w = __builtin_amdgcn_readfirstlane(tid >> 6), ln = tid & 63;
      const float A = -__expf(a.a_log[a.layer * 16 + g * 8 + w]); const float dtv = dtab[ln * 8 + w]; float v = dtv * A;
#pragma unroll
      for (int d = 1; d < 64; d <<= 1) { const float t2 = __builtin_bit_cast(float, __builtin_amdgcn_ds_bpermute(((ln - d) & 63) << 2, __builtin_bit_cast(int, v))); if (ln >= d) v += t2; }
      cstab[ln * 8 + w] = v;
      const float vend = __builtin_bit_cast(float, __builtin_amdgcn_readlane(__builtin_bit_cast(int, v), 63));
      ((LAS float*)(shm + L_ECS))[ln * 8 + w] = PRE ? dtv * __expf(vend - v) : __expf(v);
      ((LAS float*)(shm + L_RDT))[ln * 8 + w] = __builtin_amdgcn_rcpf(dtv); }
    __syncthreads();
    tid = opaque_v(tid);
    { const int cg = tid & 63, col = g * 512 + cg * 8, h8 = cg >> 3; float w[4][8], bias[8]; load_w8(a, col, w, bias);
      if (!isS) {
#pragma unroll 1
          for (int ib = 0; ib < 2; ++ib) { bf16x8 v[4][4];
#pragma unroll
              for (int i = 0; i < 4; ++i) { const int s = (tid >> 6) + 8 * (4 * ib + i); conv8_load(pbase, s, t0 + s, col, v[i]); }
#pragma unroll
              for (int i = 0; i < 4; ++i) { const int s = (tid >> 6) + 8 * (4 * ib + i); float y[8]; conv8_calc(v[i], t0 + s, w, bias, y);
                  const float f = PRE ? ((LAS float*)(shm + L_ECS))[s * 8 + h8] : dtab[s * 8 + h8];
#pragma unroll
                  for (int e = 0; e < 8; ++e) y[e] *= f;
                  *(LAS u32x4*)(shm + L_XS + h8 * 8192 + ((cg & 7) >> 2) * 4096 + s * 64 + (cg & 3) * 16) = pack8(y); } } }
      else {
#pragma unroll 2
      for (int i = 0; i < 8; ++i) { const int s = (tid >> 6) + 8 * i; float y[8]; conv8(a, pbase, s, t0 + s, isS, b, col, w, bias, y);
          const float f = PRE ? ((LAS float*)(shm + L_ECS))[s * 8 + h8] : dtab[s * 8 + h8];
#pragma unroll
          for (int e = 0; e < 8; ++e) y[e] *= f;
          *(LAS u32x4*)(shm + L_XS + h8 * 8192 + ((cg & 7) >> 2) * 4096 + s * 64 + (cg & 3) * 16) = pack8(y); } } }
    tid = opaque_v(tid);
    { const int cg = tid & 15, colB = 1024 + g * 128 + cg * 8; float w[4][8], bias[8]; load_w8(a, colB, w, bias);
#pragma unroll
      for (int i = 0; i < 2; ++i) { const int s = (tid >> 4) + 32 * i; float y[8]; conv8(a, pbase, s, t0 + s, isS, b, colB, w, bias, y);
          if (PRE) *(LAS u32x4*)(shm + L_B + (cg >> 2) * 4096 + s * 64 + (cg & 3) * 16) = pack8(y);
          else     *(LAS u32x4*)(shm + L_B + cg * 1024 + s * 16) = pack8(y); } }
    tid = opaque_v(tid);
    if (!PRE) { const int cg = tid & 15, colC = 1280 + g * 128 + cg * 8; float w[4][8], bias[8]; load_w8(a, colC, w, bias);
#pragma unroll
      for (int i = 0; i < 2; ++i) { const int s = (tid >> 4) + 32 * i; float y[8]; conv8(a, pbase, s, t0 + s, isS, b, colC, w, bias, y);
          *(LAS u32x4*)(shm + L_C + cg * 1024 + s * 16) = pack8(y); } }
    __syncthreads();
}
template <bool PRE> __device__ __forceinline__ void stage_p(const Args& a, int chunk, int g, LAS unsigned char* shm, int tid_) {
    const int tid = opaque_v(tid_); const int row0 = chunk * 64, t0 = row0;
    LAS float* dtab = (LAS float*)(shm + L_DT); LAS float* cstab = (LAS float*)(shm + L_CS);
    const bf16* pbase = a.proj + ((long)row0 - 3) * NPJ + C_XBC;
    const float dt_raw = a.dtga[(size_t)(row0 + (tid >> 3)) * 32 + g * 8 + (tid & 7)], dt_b = a.dt_bias[a.layer * 16 + g * 8 + (tid & 7)];
    const float a_l = a.a_log[a.layer * 16 + g * 8 + __builtin_amdgcn_readfirstlane(tid >> 6)];
    const int cgx = tid & 63, colx = g * 512 + cgx * 8, h8 = cgx >> 3, wv = tid >> 6; float wx[4][8], bx[8]; load_w8(a, colx, wx, bx);
    bf16x8 vx[4][4];
#pragma unroll
    for (int i = 0; i < 4; ++i) { const int s = wv + 8 * i; conv8_load(pbase, s, t0 + s, colx, vx[i]); }
    const int cgb = tid & 15, colB = 1024 + g * 128 + cgb * 8, sb0 = tid >> 4; float wB[4][8], bB[8]; load_w8(a, colB, wB, bB);
    bf16x8 vB[2][4];
#pragma unroll
    for (int i = 0; i < 2; ++i) { const int s = sb0 + 32 * i; conv8_load(pbase, s, t0 + s, colB, vB[i]); }
    { const int s = tid >> 3, hh = tid & 7; dtab[s * 8 + hh] = softplus_f(dt_raw + dt_b); }
    lds_barrier();
    { const int w = __builtin_amdgcn_readfirstlane(tid >> 6), ln = tid & 63;
      const float A = -__expf(a_l); const float dtv = dtab[ln * 8 + w]; float v = dtv * A;
#pragma unroll
      for (int d = 1; d < 64; d <<= 1) { const float t2 = __builtin_bit_cast(float, __builtin_amdgcn_ds_bpermute(((ln - d) & 63) << 2, __builtin_bit_cast(int, v))); if (ln >= d) v += t2; }
      cstab[ln * 8 + w] = v;
      const float vend = __builtin_bit_cast(float, __builtin_amdgcn_readlane(__builtin_bit_cast(int, v), 63));
      ((LAS float*)(shm + L_ECS))[ln * 8 + w] = PRE ? dtv * __expf(vend - v) : __expf(v);
      ((LAS float*)(shm + L_RDT))[ln * 8 + w] = __builtin_amdgcn_rcpf(dtv); }
    lds_barrier();
#pragma unroll
    for (int i = 0; i < 4; ++i) { const int s = wv + 8 * i; float y[8]; conv8_calc(vx[i], t0 + s, wx, bx, y);
        const float f = PRE ? ((LAS float*)(shm + L_ECS))[s * 8 + h8] : dtab[s * 8 + h8];
#pragma unroll
        for (int e = 0; e < 8; ++e) y[e] *= f;
        *(LAS u32x4*)(shm + L_XS + h8 * 8192 + ((cgx & 7) >> 2) * 4096 + s * 64 + (cgx & 3) * 16) = pack8(y); }
#pragma unroll
    for (int i = 0; i < 4; ++i) { const int s = wv + 8 * (4 + i); conv8_load(pbase, s, t0 + s, colx, vx[i]); }
#pragma unroll
    for (int i = 0; i < 2; ++i) { const int s = sb0 + 32 * i; float y[8]; conv8_calc(vB[i], t0 + s, wB, bB, y);
        if (PRE) *(LAS u32x4*)(shm + L_B + (cgb >> 2) * 4096 + s * 64 + (cgb & 3) * 16) = pack8(y);
        else     *(LAS u32x4*)(shm + L_B + cgb * 1024 + s * 16) = pack8(y); }
    if (!PRE) { const int colC = 1280 + g * 128 + cgb * 8; load_w8(a, colC, wB, bB);
#pragma unroll
        for (int i = 0; i < 2; ++i) { const int s = sb0 + 32 * i; conv8_load(pbase, s, t0 + s, colC, vB[i]); } }
#pragma unroll
    for (int i = 0; i < 4; ++i) { const int s = wv + 8 * (4 + i); float y[8]; conv8_calc(vx[i], t0 + s, wx, bx, y);
        const float f = PRE ? ((LAS float*)(shm + L_ECS))[s * 8 + h8] : dtab[s * 8 + h8];
#pragma unroll
        for (int e = 0; e < 8; ++e) y[e] *= f;
        *(LAS u32x4*)(shm + L_XS + h8 * 8192 + ((cgx & 7) >> 2) * 4096 + s * 64 + (cgx & 3) * 16) = pack8(y); }
    if (!PRE) {
#pragma unroll
        for (int i = 0; i < 2; ++i) { const int s = sb0 + 32 * i; float y[8]; conv8_calc(vB[i], t0 + s, wB, bB, y);
            *(LAS u32x4*)(shm + L_C + cgb * 1024 + s * 16) = pack8(y); } }
    lds_barrier();
}
template <bool PRE> __device__ __forceinline__ void stage(const Args& a, int chunk, int g, LAS unsigned char* shm, int tid_) {
    if (PRE && chunk < SEQ / 64) stage_p<PRE>(a, chunk, g, shm, tid_); else stage_s<PRE>(a, chunk, g, shm, tid_);
}
__device__ __forceinline__ bf16x8 trfrag_nat(lds_cptr blk, int ks, int lane) {
    const int hi = lane >> 5; lds_cptr p = blk + (16 * ks + 8 * hi + ((lane & 15) >> 2)) * 64 + ((lane >> 4) & 1) * 32 + (lane & 3) * 8;
    const s16x4 lo = vtr(p), hh = vtr(p + 256); return (bf16x8){lo[0], lo[1], lo[2], lo[3], hh[0], hh[1], hh[2], hh[3]};
}
__device__ __forceinline__ bf16x8 trfrag_acc(lds_cptr blk, int ks, int lane) {
    const int hi = lane >> 5; lds_cptr p = blk + (16 * ks + 4 * hi + ((lane & 15) >> 2)) * 64 + ((lane >> 4) & 1) * 32 + (lane & 3) * 8;
    const s16x4 lo = vtr(p), hh = vtr(p + 512); return (bf16x8){lo[0], lo[1], lo[2], lo[3], hh[0], hh[1], hh[2], hh[3]};
}
__device__ __forceinline__ void pre_unit(const Args& a, int chunk, int g, LAS unsigned char* shm, int tid_) {
    stage<true>(a, chunk, g, shm, tid_);
    const int tid = opaque_v(tid_);
    const int lane = tid & 63, r32 = lane & 31, hi = lane >> 5, wid = __builtin_amdgcn_readfirstlane(tid >> 6), h = g * 8 + wid;
    const lds_cptr shm3 = (lds_cptr)shm; const lds_cptr xs = shm3 + L_XS + wid * 8192, bi = shm3 + L_B;
    bf16x8 af[2][4];
#pragma unroll
    for (int pb = 0; pb < 2; ++pb)
#pragma unroll
        for (int ks = 0; ks < 4; ++ks) af[pb][ks] = trfrag_nat(xs + pb * 4096, ks, lane);
    bf16* st = a.states + ((size_t)(chunk * 16 + h) * 64) * 128;
#pragma unroll
    for (int nb = 0; nb < 4; ++nb) { bf16x8 bfr[4];
#pragma unroll
        for (int ks = 0; ks < 4; ++ks) bfr[ks] = trfrag_nat(bi + nb * 4096, ks, lane);
#pragma unroll
        for (int pb = 0; pb < 2; ++pb) { f32x16 acc = {0.f, 0.f, 0.f, 0.f, 0.f, 0.f, 0.f, 0.f, 0.f, 0.f, 0.f, 0.f, 0.f, 0.f, 0.f, 0.f};
#pragma unroll
            for (int ks = 0; ks < 4; ++ks) acc = ATT_MFMA(bfr[ks], af[pb][ks], acc);
            bf16* sp = st + (unsigned)((32 * pb + r32) * 128 + 32 * nb + 4 * hi);
#pragma unroll
            for (int q = 0; q < 4; ++q) { u32x2 w; w.x = cvtpk(acc[4 * q], acc[4 * q + 1]); w.y = cvtpk(acc[4 * q + 2], acc[4 * q + 3]); *(u32x2*)(sp + 8 * q) = w; } } }
    if (tid < 8) a.decay[chunk * 16 + g * 8 + tid] = __expf(((LAS float*)(shm + L_CS))[63 * 8 + tid]);
    lds_barrier();
}
__device__ __forceinline__ void post_unit(const Args& a, int chunk, int g, LAS unsigned char* shm, int tid_) {
    bf16x8 hf[2][8];
    { const int tq = opaque_v(tid_), lq = tq & 63, wq = __builtin_amdgcn_readfirstlane(tq >> 6); const bf16* hq = a.hin + ((size_t)(chunk * 16 + g * 8 + wq) * 64) * 128;
#pragma unroll
      for (int dq = 0; dq < 2; ++dq)
#pragma unroll
          for (int d0 = 0; d0 < 8; ++d0) hf[dq][d0] = *(const bf16x8*)(hq + (unsigned)((32 * dq + (lq & 31)) * 128 + 16 * d0 + 8 * (lq >> 5))); }
    stage<false>(a, chunk, g, shm, tid_);
    const int tid = opaque_v(tid_);
    const int lane0 = tid & 63, wid = __builtin_amdgcn_readfirstlane(tid >> 6), h = g * 8 + wid, row0 = chunk * 64;
    bf16x8 zv[8];
    { const bf16* zb = a.proj + (size_t)row0 * NPJ + C_Z + g * 512 + lane0 * 8;
#pragma unroll
      for (int i = 0; i < 8; ++i) zv[i] = *(const bf16x8*)(zb + (unsigned)((wid * 8 + i) * NPJ)); }
    const lds_cptr shm3 = (lds_cptr)shm; const lds_cptr xs = shm3 + L_XS + wid * 8192;
    const LAS float* cstab = (const LAS float*)(shm + L_CS); const LAS float* ecs = (const LAS float*)(shm + L_ECS); const LAS float* rdt = (const LAS float*)(shm + L_RDT);
    const float Dh = a.dpar[a.layer * 16 + h];
#pragma unroll 1
    for (int qb = 1; qb >= 0; --qb) {
        const int lane = opaque_v(lane0), r32 = lane & 31, hi = lane >> 5;
        bf16x8 qr[8];
#pragma unroll
        for (int d0 = 0; d0 < 8; ++d0) qr[d0] = *(const LAS bf16x8*)(shm + L_C + (2 * d0 + hi) * 1024 + (32 * qb + r32) * 16);
        f32x16 o[2];
#pragma unroll
        for (int dq = 0; dq < 2; ++dq) o[dq] = (f32x16){0.f, 0.f, 0.f, 0.f, 0.f, 0.f, 0.f, 0.f, 0.f, 0.f, 0.f, 0.f, 0.f, 0.f, 0.f, 0.f};
        const float cs_t = cstab[(32 * qb + r32) * 8 + wid], dd_t = Dh * rdt[(32 * qb + r32) * 8 + wid];
#pragma unroll 1
        for (int sb = 0; sb <= qb; ++sb) {
            f32x16 x = {0.f, 0.f, 0.f, 0.f, 0.f, 0.f, 0.f, 0.f, 0.f, 0.f, 0.f, 0.f, 0.f, 0.f, 0.f, 0.f};
#pragma unroll
            for (int d0 = 0; d0 < 8; ++d0) { const bf16x8 kf = *(const LAS bf16x8*)(shm + L_B + (2 * d0 + hi) * 1024 + (32 * sb + r32) * 16); x = ATT_MFMA(kf, qr[d0], x); }
#pragma unroll
            for (int r = 0; r < 16; ++r) { const int s = 32 * sb + crow(r, hi), t = 32 * qb + r32;
                x[r] = (s < t) ? x[r] * __expf(cs_t - cstab[s * 8 + wid]) : (s == t ? x[r] + dd_t : 0.f); }
            typedef unsigned u4 __attribute__((ext_vector_type(4)));
            const u4 w0 = {cvtpk(x[0], x[1]), cvtpk(x[2], x[3]), cvtpk(x[4], x[5]), cvtpk(x[6], x[7])}, w1 = {cvtpk(x[8], x[9]), cvtpk(x[10], x[11]), cvtpk(x[12], x[13]), cvtpk(x[14], x[15])};
            const bf16x8 pa0 = __builtin_bit_cast(bf16x8, w0), pa1 = __builtin_bit_cast(bf16x8, w1);
#pragma unroll
            for (int dq = 0; dq < 2; ++dq) { o[dq] = ATT_MFMA(pa0, trfrag_acc(xs + dq * 4096, 2 * sb, lane), o[dq]); o[dq] = ATT_MFMA(pa1, trfrag_acc(xs + dq * 4096, 2 * sb + 1, lane), o[dq]); }
        }
        const LAS float* ecs_l = ecs + (32 * qb + 4 * hi) * 8 + wid;
#pragma unroll
        for (int dq = 0; dq < 2; ++dq) { f32x16 acc = {0.f, 0.f, 0.f, 0.f, 0.f, 0.f, 0.f, 0.f, 0.f, 0.f, 0.f, 0.f, 0.f, 0.f, 0.f, 0.f};
#pragma unroll
            for (int d0 = 0; d0 < 8; ++d0) acc = ATT_MFMA(qr[d0], hf[dq][d0], acc);
            asm volatile("s_waitcnt lgkmcnt(0)" ::: "memory");
            LAS bf16* yw = (LAS bf16*)(shm + L_XS + wid * 8192 + dq * 4096 + (32 * qb + 4 * hi) * 64 + r32 * 2);
#pragma unroll
            for (int r = 0; r < 16; ++r) { const int tc = (r & 3) + 8 * (r >> 2); yw[tc * 32] = (bf16)f2bf(o[dq][r] + ecs_l[tc * 8] * acc[r]); } }
    }
    __syncthreads();
    { const int lane = opaque_v(lane0), h8 = lane >> 3; float gn[8];
      { const f32x4 g0 = *(const f32x4*)(a.norm_g + a.layer * 1024 + g * 512 + lane * 8), g1 = *(const f32x4*)(a.norm_g + a.layer * 1024 + g * 512 + lane * 8 + 4);
        gn[0] = g0.x; gn[1] = g0.y; gn[2] = g0.z; gn[3] = g0.w; gn[4] = g1.x; gn[5] = g1.y; gn[6] = g1.z; gn[7] = g1.w; }
      bf16* mb = a.mix + (size_t)row0 * DM + g * 512 + lane * 8;
      const LAS unsigned char* yb = shm + L_XS + h8 * 8192 + ((lane & 7) >> 2) * 4096 + (lane & 3) * 16;
#pragma unroll
      for (int i = 0; i < 8; ++i) { const int t = wid * 8 + i;
          const bf16x8 yv = *(const LAS bf16x8*)(yb + t * 64); float v[8], ss = 0.f;
#pragma unroll
          for (int e = 0; e < 8; ++e) { v[e] = bf2f((bf16)yv[e]) * silu_f(bf2f((bf16)zv[i][e])); ss += v[e] * v[e]; }
          const float rn = __builtin_amdgcn_rsqf(wave_sum(ss) * (1.f / 512.f) + EPS);
          u32x4 o; o.x = pk2(v[0] * rn * gn[0], v[1] * rn * gn[1]); o.y = pk2(v[2] * rn * gn[2], v[3] * rn * gn[3]); o.z = pk2(v[4] * rn * gn[4], v[5] * rn * gn[5]); o.w = pk2(v[6] * rn * gn[6], v[7] * rn * gn[7]);
          *(u32x4*)(mb + (unsigned)(t * DM)) = o; } }
    lds_barrier();
}
struct ScanArgs { const bf16* states; const float* decay; const float* state_in; bf16* hin; float* out; int layer, pad; };
__device__ __forceinline__ f32x4 ld_bf4(const bf16* p) { const u32x2 w = *(const u32x2*)p; return (f32x4){__builtin_bit_cast(float, w.x << 16), __builtin_bit_cast(float, w.x & 0xffff0000u), __builtin_bit_cast(float, w.y << 16), __builtin_bit_cast(float, w.y & 0xffff0000u)}; }
__device__ __forceinline__ f32x4 bf4_to_f32(const u32x2 w) { return (f32x4){__builtin_bit_cast(float, w.x << 16), __builtin_bit_cast(float, w.x & 0xffff0000u), __builtin_bit_cast(float, w.y << 16), __builtin_bit_cast(float, w.y & 0xffff0000u)}; }
__device__ __forceinline__ void scan_prompt(const ScanArgs& a, int e4) {
    const int h = e4 >> 11; f32x4 hv = {0.f, 0.f, 0.f, 0.f};
#pragma unroll 1
    for (int c0 = 0; c0 < SEQ / 64; c0 += 16) { u32x2 sr[16]; float dv[16];
#pragma unroll
        for (int j = 0; j < 16; ++j) { sr[j] = *(const u32x2*)(a.states + (size_t)(c0 + j) * 131072 + e4 * 4); dv[j] = a.decay[(c0 + j) * 16 + h]; }
#pragma unroll
        for (int j = 0; j < 16; ++j) { u32x2 o; o.x = pk2(hv.x, hv.y); o.y = pk2(hv.z, hv.w); *(u32x2*)(a.hin + (size_t)(c0 + j) * 131072 + e4 * 4) = o;
            hv = hv * dv[j] + bf4_to_f32(sr[j]); } }
    *(f32x4*)(a.out + O_HP + (size_t)a.layer * 131072 + e4 * 4) = hv;
}
__device__ __forceinline__ void scan_sample8(const ScanArgs& a, int b0, int e4) {
    const int h = e4 >> 11; f32x4 h0[8]; u32x2 sr[8]; float dv[8];
#pragma unroll
    for (int j = 0; j < 8; ++j) { const int b = b0 + j, c = SEQ / 64 + b; h0[j] = *(const f32x4*)(a.state_in + (size_t)(a.layer * DB + b) * 131072 + e4 * 4);
        sr[j] = *(const u32x2*)(a.states + (size_t)c * 131072 + e4 * 4); dv[j] = a.decay[c * 16 + h]; }
#pragma unroll
    for (int j = 0; j < 8; ++j) { const int b = b0 + j, c = SEQ / 64 + b;
        u32x2 o; o.x = pk2(h0[j].x, h0[j].y); o.y = pk2(h0[j].z, h0[j].w); *(u32x2*)(a.hin + (size_t)c * 131072 + e4 * 4) = o;
        *(f32x4*)(a.out + O_HS + (size_t)(a.layer * DB + b) * 131072 + e4 * 4) = h0[j] * dv[j] + bf4_to_f32(sr[j]); }
}
}
namespace glac {
using att::bf16x8; using att::f32x16; using att::lds_cptr; using att::cvtpk; using att::crow; using ssdc::trfrag_nat; using ssdc::trfrag_acc; using ssdc::pack8;
constexpr int L_B = 0, L_QT = 16384, L_KT = 24576, L_V = 32768, L_RED = 49152, LDS_NEED = 51200;
struct Args { const bf16* proj; const float* dtga; const float* wa2; const float* ba; const float* norm_g; float* btab; bf16* states; float* decay; const bf16* hin; bf16* mix; int layer, pad; };
__device__ __forceinline__ void btable(const Args& a, int row0, int h, LAS unsigned char* shm, int tid) {
    LAS float* bt = (LAS float*)(shm + L_B); LAS float* gs = (LAS float*)(shm + L_RED);
    const int tg = __builtin_amdgcn_readfirstlane(tid >> 6), k = tid & 63;
    float w[16];
#pragma unroll
    for (int r = 0; r < 16; ++r) w[r] = a.wa2[(size_t)(a.layer * 16 + r) * 256 + h * 64 + k];
    const float bias = a.ba[a.layer * 256 + h * 64 + k]; const float* ga = a.dtga + (size_t)(row0 + 8 * tg) * 32 + 16; float acc = 0.f;
#pragma unroll
    for (int j = 0; j < 8; ++j) { float x = bias;
#pragma unroll
        for (int r = 0; r < 16; ++r) x += ga[j * 32 + r] * w[r];
        acc += logsigmoid_f(x) * (1.f / 16.f); bt[(8 * tg + j) * 64 + k] = acc; }
    gs[tg * 64 + k] = acc;
    lds_barrier();
    float off = 0.f;
    for (int g2 = 0; g2 < tg; ++g2) off += gs[g2 * 64 + k];
#pragma unroll
    for (int j = 0; j < 8; ++j) bt[(8 * tg + j) * 64 + k] += off;
    lds_barrier();
}
__device__ __forceinline__ void stage_v(const Args& a, int row0, int h, LAS unsigned char* shm, int tid) {
    const bf16* vb = a.proj + (size_t)row0 * NPJ + C_GV + h * 128;
#pragma unroll
    for (int i = 0; i < 2; ++i) { const int it = tid + 512 * i, s = it >> 4, vg = it & 15;
        *(LAS u32x4*)(shm + L_V + (vg >> 2) * 4096 + s * 64 + (vg & 3) * 16) = *(const u32x4*)(vb + (unsigned)(s * NPJ + vg * 8)); }
}
__device__ __forceinline__ void pre_unit(const Args& a, int chunk, int h, LAS unsigned char* shm, int tid_) {
    const int tid = opaque_v(tid_), row0 = chunk * 64;
    const bf16x8 kv = *(const bf16x8*)(a.proj + (size_t)row0 * NPJ + C_GK + h * 64 + (unsigned)((tid >> 3) * NPJ + (tid & 7) * 8)); u32x4 vv[2];
    { const bf16* vbp = a.proj + (size_t)row0 * NPJ + C_GV + h * 128;
#pragma unroll
      for (int i = 0; i < 2; ++i) { const int it = tid + 512 * i, s = it >> 4, vg = it & 15; vv[i] = *(const u32x4*)(vbp + (unsigned)(s * NPJ + vg * 8)); } }
    btable(a, row0, h, shm, tid);
    const LAS float* bt = (const LAS float*)(shm + L_B);
    { float* bg = a.btab + (size_t)row0 * 256 + h * 64;
#pragma unroll
      for (int i = 0; i < 2; ++i) { const int it = tid + 512 * i, s = it >> 4, c4 = (it & 15) * 4; *(f32x4*)(bg + (unsigned)(s * 256 + c4)) = *(const LAS f32x4*)(bt + s * 64 + c4); } }
    { const int s = tid >> 3, kg = tid & 7; float y[8];
#pragma unroll
      for (int e = 0; e < 8; ++e) y[e] = bf2f((bf16)kv[e]) * __expf(bt[63 * 64 + kg * 8 + e] - bt[s * 64 + kg * 8 + e]);
      *(LAS u32x4*)(shm + L_QT + (kg >> 2) * 4096 + s * 64 + (kg & 3) * 16) = pack8(y); }
#pragma unroll
    for (int i = 0; i < 2; ++i) { const int it = tid + 512 * i, s = it >> 4, vg = it & 15; *(LAS u32x4*)(shm + L_V + (vg >> 2) * 4096 + s * 64 + (vg & 3) * 16) = vv[i]; }
    lds_barrier();
    const int lane = tid & 63, r32 = lane & 31, hi = lane >> 5, wid = __builtin_amdgcn_readfirstlane(tid >> 6), kb = wid & 1, vb = wid >> 1;
    const lds_cptr shm3 = (lds_cptr)shm;
    f32x16 acc = {0.f, 0.f, 0.f, 0.f, 0.f, 0.f, 0.f, 0.f, 0.f, 0.f, 0.f, 0.f, 0.f, 0.f, 0.f, 0.f};
#pragma unroll
    for (int ks = 0; ks < 4; ++ks) acc = ATT_MFMA(trfrag_nat(shm3 + L_QT + kb * 4096, ks, lane), trfrag_nat(shm3 + L_V + vb * 4096, ks, lane), acc);
    bf16* st = a.states + ((size_t)(chunk * 4 + h) * 128 + 32 * vb + r32) * 64 + 32 * kb + 4 * hi;
#pragma unroll
    for (int q = 0; q < 4; ++q) { u32x2 w; w.x = cvtpk(acc[4 * q], acc[4 * q + 1]); w.y = cvtpk(acc[4 * q + 2], acc[4 * q + 3]); *(u32x2*)(st + 8 * q) = w; }
    if (tid < 64) a.decay[(chunk * 4 + h) * 64 + tid] = __expf(bt[63 * 64 + tid]);
    lds_barrier();
}
__device__ __forceinline__ void post_unit(const Args& a, int chunk, int h, LAS unsigned char* shm, int tid_) {
    const int tid = opaque_v(tid_), row0 = chunk * 64;
    const int lane = tid & 63, r32 = lane & 31, hi = lane >> 5, wid = __builtin_amdgcn_readfirstlane(tid >> 6), tb = wid & 1, vb = wid >> 1, rs = lane >> 4, cg = lane & 15;
    const LAS float* bt = (const LAS float*)(shm + L_B);
    f32x4 btv[2]; u32x4 vv[2]; bf16x8 hf[4], gv[2];
    { const float* bg = a.btab + (size_t)row0 * 256 + h * 64;
#pragma unroll
      for (int i = 0; i < 2; ++i) { const int it = tid + 512 * i, s = it >> 4, c4 = (it & 15) * 4; btv[i] = *(const f32x4*)(bg + (unsigned)(s * 256 + c4)); } }
    const bf16* pr = a.proj + (size_t)row0 * NPJ + h * 64;
    const bf16x8 qv = *(const bf16x8*)(pr + (unsigned)((tid >> 3) * NPJ + C_GQ + (tid & 7) * 8)), kv = *(const bf16x8*)(pr + (unsigned)((tid >> 3) * NPJ + C_GK + (tid & 7) * 8));
    { const bf16* vbp = a.proj + (size_t)row0 * NPJ + C_GV + h * 128;
#pragma unroll
      for (int i = 0; i < 2; ++i) { const int it = tid + 512 * i, s = it >> 4, vg = it & 15; vv[i] = *(const u32x4*)(vbp + (unsigned)(s * NPJ + vg * 8)); } }
    { const bf16* hin = a.hin + ((size_t)(chunk * 4 + h) * 128 + 32 * vb + r32) * 64 + 8 * hi;
#pragma unroll
      for (int d0 = 0; d0 < 4; ++d0) hf[d0] = *(const bf16x8*)(hin + 16 * d0); }
#pragma unroll
    for (int i = 0; i < 2; ++i) gv[i] = *(const bf16x8*)(a.proj + (size_t)(row0 + wid * 8 + i * 4 + rs) * NPJ + C_GG + h * 128 + cg * 8);
    const f32x4 g0 = *(const f32x4*)(a.norm_g + a.layer * 128 + cg * 8), g1 = *(const f32x4*)(a.norm_g + a.layer * 128 + cg * 8 + 4);
#pragma unroll
    for (int i = 0; i < 2; ++i) { const int it = tid + 512 * i, s = it >> 4, c4 = (it & 15) * 4; *(LAS f32x4*)((LAS float*)(shm + L_B) + s * 64 + c4) = btv[i]; }
    lds_barrier();
    { const int s = tid >> 3, kg = tid & 7; float yq[8], yk[8];
#pragma unroll
      for (int e = 0; e < 8; ++e) { const float bb = bt[s * 64 + kg * 8 + e]; yq[e] = bf2f((bf16)qv[e]) * 0.125f * __expf(bb); yk[e] = bf2f((bf16)kv[e]) * __expf(-bb); }
      *(LAS u32x4*)(shm + L_QT + kg * 1024 + s * 16) = pack8(yq); *(LAS u32x4*)(shm + L_KT + kg * 1024 + s * 16) = pack8(yk); }
#pragma unroll
    for (int i = 0; i < 2; ++i) { const int it = tid + 512 * i, s = it >> 4, vg = it & 15; *(LAS u32x4*)(shm + L_V + (vg >> 2) * 4096 + s * 64 + (vg & 3) * 16) = vv[i]; }
    lds_barrier();
    const lds_cptr shm3 = (lds_cptr)shm;
    bf16x8 qr[4];
#pragma unroll
    for (int d0 = 0; d0 < 4; ++d0) qr[d0] = *(const LAS bf16x8*)(shm + L_QT + (2 * d0 + hi) * 1024 + (32 * tb + r32) * 16);
    f32x16 o = {0.f, 0.f, 0.f, 0.f, 0.f, 0.f, 0.f, 0.f, 0.f, 0.f, 0.f, 0.f, 0.f, 0.f, 0.f, 0.f};
#pragma unroll
    for (int d0 = 0; d0 < 4; ++d0) o = ATT_MFMA(qr[d0], hf[d0], o);
#pragma unroll 1
    for (int sb = 0; sb <= tb; ++sb) {
        f32x16 x = {0.f, 0.f, 0.f, 0.f, 0.f, 0.f, 0.f, 0.f, 0.f, 0.f, 0.f, 0.f, 0.f, 0.f, 0.f, 0.f};
#pragma unroll
        for (int d0 = 0; d0 < 4; ++d0) x = ATT_MFMA(*(const LAS bf16x8*)(shm + L_KT + (2 * d0 + hi) * 1024 + (32 * sb + r32) * 16), qr[d0], x);
#pragma unroll
        for (int r = 0; r < 16; ++r) { const int s = 32 * sb + crow(r, hi), t = 32 * tb + r32; x[r] = (s <= t) ? x[r] : 0.f; }
        typedef unsigned u4 __attribute__((ext_vector_type(4)));
        const u4 w0 = {cvtpk(x[0], x[1]), cvtpk(x[2], x[3]), cvtpk(x[4], x[5]), cvtpk(x[6], x[7])}, w1 = {cvtpk(x[8], x[9]), cvtpk(x[10], x[11]), cvtpk(x[12], x[13]), cvtpk(x[14], x[15])};
        o = ATT_MFMA(__builtin_bit_cast(bf16x8, w0), trfrag_acc(shm3 + L_V + vb * 4096, 2 * sb, lane), o);
        o = ATT_MFMA(__builtin_bit_cast(bf16x8, w1), trfrag_acc(shm3 + L_V + vb * 4096, 2 * sb + 1, lane), o);
    }
    lds_barrier();
    { LAS float* ot = (LAS float*)shm + (32 * tb + 4 * hi) * 128 + 32 * vb + r32;
#pragma unroll
      for (int r = 0; r < 16; ++r) ot[((r & 3) + 8 * (r >> 2)) * 128] = o[r]; }
    lds_barrier();
    { const float gn[8] = {g0.x, g0.y, g0.z, g0.w, g1.x, g1.y, g1.z, g1.w};
#pragma unroll
      for (int i = 0; i < 2; ++i) { const int t = wid * 8 + i * 4 + rs;
          const f32x4 a0 = *(const LAS f32x4*)((LAS float*)shm + t * 128 + cg * 8), a1 = *(const LAS f32x4*)((LAS float*)shm + t * 128 + cg * 8 + 4);
          float v[8] = {a0.x, a0.y, a0.z, a0.w, a1.x, a1.y, a1.z, a1.w}; float ss = 0.f;
#pragma unroll
          for (int e = 0; e < 8; ++e) ss += v[e] * v[e];
          ss += dpp_xor1(ss); ss += dpp_xor2(ss); ss += swz_xor4(ss); ss += swz_xor8(ss);
          const float rn = __builtin_amdgcn_rsqf(ss * (1.f / 128.f) + EPS);
#pragma unroll
          for (int e = 0; e < 8; ++e) v[e] = v[e] * rn * gn[e] * silu_f(bf2f((bf16)gv[i][e]));
          *(u32x4*)(a.mix + (size_t)(row0 + t) * DM + 1536 + h * 128 + cg * 8) = pack8(v); } }
    lds_barrier();
}
struct ScanArgs { const bf16* states; const float* decay; const float* state_in; bf16* hin; float* out; int layer, pad; };
__device__ __forceinline__ void scan_prompt(const ScanArgs& a, int e4) {
    const int h = e4 >> 11, k = (e4 * 4) & 63, v = (e4 >> 4) & 127; f32x4 sv = {0.f, 0.f, 0.f, 0.f};
#pragma unroll 1
    for (int c0 = 0; c0 < SEQ / 64; c0 += 8) { u32x2 sr[8]; f32x4 dv[8];
#pragma unroll
        for (int j = 0; j < 8; ++j) { sr[j] = *(const u32x2*)(a.states + (size_t)(c0 + j) * 32768 + e4 * 4); dv[j] = *(const f32x4*)(a.decay + ((c0 + j) * 4 + h) * 64 + k); }
#pragma unroll
        for (int j = 0; j < 8; ++j) { u32x2 o; o.x = pk2(sv.x, sv.y); o.y = pk2(sv.z, sv.w); *(u32x2*)(a.hin + (size_t)(c0 + j) * 32768 + e4 * 4) = o;
            sv = sv * dv[j] + ssdc::bf4_to_f32(sr[j]); } }
    float* op = a.out + O_SP + ((size_t)(a.layer * 4 + h) * 64 + k) * 128 + v; op[0] = sv.x; op[128] = sv.y; op[256] = sv.z; op[384] = sv.w;
}
__device__ __forceinline__ void scan_sample8(const ScanArgs& a, int b0, int e4) {
    const int h = e4 >> 11, k = (e4 * 4) & 63, v = (e4 >> 4) & 127; f32x4 s0[8], dv[8]; u32x2 sr[8];
#pragma unroll
    for (int j = 0; j < 8; ++j) { const int b = b0 + j, c = SEQ / 64 + b; const float* ip = a.state_in + ((size_t)((a.layer * DB + b) * 4 + h) * 64 + k) * 128 + v; s0[j] = (f32x4){ip[0], ip[128], ip[256], ip[384]};
        sr[j] = *(const u32x2*)(a.states + (size_t)c * 32768 + e4 * 4); dv[j] = *(const f32x4*)(a.decay + (c * 4 + h) * 64 + k); }
#pragma unroll
    for (int j = 0; j < 8; ++j) { const int b = b0 + j, c = SEQ / 64 + b;
        u32x2 o; o.x = pk2(s0[j].x, s0[j].y); o.y = pk2(s0[j].z, s0[j].w); *(u32x2*)(a.hin + (size_t)c * 32768 + e4 * 4) = o;
        const f32x4 sv = s0[j] * dv[j] + ssdc::bf4_to_f32(sr[j]);
        float* op = a.out + O_SS + ((size_t)((a.layer * DB + b) * 4 + h) * 64 + k) * 128 + v; op[0] = sv.x; op[128] = sv.y; op[256] = sv.z; op[384] = sv.w; }
}
}
__device__ __forceinline__ int win_orig_col(int n) {
    if (n < 2560) return n;
    if (n < 5120) return n + 16;
    if (n < 5632) return n + 32;
    if (n < 5648) return 2560 + (n - 5632);
    if (n < 5664) return 5136 + (n - 5648);
    return -1;
}
__device__ __forceinline__ void tw_load(const float* __restrict__ W, const float* __restrict__ gk, int N, int nblk, int mode, int item, int lane, f32x4 (&v)[8]) {
    const int kb = item / nblk, nb = item % nblk, k0 = 64 * kb, n0 = 32 * nb + (lane & 7) * 4; const int oc = mode ? win_orig_col(n0) : n0;
#pragma unroll
    for (int i = 0; i < 8; ++i) { const int kk = k0 + 8 * i + (lane >> 3);
        if (oc >= 0) { const f32x4 w = *(const f32x4*)(W + (size_t)kk * N + oc); v[i] = gk ? w * gk[kk] : w; } else v[i] = (f32x4){0.f, 0.f, 0.f, 0.f}; }
}
__device__ __forceinline__ void transpose_w(const float* __restrict__ W, const float* __restrict__ gk  , int K, int N, bf16* __restrict__ WT, int Nout, int mode, LAS float* scr, int gw, int ngw, int lane) {
    const int nblk = Nout / 32, nitems = (K / 64) * nblk;
    f32x4 cur[8], nxt[8];
    if (gw < nitems) tw_load(W, gk, N, nblk, mode, gw, lane, cur);
    for (int item = gw; item < nitems; item += ngw) {
        const bool more = item + ngw < nitems;
        if (more) tw_load(W, gk, N, nblk, mode, item + ngw, lane, nxt);
        const int kb = item / nblk, nb = item % nblk, k0 = 64 * kb, n0 = 32 * nb;
#pragma unroll
        for (int i = 0; i < 8; ++i) { LAS float* d = scr + (8 * i + (lane >> 3)) * 33 + (lane & 7) * 4; d[0] = cur[i].x; d[1] = cur[i].y; d[2] = cur[i].z; d[3] = cur[i].w; }
        __builtin_amdgcn_s_waitcnt(0xC07F); __builtin_amdgcn_wave_barrier();
        const int c = lane & 7;
#pragma unroll
        for (int j = 0; j < 4; ++j) { const int n = (lane >> 3) + 8 * j; const LAS float* s = scr + (8 * c) * 33 + n;
            u32x4 o; o.x = pk2(s[0 * 33], s[1 * 33]); o.y = pk2(s[2 * 33], s[3 * 33]); o.z = pk2(s[4 * 33], s[5 * 33]); o.w = pk2(s[6 * 33], s[7 * 33]);
            *(u32x4*)(WT + (size_t)(n0 + n) * K + k0 + 8 * c) = o; }
        __builtin_amdgcn_s_waitcnt(0xC07F); __builtin_amdgcn_wave_barrier();
        if (more) {
#pragma unroll
            for (int i = 0; i < 8; ++i) cur[i] = nxt[i]; }
    }
}
__device__ __forceinline__ void transpose_w4(const float* __restrict__ W, const float* __restrict__ gk, int K, int N, bf16* __restrict__ WT, int Nout, int mode, LAS float* scr, int gw, int ngw, int lane) {
    const int nblk = Nout / 32, nitems = (K / 64) * nblk;
    for (int base = gw; base < nitems; base += 4 * ngw) {
        f32x4 t[4][8]; float gv[4][8], msk[4];
#pragma unroll
        for (int q = 0; q < 4; ++q) { int item = base + q * ngw; if (item >= nitems) item = base;
            const int kb = item / nblk, nb = item % nblk, k0 = 64 * kb, n0 = 32 * nb + (lane & 7) * 4; const int oc = mode ? win_orig_col(n0) : n0; msk[q] = oc >= 0 ? 1.f : 0.f; const int ocs = oc >= 0 ? oc : 0;
#pragma unroll
            for (int i = 0; i < 8; ++i) { const int kk = k0 + 8 * i + (lane >> 3); t[q][i] = *(const f32x4*)(W + (size_t)kk * N + ocs); gv[q][i] = gk ? gk[kk] : 1.f; } }
#pragma unroll
        for (int q = 0; q < 4; ++q) { const int item = base + q * ngw; if (item >= nitems) break;
            const int kb = item / nblk, nb = item % nblk, k0 = 64 * kb, n0 = 32 * nb;
#pragma unroll
            for (int i = 0; i < 8; ++i) { LAS float* d = scr + (8 * i + (lane >> 3)) * 33 + (lane & 7) * 4; const float gg = gv[q][i] * msk[q]; d[0] = t[q][i].x * gg; d[1] = t[q][i].y * gg; d[2] = t[q][i].z * gg; d[3] = t[q][i].w * gg; }
            __builtin_amdgcn_s_waitcnt(0xC07F); __builtin_amdgcn_wave_barrier();
            const int c = lane & 7;
#pragma unroll
            for (int j = 0; j < 4; ++j) { const int n = (lane >> 3) + 8 * j; const LAS float* s = scr + (8 * c) * 33 + n;
                u32x4 o; o.x = pk2(s[0 * 33], s[1 * 33]); o.y = pk2(s[2 * 33], s[3 * 33]); o.z = pk2(s[4 * 33], s[5 * 33]); o.w = pk2(s[6 * 33], s[7 * 33]);
                *(u32x4*)(WT + (size_t)(n0 + n) * K + k0 + 8 * c) = o; }
            __builtin_amdgcn_s_waitcnt(0xC07F); __builtin_amdgcn_wave_barrier(); }
    }
}
__device__ __forceinline__ void scalars_body(const float* __restrict__ diff_lambda, float* ctlf, int l) {
    const float* p = diff_lambda + l * 256; float s1 = 0.f, s2 = 0.f;
    for (int i = 0; i < 64; ++i) { s1 += p[i] * p[64 + i]; s2 += p[128 + i] * p[192 + i]; }
    ctlf[l] = expf(s1) - expf(s2) + (0.8f - 0.6f * expf(-0.3f * (float)l));
}
__device__ __forceinline__ void xrow_to_bf16(const float* __restrict__ xa, const float* __restrict__ xb, bf16* __restrict__ XB, float* __restrict__ ssq, int row, int lane) {
    const float* x = row < SEQ ? xa + (size_t)row * DM : xb + (size_t)(row - SEQ) * DM;
    f32x4 v[8]; float s = 0.f;
#pragma unroll
    for (int j = 0; j < 8; ++j) { v[j] = ((const f32x4*)x)[lane + 64 * j]; s += (v[j].x * v[j].x + v[j].y * v[j].y) + (v[j].z * v[j].z + v[j].w * v[j].w); }
    s = wave_sum(s);
#pragma unroll
    for (int j = 0; j < 8; ++j) { u32x2 o; o.x = pk2(v[j].x, v[j].y); o.y = pk2(v[j].z, v[j].w); ((u32x2*)(XB + (size_t)row * DM))[lane + 64 * j] = o; }
    if (lane == 0) ssq[row] = s;
}
struct PrepArgs { const bf16* proj; const float* dtga; const float* conv_state; const float* conv_w; const float* conv_b; const float* dt_bias; const float* wa2; const float* ba;
                  const float* qn_g; const float* kn_g; float* xc; float* dt; float* loga; bf16* qn; bf16* kp; bf16* vp; bf16* kc; bf16* vc; float* out; int layer, pad; };
__device__ __forceinline__ float sum8(float v) { v += dpp_xor1(v); v += dpp_xor2(v); v += swz_xor4(v); return v; }
__device__ __forceinline__ void prep_row(const PrepArgs& a, int row, int lane, float& qmax2, float& kmax2) {
    typedef short bf16x8 __attribute__((ext_vector_type(8)));
    const int l = a.layer; const bool isS = row >= SEQ; const int b = isS ? (row - SEQ) >> 6 : 0, t = isS ? (row - SEQ) & 63 : row, L = isS ? DS : SEQ;
    const bf16* pr = a.proj + (size_t)row * NPJ; const int c0 = 8 * lane, d = c0 & 63;
    const bf16x8 qv = *(const bf16x8*)(pr + C_DQ + c0), kv = *(const bf16x8*)(pr + C_DK + c0); const u32x4 vv = *(const u32x4*)(pr + C_DV + c0);
    float q[8], k[8], sq = 0.f, sk = 0.f;
#pragma unroll
    for (int e = 0; e < 8; ++e) { q[e] = bf2f((bf16)qv[e]); k[e] = bf2f((bf16)kv[e]); sq += q[e] * q[e]; sk += k[e] * k[e]; }
    sq = sum8(sq); sk = sum8(sk);
    const float rq = __builtin_amdgcn_rsqf(sq * (1.f / 64.f) + EPS) * att::QSCALE, rk = __builtin_amdgcn_rsqf(sk * (1.f / 64.f) + EPS);
    const f32x4 gq0 = *(const f32x4*)(a.qn_g + l * 64 + d), gq1 = *(const f32x4*)(a.qn_g + l * 64 + d + 4), gk0 = *(const f32x4*)(a.kn_g + l * 64 + d), gk1 = *(const f32x4*)(a.kn_g + l * 64 + d + 4);
    const float gq[8] = {gq0.x, gq0.y, gq0.z, gq0.w, gq1.x, gq1.y, gq1.z, gq1.w}, gk[8] = {gk0.x, gk0.y, gk0.z, gk0.w, gk1.x, gk1.y, gk1.z, gk1.w};
    float nq = 0.f, nk = 0.f;
#pragma unroll
    for (int e = 0; e < 8; ++e) { q[e] *= rq * gq[e]; k[e] *= rk * gk[e]; const float qr = rbf(q[e]), kr = rbf(k[e]); nq += qr * qr; nk += kr * kr; }
    qmax2 = fmaxf(qmax2, sum8(nq)); kmax2 = fmaxf(kmax2, sum8(nk));
    u32x4 qo, ko; qo.x = pk2(q[0], q[1]); qo.y = pk2(q[2], q[3]); qo.z = pk2(q[4], q[5]); qo.w = pk2(q[6], q[7]); ko.x = pk2(k[0], k[1]); ko.y = pk2(k[2], k[3]); ko.z = pk2(k[4], k[5]); ko.w = pk2(k[6], k[7]);
    *(u32x4*)(a.qn + (size_t)row * 512 + c0) = qo;
    const size_t kvrow = isS ? (size_t)b * (PAST + DS) + PAST + t : (size_t)row; bf16* kd = isS ? a.kc : a.kp; bf16* vd = isS ? a.vc : a.vp;
    *(u32x4*)(kd + kvrow * 512 + c0) = ko; *(u32x4*)(vd + kvrow * 512 + c0) = vv;
    float* ko_f = a.out + (isS ? O_KS + ((size_t)(l * DB + b) * DS + t) * 512 : O_KP + ((size_t)l * SEQ + t) * 512) + c0;
    float* vo_f = a.out + (isS ? O_VS + ((size_t)(l * DB + b) * DS + t) * 512 : O_VP + ((size_t)l * SEQ + t) * 512) + c0;
    *(f32x4*)(ko_f) = (f32x4){k[0], k[1], k[2], k[3]}; *(f32x4*)(ko_f + 4) = (f32x4){k[4], k[5], k[6], k[7]};
    *(f32x4*)(vo_f) = (f32x4){bf2f((bf16)(vv.x & 0xffff)), bf2f((bf16)(vv.x >> 16)), bf2f((bf16)(vv.y & 0xffff)), bf2f((bf16)(vv.y >> 16))};
    *(f32x4*)(vo_f + 4) = (f32x4){bf2f((bf16)(vv.z & 0xffff)), bf2f((bf16)(vv.z >> 16)), bf2f((bf16)(vv.w & 0xffff)), bf2f((bf16)(vv.w >> 16))};
    if (t >= L - 3) { const int idx = t - (L - 3);
        float* dst = a.out + (isS ? O_CS + ((size_t)(l * DB + b) * 3 + idx) * CONV_DIM : O_CP + (size_t)(l * 3 + idx) * CONV_DIM);
        for (int c = lane; c < CONV_DIM; c += 64) dst[c] = bf2f(pr[C_XBC + c]); }
}
__device__ __forceinline__ void cache_convert(const float* __restrict__ ck, const float* __restrict__ cv, bf16* __restrict__ kc, bf16* __restrict__ vc, int layer, int gtid, int ngt, float& kmax2) {
    const size_t n8 = (size_t)DB * PAST * 512 / 8; const float* sk = ck + (size_t)layer * DB * PAST * 512; const float* sv = cv + (size_t)layer * DB * PAST * 512;
    for (size_t i = gtid; i < n8; i += ngt) { const size_t e = i * 8, row = e >> 9, col = e & 511, b = row / PAST, pos = row % PAST; const size_t d = (b * (PAST + DS) + pos) * 512 + col;
        const f32x4 a0 = *(const f32x4*)(sk + e), a1 = *(const f32x4*)(sk + e + 4), b0 = *(const f32x4*)(sv + e), b1 = *(const f32x4*)(sv + e + 4);
        u32x4 o; o.x = pk2(a0.x, a0.y); o.y = pk2(a0.z, a0.w); o.z = pk2(a1.x, a1.y); o.w = pk2(a1.z, a1.w); *(u32x4*)(kc + d) = o;
        { float ss = 0.f; const float v8[8] = {a0.x, a0.y, a0.z, a0.w, a1.x, a1.y, a1.z, a1.w};
#pragma unroll
          for (int j = 0; j < 8; ++j) { const float r = rbf(v8[j]); ss += r * r; }
          ss += dpp_xor1(ss); ss += dpp_xor2(ss); ss += swz_xor4(ss); kmax2 = fmaxf(kmax2, ss); }
        o.x = pk2(b0.x, b0.y); o.y = pk2(b0.z, b0.w); o.z = pk2(b1.x, b1.y); o.w = pk2(b1.z, b1.w); *(u32x4*)(vc + d) = o; }
}
__device__ __forceinline__ void cache_convert_queue(const float* __restrict__ ck, const float* __restrict__ cv, bf16* __restrict__ kc, bf16* __restrict__ vc, int layer, unsigned* qword, unsigned* kmax_word,
                                                    volatile LAS unsigned* qw, int tid, int lane, unsigned ch0 = 0u, unsigned nch = 512u) {
    const float* sk = ck + (size_t)layer * DB * PAST * 512; const float* sv = cv + (size_t)layer * DB * PAST * 512; float kmax2 = 0.f;
    for (;;) {
        if (tid == 0) qw[0] = atomicAdd(qword, 1u);
        __syncthreads(); const unsigned cq = qw[0]; __syncthreads();
        if (cq >= nch) break;
        const unsigned ch = ch0 + cq;
#pragma unroll 1
        for (int it0 = 0; it0 < 16; it0 += 4) { f32x4 A0[4], A1[4], B0[4], B1[4];
#pragma unroll
            for (int j = 0; j < 4; ++j) { const size_t e = ((size_t)ch * 8192 + (it0 + j) * 512 + tid) * 8; A0[j] = *(const f32x4*)(sk + e); A1[j] = *(const f32x4*)(sk + e + 4); B0[j] = *(const f32x4*)(sv + e); B1[j] = *(const f32x4*)(sv + e + 4); }
#pragma unroll
            for (int j = 0; j < 4; ++j) { const size_t e = ((size_t)ch * 8192 + (it0 + j) * 512 + tid) * 8, row = e >> 9, col = e & 511, b = row / PAST, pos = row % PAST; const size_t d = (b * (PAST + DS) + pos) * 512 + col;
                const f32x4 a0 = A0[j], a1 = A1[j], b0 = B0[j], b1 = B1[j];
                u32x4 o; o.x = pk2(a0.x, a0.y); o.y = pk2(a0.z, a0.w); o.z = pk2(a1.x, a1.y); o.w = pk2(a1.z, a1.w); *(u32x4*)(kc + d) = o;
                { float ss = 0.f; const float v8[8] = {a0.x, a0.y, a0.z, a0.w, a1.x, a1.y, a1.z, a1.w};
#pragma unroll
                  for (int q = 0; q < 8; ++q) { const float r = rbf(v8[q]); ss += r * r; }
                  ss += dpp_xor1(ss); ss += dpp_xor2(ss); ss += swz_xor4(ss); kmax2 = fmaxf(kmax2, ss); }
                o.x = pk2(b0.x, b0.y); o.y = pk2(b0.z, b0.w); o.z = pk2(b1.x, b1.y); o.w = pk2(b1.z, b1.w); *(u32x4*)(vc + d) = o; } }
    }
    kmax2 = wave_max(kmax2); if (lane == 0 && kmax2 > 0.f) atomicMax(kmax_word, __float_as_uint(kmax2));
}
constexpr int NCONV = 160;
#ifndef WGM_IN
#define WGM_IN 4
#endif
#ifndef WGM_M1
#define WGM_M1 4
#endif
constexpr int RING_OFF = 0, RING_BYTES = 131072, LDSCTL_OFF = RING_BYTES, MISC_OFF = LDSCTL_OFF + 320, LDS_BYTES = 147456;
constexpr int CW_GSL = 65536;
constexpr int CW_TMO = 0, CW_CODE = 1, CW_BAR = 4096, CW_LAM = 8192, CW_QMAX = 8320, CW_KMAX = 8448, CW_QSCAN = 8576, CW_QATT = 8704, CW_QCONV = 12288  , CW_QPRE = 8832  , CW_SEG = 16384;
constexpr int NWAVES = 8;
__device__ int probe_reps[12] = {1, 1, 1, 1, 1, 1, 1, 1, 1, 1, 1, 1};
#define REPS(k) __builtin_amdgcn_readfirstlane(probe_reps[k])
__device__ int probe_scan = 1;
struct Params { const float* in[26]; float* out; unsigned char* ws; };
enum { I_XP = 0, I_XS, I_CK, I_CV, I_STCONV, I_STSSD, I_STGLA, I_N1G, I_WIN, I_CONVW, I_CONVB, I_DTB, I_ALOG, I_SSDD, I_SSDNG, I_QNG, I_KNG, I_DLAM, I_DOUTG, I_WA2, I_GBA, I_GLANG, I_WOUT, I_N2G, I_W1, I_W2, I_OUT, I_WS };
typedef const float* cfp;
typedef const __attribute__((address_space(4))) cfp* kargp;
__device__ __forceinline__ kargp kargs_opaque() { kargp p = (kargp)__builtin_amdgcn_kernarg_segment_ptr(); asm volatile("" : "+s"(p)); return p; }
#define PHASE_ENTER() \
    const kargp ka = kargs_opaque(); const int wave = opaque_s(wave_s), lane = opaque_v(lane_id()), tid = wave * 64 + lane; \
    const int bx = opaque_s((int)blockIdx.x), G = (int)gridDim.x; const int gw = bx * NWAVES + wave, ngw = G * NWAVES, vb = tid >> 8, vt = tid & 255, nvb = 2 * G; \
    unsigned char* const ws = (unsigned char*)ka[I_WS]; float* const out = (float*)ka[I_OUT]; \
    (void)lane; (void)gw; (void)ngw; (void)vb; (void)vt; (void)nvb; (void)ws; (void)out
#define WSP(T, off) ((T*)(ws + (off)))

__global__ void __launch_bounds__(NWAVES * 64, 2) fwd_kernel(Params P) {
    extern __shared__ __attribute__((aligned(16))) unsigned char lds[];
    LAS unsigned char* const ldsp = (LAS unsigned char*)lds;
    XcdBarrier bar;
    const int wave_s = __builtin_amdgcn_readfirstlane((int)threadIdx.x >> 6);
    {
        PHASE_ENTER();
        volatile LAS unsigned* const MISC = (volatile LAS unsigned*)(ldsp + MISC_OFF);
        for (int u = tid; u < (LDS_BYTES - LDSCTL_OFF) / 4; u += NWAVES * 64) ((LAS unsigned*)(ldsp + LDSCTL_OFF))[u] = 0u;
        __syncthreads();
        bar = xcd_barrier_post((unsigned*)(WSP(unsigned, WS_CTL) + CW_BAR), MISC + 8);
        LAS float* scr = (LAS float*)(ldsp + RING_OFF + wave * 16384);
        for (int rep = REPS(0) - 1; rep >= 0; --rep) {
        transpose_w(ka[I_WIN], ka[I_N1G], DM, IN_COLS, WSP(bf16, WS_WIN), NPAD, 1, scr, gw, ngw, lane);
        if (gw == 0 && lane < DEPTH) scalars_body(ka[I_DLAM], WSP(float, WS_CTL) + CW_LAM, lane);
        for (int row = gw; row < NROW; row += ngw) xrow_to_bf16(ka[I_XP], ka[I_XS], WSP(bf16, WS_H), WSP(float, WS_SUMSQ), row, lane);
        }
        for (int i = bx * (NWAVES * 64) + tid; i < 3 * NROW; i += G * NWAVES * 64) (WSP(float, WS_SUMSQ) + NROW)[i] = 0.f;
    }
#define GRID_BAR() do { XcdBarrier b_ = bar; asm volatile("" : "+s"(b_.bar), "+s"(b_.x)); xcd_barrier(b_); } while (0)
    GRID_BAR();
    for (int rep = REPS(3) - 1; rep > 0; --rep) GRID_BAR();
    for (int l = 0; l < DEPTH; ++l) {
        for (int rep = REPS(1) - 1; rep >= 0; --rep) {
        { PHASE_ENTER();
          pg8::Gemm g{WSP(bf16, WS_H), WSP(bf16, WS_WIN) + (size_t)l * NPAD * DM, NROW, NPAD, DM}; pg8::StaticOrder S; S.init(NROW, NPAD, G, bx, DM); S.wgm = WGM_IN;
          pg8::EpiInProj E{WSP(bf16, WS_PROJ), WSP(float, WS_DTGA), WSP(float, WS_SUMSQ) + (size_t)(2 * l) * NROW};
          pg8::gemm_phase<pg8::EpiInProj, pg8::StaticOrder, true, true>(ldsp + RING_OFF, g, S, E, tid);
          if (rep == 0) { if (l == 0) cache_convert_queue(ka[I_CK], ka[I_CV], WSP(bf16, WS_KC), WSP(bf16, WS_VC), 0, WSP(unsigned, WS_CTL) + CW_QCONV, WSP(unsigned, WS_CTL) + CW_KMAX,
                                                      (volatile LAS unsigned*)(ldsp + MISC_OFF) + 12, tid, lane);
                          else cache_convert_queue(ka[I_CK], ka[I_CV], WSP(bf16, WS_KC), WSP(bf16, WS_VC), l, WSP(unsigned, WS_CTL) + CW_QCONV + 16 * l + 8, WSP(unsigned, WS_CTL) + CW_KMAX + 64 * l,
                                                      (volatile LAS unsigned*)(ldsp + MISC_OFF) + 12, tid, lane, 256u, 256u); } }
                if (rep > 0) GRID_BAR(); }
        GRID_BAR();
        { PHASE_ENTER();
          PrepArgs pa; pa.proj = WSP(bf16, WS_PROJ); pa.dtga = WSP(float, WS_DTGA); pa.conv_state = ka[I_STCONV]; pa.conv_w = ka[I_CONVW]; pa.conv_b = ka[I_CONVB]; pa.dt_bias = ka[I_DTB]; pa.wa2 = ka[I_WA2]; pa.ba = ka[I_GBA];
          pa.qn_g = ka[I_QNG]; pa.kn_g = ka[I_KNG]; pa.xc = nullptr; pa.dt = nullptr; pa.loga = nullptr; pa.qn = WSP(bf16, WS_QN); pa.kp = WSP(bf16, WS_KP); pa.vp = WSP(bf16, WS_VP); pa.kc = WSP(bf16, WS_KC); pa.vc = WSP(bf16, WS_VC); pa.out = out; pa.layer = l; pa.pad = 0;
          float qmax2 = 0.f, kmax2 = 0.f;
          for (int rep = REPS(6) - 1; rep >= 0; --rep)
#pragma unroll 3
          for (int row = gw; row < NROW; row += ngw) prep_row(pa, row, lane, qmax2, kmax2);
          qmax2 = wave_max(qmax2); kmax2 = wave_max(kmax2);
          if (lane == 0) { atomicMax(WSP(unsigned, WS_CTL) + CW_QMAX + 64 * l, __float_as_uint(qmax2)); atomicMax(WSP(unsigned, WS_CTL) + CW_KMAX + 64 * l, __float_as_uint(kmax2)); } }
        { PHASE_ENTER();
          ssdc::Args sa; sa.proj = WSP(bf16, WS_PROJ); sa.dtga = WSP(float, WS_DTGA); sa.dt_bias = ka[I_DTB]; sa.conv_state = ka[I_STCONV]; sa.conv_w = ka[I_CONVW]; sa.conv_b = ka[I_CONVB]; sa.a_log = ka[I_ALOG]; sa.dpar = ka[I_SSDD];
          sa.norm_g = ka[I_SSDNG]; sa.states = WSP(bf16, WS_SSTATE); sa.decay = WSP(float, WS_SDECAY); sa.hin = WSP(bf16, WS_HIN); sa.mix = WSP(bf16, WS_MIX); sa.layer = l; sa.pad = 0;
          for (int rep = REPS(8) - 1; rep >= 0; --rep)
          { volatile LAS unsigned* qw = (volatile LAS unsigned*)(ldsp + MISC_OFF) + 12;
            for (;;) { if (tid == 0) qw[0] = atomicAdd(WSP(unsigned, WS_CTL) + CW_QPRE + 0 + 64 * l + 1024 * rep, 1u);
                lds_barrier(); const int u = (int)qw[0]; lds_barrier(); if (u >= 576) break; ssdc::pre_unit(sa, u >> 1, u & 1, ldsp + RING_OFF, tid); } } }
        { PHASE_ENTER();
          glac::Args ga; ga.proj = WSP(bf16, WS_PROJ); ga.dtga = WSP(float, WS_DTGA); ga.wa2 = ka[I_WA2]; ga.ba = ka[I_GBA]; ga.norm_g = ka[I_GLANG]; ga.btab = out  ; ga.states = WSP(bf16, WS_GSTATE); ga.decay = WSP(float, WS_GDECAY); ga.hin = WSP(bf16, WS_GHIN); ga.mix = WSP(bf16, WS_MIX); ga.layer = l; ga.pad = 0;
          for (int rep = REPS(9) - 1; rep >= 0; --rep)
          { volatile LAS unsigned* qw = (volatile LAS unsigned*)(ldsp + MISC_OFF) + 12;
            for (;;) { if (tid == 0) qw[0] = atomicAdd(WSP(unsigned, WS_CTL) + CW_QPRE + 16 + 64 * l + 1024 * rep, 1u);
                lds_barrier(); const int u = (int)qw[0]; lds_barrier(); if (u >= 1152) break; glac::pre_unit(ga, u >> 2, u & 3, ldsp + RING_OFF, tid); } } }
        GRID_BAR();
        for (int rep = (int)__builtin_amdgcn_readfirstlane(probe_scan) - 1; rep >= 0; --rep) {
        { PHASE_ENTER();
          ssdc::ScanArgs sc; sc.states = WSP(bf16, WS_SSTATE); sc.decay = WSP(float, WS_SDECAY); sc.state_in = ka[I_STSSD]; sc.hin = WSP(bf16, WS_HIN); sc.out = out; sc.layer = l; sc.pad = 0;
          glac::ScanArgs gc; gc.states = WSP(bf16, WS_GSTATE); gc.decay = WSP(float, WS_GDECAY); gc.state_in = ka[I_STGLA]; gc.hin = WSP(bf16, WS_GHIN); gc.out = out; gc.layer = l; gc.pad = 0;
          volatile LAS unsigned* qw = (volatile LAS unsigned*)(ldsp + MISC_OFF) + 12;
          for (;;) {
              if (tid == 0) qw[0] = atomicAdd(WSP(unsigned, WS_CTL) + CW_QSCAN + 64 * l + 32 * rep, 1u);
              lds_barrier(); const int it = (int)qw[0]; lds_barrier();
              if (it >= 160) break;
              if (it < 64) ssdc::scan_prompt(sc, it * 512 + tid);
              else if (it < 80) glac::scan_prompt(gc, (it - 64) * 512 + tid);
              else if (it < 144) { for (int b = 0; b < DB; b += 8) ssdc::scan_sample8(sc, b, (it - 80) * 512 + tid); }
              else { for (int b = 0; b < DB; b += 8) glac::scan_sample8(gc, b, (it - 144) * 512 + tid); } } }
        if (rep > 0) GRID_BAR(); }
        for (;;) { int conv_item = -1;
        { PHASE_ENTER();
          att::Tensors T; T.QN = WSP(bf16, WS_QN); T.MIX = WSP(bf16, WS_MIX); T.out_g = ka[I_DOUTG] + l * 128; T.lam = (WSP(float, WS_CTL) + CW_LAM)[l]; T.lam_init_c = 1.f - (0.8f - 0.6f * expf(-0.3f * (float)l));
          T.part = WSP(float, WS_APART); T.segcnt = WSP(unsigned, WS_CTL) + CW_SEG + 16384 * l; T.bound = sqrtf((WSP(float, WS_CTL) + CW_QMAX)[64 * l] * (WSP(float, WS_CTL) + CW_KMAX)[64 * l]) * 1.01f + 0.01f; T.kmax = sqrtf((WSP(float, WS_CTL) + CW_KMAX)[64 * l]);
          volatile LAS unsigned* qw = (volatile LAS unsigned*)(ldsp + MISC_OFF) + 12;
          for (;;) {
              if (tid == 0) qw[0] = atomicAdd(WSP(unsigned, WS_CTL) + CW_QATT + 64 * l, 1u);
              lds_barrier(); int it = (int)qw[0]; lds_barrier();
              if (it >= ATT_NITEMS + (l == 0 ? NCONV : 0)) break;
              if (l == 0) { if (it < 5 * NCONV) { if (it % 5 == 4) { conv_item = it / 5; break; } it -= it / 5; } else it -= NCONV; }
              const unsigned w = att_items[it]; const int jb = (w >> 3) & 255;
              att::Unit u; u.h = (w >> 1) & 3; u.nseg = 1 + ((w >> 11) & 1); u.seg = (w >> 12) & 1; u.pidx = (w >> 13) & 255; u.pad = 0;
              if (w & 1) { u.K = WSP(bf16, WS_KC) + (size_t)jb * (PAST + DS) * 512; u.V = WSP(bf16, WS_VC) + (size_t)jb * (PAST + DS) * 512; u.qrow0 = SEQ + DS * jb; u.chunkA = PAST / 64; u.chunkB = -1; }
              else { u.K = WSP(bf16, WS_KP); u.V = WSP(bf16, WS_VP); u.qrow0 = 128 * jb; u.chunkA = 2 * jb; u.chunkB = 2 * jb + 1; }
              att::attn_unit(u, T, ldsp + RING_OFF, tid); } }
        if (conv_item < 0) break;
        { PHASE_ENTER();
          const int cg = conv_item * NWAVES + wave, cn = NCONV * NWAVES; LAS float* scr = (LAS float*)(ldsp + RING_OFF + wave * 16384);
          transpose_w4(ka[I_WOUT], nullptr, DM, DM, WSP(bf16, WS_WOUT), DM, 0, scr, cg, cn, lane);
          transpose_w4(ka[I_W1], ka[I_N2G], DM, DFF, WSP(bf16, WS_W1), DFF, 0, scr, cg, cn, lane);
          transpose_w4(ka[I_W2], nullptr, DFF, DM, WSP(bf16, WS_W2), DM, 0, scr, cg, cn, lane);
          transpose_w4(ka[I_WIN] + (size_t)DM * IN_COLS, ka[I_N1G] + DM, DM, IN_COLS, WSP(bf16, WS_WIN) + (size_t)NPAD * DM, NPAD, 1, scr, cg, cn, lane);
          transpose_w4(ka[I_WOUT] + (size_t)DM * DM, nullptr, DM, DM, WSP(bf16, WS_WOUT) + (size_t)DM * DM, DM, 0, scr, cg, cn, lane);
          transpose_w4(ka[I_W1] + (size_t)DM * DFF, ka[I_N2G] + DM, DM, DFF, WSP(bf16, WS_W1) + (size_t)DFF * DM, DFF, 0, scr, cg, cn, lane);
          transpose_w4(ka[I_W2] + (size_t)DFF * DM, nullptr, DFF, DM, WSP(bf16, WS_W2) + (size_t)DM * DFF, DM, 0, scr, cg, cn, lane);
          __syncthreads(); } }
        GRID_BAR();
        { PHASE_ENTER();
          ssdc::Args sa; sa.proj = WSP(bf16, WS_PROJ); sa.dtga = WSP(float, WS_DTGA); sa.dt_bias = ka[I_DTB]; sa.conv_state = ka[I_STCONV]; sa.conv_w = ka[I_CONVW]; sa.conv_b = ka[I_CONVB]; sa.a_log = ka[I_ALOG]; sa.dpar = ka[I_SSDD];
          sa.norm_g = ka[I_SSDNG]; sa.states = WSP(bf16, WS_SSTATE); sa.decay = WSP(float, WS_SDECAY); sa.hin = WSP(bf16, WS_HIN); sa.mix = WSP(bf16, WS_MIX); sa.layer = l; sa.pad = 0;
          for (int rep = REPS(10) - 1; rep >= 0; --rep)
          { volatile LAS unsigned* qw = (volatile LAS unsigned*)(ldsp + MISC_OFF) + 12;
            for (;;) { if (tid == 0) qw[0] = atomicAdd(WSP(unsigned, WS_CTL) + CW_QPRE + 32 + 64 * l + 1024 * rep, 1u);
                lds_barrier(); const int u = (int)qw[0]; lds_barrier(); if (u >= 576) break; ssdc::post_unit(sa, u >> 1, u & 1, ldsp + RING_OFF, tid); } } }
        { PHASE_ENTER();
          glac::Args ga; ga.proj = WSP(bf16, WS_PROJ); ga.dtga = WSP(float, WS_DTGA); ga.wa2 = ka[I_WA2]; ga.ba = ka[I_GBA]; ga.norm_g = ka[I_GLANG]; ga.btab = out  ; ga.states = WSP(bf16, WS_GSTATE); ga.decay = WSP(float, WS_GDECAY); ga.hin = WSP(bf16, WS_GHIN); ga.mix = WSP(bf16, WS_MIX); ga.layer = l; ga.pad = 0;
          for (int rep = REPS(11) - 1; rep >= 0; --rep)
          { volatile LAS unsigned* qw = (volatile LAS unsigned*)(ldsp + MISC_OFF) + 12;
            for (;;) { if (tid == 0) qw[0] = atomicAdd(WSP(unsigned, WS_CTL) + CW_QPRE + 48 + 64 * l + 1024 * rep, 1u);
                lds_barrier(); const int u = (int)qw[0]; lds_barrier(); if (u >= 1152) break; glac::post_unit(ga, u >> 2, u & 3, ldsp + RING_OFF, tid); } } }
        GRID_BAR();
        for (int rep = REPS(2) - 1; rep >= 0; --rep) {
        { PHASE_ENTER();
          pg8::Gemm g{WSP(bf16, WS_MIX), WSP(bf16, WS_WOUT) + (size_t)l * DM * DM, NROW, DM, DM}; pg8::StaticOrder S; S.init(NROW, DM, G, bx, DM);
          pg8::EpiResid E{ka[I_XP], ka[I_XS], l == 0 ? nullptr : WSP(bf16, WS_H), nullptr, rep > 0 ? (bf16*)(ws + 623 * MiB) : WSP(bf16, WS_H), WSP(float, WS_SUMSQ) + (size_t)(2 * l + 1) * NROW, nullptr};
          pg8::gemm_phase<pg8::EpiResid, pg8::StaticOrder, true, true>(ldsp + RING_OFF, g, S, E, tid);
          if (l + 1 < DEPTH && rep == 0) cache_convert_queue(ka[I_CK], ka[I_CV], WSP(bf16, WS_KC), WSP(bf16, WS_VC), l + 1, WSP(unsigned, WS_CTL) + CW_QCONV + 16 * (l + 1), WSP(unsigned, WS_CTL) + CW_KMAX + 64 * (l + 1),
                                                              (volatile LAS unsigned*)(ldsp + MISC_OFF) + 12, tid, lane, 0u, 256u); }
                if (rep > 0) GRID_BAR(); }
        GRID_BAR();
        for (int rep = REPS(4) - 1; rep >= 0; --rep) {
        { PHASE_ENTER();
          pg8::Gemm g{WSP(bf16, WS_H), WSP(bf16, WS_W1) + (size_t)l * DFF * DM, NROW, DFF, DM}; pg8::StaticOrder S; S.init(NROW, DFF, G, bx, DM); S.wgm = WGM_M1;
          pg8::EpiRelu2 E{WSP(bf16, WS_HID), (long)DFF};
          pg8::gemm_phase<pg8::EpiRelu2, pg8::StaticOrder, true, true>(ldsp + RING_OFF, g, S, E, tid); }
                if (rep > 0) GRID_BAR(); }
        GRID_BAR();
        for (int rep = REPS(5) - 1; rep >= 0; --rep) {
        { PHASE_ENTER();
          pg8::Gemm g{WSP(bf16, WS_HID), WSP(bf16, WS_W2) + (size_t)l * DM * DFF, NROW, DM, DFF}; pg8::StaticOrder S; S.init(NROW, DM, G, bx, DFF, (float*)(ws + 623 * MiB)  , WSP(unsigned, WS_CTL) + CW_GSL + (4 * l + 3) * 8192 + (rep > 0 ? 65536 : 0));
          pg8::EpiResid E{nullptr, nullptr, WSP(bf16, WS_H), l + 1 == DEPTH ? out : nullptr, l + 1 == DEPTH ? nullptr : (rep > 0 ? WSP(bf16, WS_MIX) : WSP(bf16, WS_H)), WSP(float, WS_SUMSQ) + (size_t)(2 * l + 2) * NROW, WSP(float, WS_SUMSQ) + (size_t)(2 * l + 1) * NROW};
          pg8::gemm_phase<pg8::EpiResid, pg8::StaticOrder, true, true>(ldsp + RING_OFF, g, S, E, tid); }
        if (rep > 0) GRID_BAR(); }
        if (l + 1 < DEPTH) GRID_BAR();
    }
}

extern "C" void kernel_launch(void* const* d_in, const int* in_sizes, int n_in, void* d_out, int out_size, void* d_ws, size_t ws_size, hipStream_t stream) {
    static int grid = 0;
    if (grid == 0) {
        if (n_in != 26 || out_size != (int)O_END || ws_size < WS_END) { fprintf(stderr, "kernel_launch: unexpected shapes (n_in %d out %d ws %zu)\n", n_in, out_size, ws_size); grid = -1; return; }
        int dev = 0, cus = 0, per_cu = 0;
        if (hipGetDevice(&dev) != hipSuccess || hipDeviceGetAttribute(&cus, hipDeviceAttributeMultiprocessorCount, dev) != hipSuccess) { grid = -1; return; }
        if (hipFuncSetAttribute((const void*)fwd_kernel, hipFuncAttributeMaxDynamicSharedMemorySize, LDS_BYTES) != hipSuccess) { fprintf(stderr, "kernel_launch: hipFuncSetAttribute failed\n"); grid = -1; return; }
        if (hipOccupancyMaxActiveBlocksPerMultiprocessor(&per_cu, (const void*)fwd_kernel, NWAVES * 64, LDS_BYTES) != hipSuccess || per_cu < 1) fprintf(stderr, "kernel_launch: occupancy query says %d\n", per_cu);
        (void)hipGetLastError();
        grid = cus;
    }
    if (grid < 0) return;
    (void)hipMemsetAsync((char*)d_ws + WS_CTL, 0, 1 * MiB, stream);
    Params p{};
    for (int i = 0; i < 26; ++i) p.in[i] = (const float*)d_in[i];
    p.out = (float*)d_out; p.ws = (unsigned char*)d_ws;
    hipLaunchKernelGGL(fwd_kernel, dim3(grid), dim3(NWAVES * 64), LDS_BYTES, stream, p);
}
```

```cpp
#include <hip/hip_runtime.h>
#include <cstdio>
#include <cstdint>
namespace pg8 {
#define PG8_LAS __attribute__((address_space(3)))
typedef unsigned short bf16_t;
typedef short bf16x8 __attribute__((ext_vector_type(8)));
typedef float f32x4 __attribute__((ext_vector_type(4)));
typedef unsigned u32x4 __attribute__((ext_vector_type(4)));
constexpr int BM = 256, BK = 64, HALF = 128, HTB = HALF * BK * 2  , STAGE_BYTES = 8 * HTB, NXCD = 8, WGM = 8;

__host__ __device__ __forceinline__ int lds_byte(int r, int c) { const int st = (r >> 4) * 2 + (c >> 5), rr = r & 15, cc = c & 31, ob = rr * 64 + cc * 2; return st * 1024 + (ob ^ (((ob >> 9) & 1) << 5)); }
__host__ __device__ __forceinline__ void stage_rc(int b, int& R, int& C) { const int st = b / 1024, sb = b % 1024, swz = sb ^ (((sb >> 9) & 1) << 5); R = (st >> 1) * 16 + swz / 64; C = (st & 1) * 32 + (swz % 64) / 2; }
__host__ __device__ __forceinline__ int perm32(int rho) { const int n = rho >> 4, i = rho & 15; return 8 * (i >> 2) + 4 * n + (i & 3); }

struct Unit { int pm, pn, k0, nt, ns, sl, ti; };
struct Gemm { const bf16_t* A; const bf16_t* Bt; int M, N, K; };

struct StaticOrder {
    int nM, nN, nwg, G, c, K, R, T, Sn, wgm; float* slabs; unsigned* cnt;
    __host__ __device__ __forceinline__ void init(int M, int N, int G_, int c_, int K_ = 0, float* slabs_ = nullptr, unsigned* cnt_ = nullptr) { nM = M / BM; nN = N / BM; nwg = nM * nN; G = G_; c = c_; K = K_; slabs = slabs_; cnt = cnt_;
        R = nwg / G; T = nwg - R * G; Sn = 1; wgm = 4;
        if (T > 0 && slabs_) { Sn = G / T; while (Sn > 1 && ((K / Sn) % 128 != 0 || K / Sn < 256)) --Sn; }
        if (!slabs_ || Sn <= 1) { Sn = 1; } }
    __host__ __device__ __forceinline__ void tile(int L, Unit& u) const {
        int wgid = L; { const int q = nwg / NXCD, r = nwg % NXCD, xcd = wgid % NXCD, off = wgid / NXCD; wgid = (xcd < r ? xcd * (q + 1) : r * (q + 1) + (xcd - r) * q) + off; }
        const int nig = wgm * nN, gid = wgid / nig, fm = gid * wgm, gsz = (nM - fm) < wgm ? (nM - fm) : wgm;
        u.pm = fm + ((wgid % nig) % gsz); u.pn = (wgid % nig) / gsz; }
    __host__ __device__ __forceinline__ bool next(int i, Unit& u) const {
        u.k0 = 0; u.nt = K / BK; u.ns = 1; u.sl = 0; u.ti = 0;
        if (Sn > 1 && i >= R) { if (i > R || c >= T * Sn) return false; u.ti = c % T; u.sl = c / T; u.ns = Sn; u.nt = K / BK / Sn; u.k0 = u.sl * (K / Sn); tile(R * G + u.ti, u); return true; }
        const long L = (long)i * G + c; if (L >= nwg) return false;
        tile((int)L, u); return true;
    }
    __device__ __forceinline__ void a_ready(const Unit&) const {}
    __device__ __forceinline__ void done(const Unit&) const {}
};

__device__ __forceinline__ unsigned cvt_pk_bf16(float lo, float hi) { unsigned r; asm volatile("v_cvt_pk_bf16_f32 %0, %1, %2" : "=v"(r) : "v"(lo), "v"(hi)); return r; }
typedef float f32x2 __attribute__((ext_vector_type(2)));
template <class Epi, class Sched, bool ALIGN_EPI = false, bool SP2 = false>
__device__ __forceinline__ void gemm_phase(PG8_LAS unsigned char* lds, const Gemm g, const Sched& S, const Epi& E, int tid_in) {
    int tid_ = tid_in; asm volatile("" : "+v"(tid_));
    const int tid = tid_, wid = __builtin_amdgcn_readfirstlane(tid >> 6), lane = tid & 63, wr = wid >> 2, wc = wid & 3, fr = lane & 15, fq = lane >> 4;
    const int K = g.K;
    unsigned voffA[2], voffB[2];
#pragma unroll
    for (int i = 0; i < 2; ++i) { int R, C; stage_rc(tid * 16 + i * 8192, R, C); const int Rb = Epi::PERM ? ((R & ~31) + perm32(R & 31)) : R;
        voffA[i] = (unsigned)(R * K + C) * 2u; voffB[i] = (unsigned)(Rb * K + C) * 2u; }
    const size_t kstep = (size_t)(BK * 2);
    const size_t hstep = (size_t)HALF * K * 2;
    const size_t tstep = 2 * hstep;
    const unsigned ldsw = (unsigned)wid * 1024u;
    const int aoff = lds_byte(wr * 64 + fr, fq * 8), boff = lds_byte(wc * 32 + fr, fq * 8);
#define PG8_SA(b, h) (((b) * 2 + (h)) * HTB)
#define PG8_SB(b, h) ((4 + (b) * 2 + (h)) * HTB)
#define PG8_STAGE(bufoff, gbase, voff) do { _Pragma("unroll") for (int _i = 0; _i < 2; ++_i) \
        __builtin_amdgcn_global_load_lds((const unsigned*)((const char*)(gbase) + (voff)[_i]), (PG8_LAS unsigned*)(lds + (bufoff) + ldsw + _i * 8192), 16, 0, 0); } while (0)
#define PG8_LDA(dst, b, h) do { _Pragma("unroll") for (int m = 0; m < 4; ++m) _Pragma("unroll") for (int k = 0; k < 2; ++k) dst[m][k] = *(const PG8_LAS bf16x8*)(lds + PG8_SA(b, h) + aoff + m * 2048 + k * 1024); } while (0)
#define PG8_LDB(dst, b, h) do { _Pragma("unroll") for (int n = 0; n < 2; ++n) _Pragma("unroll") for (int k = 0; k < 2; ++k) dst[n][k] = *(const PG8_LAS bf16x8*)(lds + PG8_SB(b, h) + boff + n * 2048 + k * 1024); } while (0)
#define PG8_MMA(ai, bj, At, Bt) do { __builtin_amdgcn_s_setprio(1); _Pragma("unroll") for (int m = 0; m < 4; ++m) _Pragma("unroll") for (int n = 0; n < 2; ++n) _Pragma("unroll") for (int k = 0; k < 2; ++k) \
        acc[ai][bj][m][n] = __builtin_amdgcn_mfma_f32_16x16x32_bf16(Bt[n][k], At[m][k], acc[ai][bj][m][n], 0, 0, 0); __builtin_amdgcn_s_setprio(0); } while (0)
#define PG8_WAIT_V(n) asm volatile("s_waitcnt vmcnt(" #n ")" ::: "memory")
#define PG8_WAIT_L(n) asm volatile("s_waitcnt lgkmcnt(" #n ")" ::: "memory")
#define PG8_BAR __builtin_amdgcn_s_barrier()
#define PG8_SCHED __builtin_amdgcn_sched_barrier(0)
    Unit cur, nxt; int ui = 0;
    if (!S.next(0, cur)) return;
    f32x4 acc[2][2][4][2];
#pragma unroll
    for (int a = 0; a < 2; ++a)
#pragma unroll
        for (int b = 0; b < 2; ++b)
#pragma unroll
            for (int m = 0; m < 4; ++m)
#pragma unroll
                for (int n = 0; n < 2; ++n) acc[a][b][m][n] = (f32x4){0.f, 0.f, 0.f, 0.f};
    bf16x8 At[4][2], B0[2][2], B1[2][2];
    const char* cA = (const char*)g.A + (size_t)cur.pm * tstep + (size_t)cur.k0 * 2; const char* cB = (const char*)g.Bt + (size_t)cur.pn * tstep + (size_t)cur.k0 * 2;
    S.a_ready(cur);
    if constexpr (SP2) {
        PG8_STAGE(PG8_SB(0, 0), cB, voffB); PG8_STAGE(PG8_SB(0, 1), cB + hstep, voffB); PG8_STAGE(PG8_SA(0, 0), cA, voffA); PG8_STAGE(PG8_SA(0, 1), cA + hstep, voffA);
        if (wr == 1) PG8_BAR;
        PG8_WAIT_V(2); PG8_BAR;
        PG8_STAGE(PG8_SB(1, 0), cB + kstep, voffB); PG8_STAGE(PG8_SA(1, 0), cA + kstep, voffA); PG8_STAGE(PG8_SB(1, 1), cB + hstep + kstep, voffB);
        PG8_WAIT_V(6); PG8_BAR;
    } else {
        PG8_STAGE(PG8_SB(0, 0), cB, voffB); PG8_STAGE(PG8_SA(0, 0), cA, voffA); PG8_STAGE(PG8_SB(0, 1), cB + hstep, voffB); PG8_STAGE(PG8_SA(0, 1), cA + hstep, voffA);
        if (wr == 1) PG8_BAR;
        PG8_WAIT_V(4); PG8_BAR;
        PG8_STAGE(PG8_SB(1, 0), cB + kstep, voffB); PG8_STAGE(PG8_SA(1, 0), cA + kstep, voffA); PG8_STAGE(PG8_SB(1, 1), cB + hstep + kstep, voffB);
        PG8_WAIT_V(6); PG8_BAR;
    }
    for (;;) {
        const bool has_next = S.next(ui + 1, nxt);
        const char* nA = has_next ? (const char*)g.A + (size_t)nxt.pm * tstep + (size_t)nxt.k0 * 2 : cA; const char* nB = has_next ? (const char*)g.Bt + (size_t)nxt.pn * tstep + (size_t)nxt.k0 * 2 : cB;
        const int nt = cur.nt;
        for (int t = 0; t < nt; t += 2) {
            const bool last = (t == nt - 2);
            const char* a1 = cA + (size_t)(t + 1) * kstep;
            const char* a2 = last ? nA : cA + (size_t)(t + 2) * kstep; const char* b2 = last ? nB : cB + (size_t)(t + 2) * kstep;
            const char* a3 = a2 + kstep; const char* b3 = b2 + kstep;
            if (last && has_next) S.a_ready(nxt);
            if constexpr (SP2) {
            PG8_LDB(B0, 0, 0); PG8_LDB(B1, 0, 1); PG8_SCHED; PG8_LDA(At, 0, 0); PG8_STAGE(PG8_SA(1, 1), a1 + hstep, voffA);
            PG8_WAIT_V(8); PG8_WAIT_L(0); PG8_BAR; PG8_MMA(0, 0, At, B0); PG8_MMA(0, 1, At, B1); PG8_BAR; PG8_SCHED;
            PG8_LDA(At, 0, 1); PG8_STAGE(PG8_SB(0, 0), b2, voffB); PG8_STAGE(PG8_SB(0, 1), b2 + hstep, voffB); PG8_STAGE(PG8_SA(0, 0), a2, voffA);
            PG8_WAIT_V(8); PG8_WAIT_L(0); PG8_BAR; PG8_MMA(1, 0, At, B0); PG8_MMA(1, 1, At, B1); PG8_BAR; PG8_SCHED;
            PG8_LDB(B0, 1, 0); PG8_LDB(B1, 1, 1); PG8_SCHED; PG8_LDA(At, 1, 0); PG8_STAGE(PG8_SA(0, 1), a2 + hstep, voffA);
            PG8_WAIT_V(8); PG8_WAIT_L(0); PG8_BAR; PG8_MMA(0, 0, At, B0); PG8_MMA(0, 1, At, B1); PG8_BAR; PG8_SCHED;
            PG8_LDA(At, 1, 1); PG8_STAGE(PG8_SB(1, 0), b3, voffB); PG8_STAGE(PG8_SB(1, 1), b3 + hstep, voffB); PG8_STAGE(PG8_SA(1, 0), a3, voffA);
            PG8_WAIT_V(8); PG8_WAIT_L(0); PG8_BAR; PG8_MMA(1, 0, At, B0); PG8_MMA(1, 1, At, B1); PG8_BAR; PG8_SCHED;
            } else {
            PG8_LDB(B0, 0, 0); PG8_SCHED; PG8_LDA(At, 0, 0); PG8_STAGE(PG8_SA(1, 1), a1 + hstep, voffA);
            PG8_WAIT_L(8); PG8_BAR; PG8_WAIT_L(0); PG8_MMA(0, 0, At, B0); PG8_BAR; PG8_SCHED;
            PG8_LDB(B1, 0, 1); PG8_STAGE(PG8_SB(0, 0), b2, voffB);
            PG8_BAR; PG8_WAIT_L(0); PG8_MMA(0, 1, At, B1); PG8_BAR;
            PG8_LDA(At, 0, 1); PG8_STAGE(PG8_SA(0, 0), a2, voffA);
            PG8_BAR; PG8_WAIT_L(0); PG8_MMA(1, 0, At, B0); PG8_BAR; PG8_SCHED;
            PG8_STAGE(PG8_SB(0, 1), b2 + hstep, voffB);
            PG8_WAIT_V(6); PG8_BAR; PG8_MMA(1, 1, At, B1); PG8_BAR;
            PG8_LDB(B0, 1, 0); PG8_SCHED; PG8_LDA(At, 1, 0); PG8_STAGE(PG8_SA(0, 1), a2 + hstep, voffA);
            PG8_WAIT_L(8); PG8_BAR; PG8_WAIT_L(0); PG8_MMA(0, 0, At, B0); PG8_BAR; PG8_SCHED;
            PG8_LDB(B1, 1, 1); PG8_STAGE(PG8_SB(1, 0), b3, voffB);
            PG8_BAR; PG8_WAIT_L(0); PG8_MMA(0, 1, At, B1); PG8_BAR;
            PG8_LDA(At, 1, 1); PG8_STAGE(PG8_SA(1, 0), a3, voffA);
            PG8_BAR; PG8_WAIT_L(0); PG8_MMA(1, 0, At, B0); PG8_BAR; PG8_SCHED;
            PG8_STAGE(PG8_SB(1, 1), b3 + hstep, voffB);
            PG8_WAIT_V(6); PG8_BAR; PG8_MMA(1, 1, At, B1); PG8_BAR;
            }
        }
        if constexpr (ALIGN_EPI) { if (wr == 0) PG8_BAR; }
        if constexpr (!Epi::AFTER_DRAIN) { if (cur.ns == 1) { E(acc, cur, wr, wc, fr, fq); S.done(cur); } }
        if (!has_next) break;
#pragma unroll
        for (int a = 0; a < 2; ++a)
#pragma unroll
            for (int b = 0; b < 2; ++b)
#pragma unroll
                for (int m = 0; m < 4; ++m)
#pragma unroll
                    for (int n = 0; n < 2; ++n) acc[a][b][m][n] = (f32x4){0.f, 0.f, 0.f, 0.f};
        cur = nxt; cA = nA; cB = nB; ++ui;
        if constexpr (ALIGN_EPI) { if (wr == 1) PG8_BAR; }
    }
    PG8_WAIT_V(0);
    if constexpr (!ALIGN_EPI) { if (wr == 0) PG8_BAR; }
    PG8_BAR;
    if constexpr (Epi::AFTER_DRAIN) { E.fused(acc, cur, wr, wc, fr, fq, lds, wid, lane); S.done(cur); }
    else if (cur.ns > 1) {
        float* slab = S.slabs + ((size_t)cur.ti * cur.ns + cur.sl) * (BM * BM);
        { const __amdgpu_buffer_rsrc_t rsrc = __builtin_amdgcn_make_buffer_rsrc(slab, 0, BM * BM * 4, 0x00020000);
#pragma unroll
          for (int a = 0; a < 2; ++a)
#pragma unroll
              for (int b = 0; b < 2; ++b)
#pragma unroll
                  for (int m = 0; m < 4; ++m)
#pragma unroll
                      for (int n = 0; n < 2; ++n) __builtin_amdgcn_raw_buffer_store_b128(__builtin_bit_cast(u32x4, acc[a][b][m][n]), rsrc, ((((a * 2 + b) * 4 + m) * 2 + n) * 512 + tid) * 16, 0, 16); }
        asm volatile("s_waitcnt vmcnt(0)" ::: "memory"); __syncthreads();
        volatile PG8_LAS unsigned* flag = (volatile PG8_LAS unsigned*)lds;
        if (tid == 0) { flag[0] = __hip_atomic_fetch_add(S.cnt + 64 * cur.ti, 1u, __ATOMIC_RELAXED, __HIP_MEMORY_SCOPE_AGENT); }
        __syncthreads();
        const bool lastarr = flag[0] == (unsigned)(cur.ns - 1);
        if (lastarr) {
            if (tid == 0) { __builtin_amdgcn_fence(__ATOMIC_ACQUIRE, "agent"); asm volatile("s_waitcnt vmcnt(0)" ::: "memory"); }
            __syncthreads();
            for (int s2 = 0; s2 < cur.ns; ++s2) if (s2 != cur.sl) { const float* os = S.slabs + ((size_t)cur.ti * cur.ns + s2) * (BM * BM);
#pragma unroll
                for (int ab = 0; ab < 4; ++ab) { f32x4 t[4][2];
#pragma unroll
                    for (int m = 0; m < 4; ++m)
#pragma unroll
                        for (int n = 0; n < 2; ++n) t[m][n] = *(const f32x4*)(os + (unsigned)((((ab * 4 + m) * 2 + n) * 512 + tid) * 4));
                    __builtin_amdgcn_sched_barrier(0);
#pragma unroll
                    for (int m = 0; m < 4; ++m)
#pragma unroll
                        for (int n = 0; n < 2; ++n) acc[ab >> 1][ab & 1][m][n] += t[m][n];
                    __builtin_amdgcn_sched_barrier(0); } }
            E(acc, cur, wr, wc, fr, fq); S.done(cur);
        }
        __syncthreads();
    }
#undef PG8_SA
#undef PG8_SB
#undef PG8_STAGE
#undef PG8_LDA
#undef PG8_LDB
#undef PG8_MMA
#undef PG8_WAIT_V
#undef PG8_WAIT_L
#undef PG8_BAR
#undef PG8_SCHED
}
}
constexpr int DM = 2048, SEQ = 16384, DEPTH = 2, DB = 32, DS = 64, PAST = 2048;
constexpr int NROW = SEQ + DB * DS;
constexpr int SSD_H = 16, SSD_P = 64, SSD_N = 128, CONV_DIM = 1536;
constexpr int NPJ = 5632, NPAD = 5888, DFF = 8192, IN_COLS = 5664;
constexpr float EPS = 1e-6f;
constexpr int C_Z = 0, C_XBC = 1024, C_DQ = 2560, C_DK = 3072, C_DV = 3584, C_GQ = 4096, C_GK = 4352, C_GV = 4608, C_GG = 5120;
constexpr size_t O_Y = 0, O_KP = 37748736, O_VP = 54525952, O_CP = 71303168, O_HP = 71312384, O_SP = 71574528, O_KS = 71640064, O_VS = 73737216,
                 O_CS = 75834368, O_HS = 76129280, O_SS = 84517888, O_END = 86615040;
constexpr size_t MiB = 1u << 20;
constexpr size_t WS_CTL = 0, WS_WIN = 1 * MiB, WS_WOUT = 47 * MiB, WS_W1 = 63 * MiB, WS_W2 = 127 * MiB, WS_H = 191 * MiB, WS_MIX = 263 * MiB,
                 WS_PROJ = 335 * MiB, WS_HID = 335 * MiB  , WS_SSTATE = 533 * MiB, WS_HIN = 677 * MiB, WS_KP = 749 * MiB, WS_VP = 765 * MiB,
                 WS_QN = 785 * MiB, WS_GSTATE = 821 * MiB, WS_DTGA = 857 * MiB, WS_SDECAY = 860 * MiB, WS_KC = 861 * MiB, WS_VC = 927 * MiB, WS_GHIN = 993 * MiB, WS_GDECAY = 1011 * MiB, WS_APART = 1012 * MiB, WS_SUMSQ = 1054 * MiB, WS_END = 1056 * MiB;
typedef unsigned short bf16;
typedef float f32x4 __attribute__((ext_vector_type(4)));
typedef unsigned u32x4 __attribute__((ext_vector_type(4)));
typedef unsigned u32x2 __attribute__((ext_vector_type(2)));
__device__ __forceinline__ unsigned f2bf(float f) { unsigned u = __builtin_bit_cast(unsigned, f); return (u + 0x7fffu + ((u >> 16) & 1u)) >> 16; }
__device__ __forceinline__ unsigned pk2(float lo, float hi) { return f2bf(lo) | (f2bf(hi) << 16); }
__device__ __forceinline__ float bf2f(bf16 b) { return __builtin_bit_cast(float, (unsigned)b << 16); }
__device__ __forceinline__ float silu_f(float x) { return x * __builtin_amdgcn_rcpf(1.f + __expf(-x)); }
__device__ __forceinline__ float softplus_f(float x) { return x > 15.f ? x : __logf(1.f + __expf(x)); }
__device__ __forceinline__ float logsigmoid_f(float x) { return fminf(x, 0.f) - __logf(1.f + __expf(-fabsf(x))); }

#define GAS __attribute__((address_space(1)))
#define LAS __attribute__((address_space(3)))
typedef GAS unsigned gu32;
#define RLX_AGENT __ATOMIC_RELAXED, __HIP_MEMORY_SCOPE_AGENT
__device__ __forceinline__ int opaque_s(int x) { asm volatile("" : "+s"(x)); return x; }
__device__ __forceinline__ int opaque_v(int x) { asm volatile("" : "+v"(x)); return x; }
__device__ __forceinline__ float swz_xor16(float v) { return __builtin_bit_cast(float, __builtin_amdgcn_ds_swizzle(__builtin_bit_cast(int, v), 0x401F)); }
__device__ __forceinline__ float swz_xor8(float v)  { return __builtin_bit_cast(float, __builtin_amdgcn_ds_swizzle(__builtin_bit_cast(int, v), 0x201F)); }
__device__ __forceinline__ float swz_xor4(float v)  { return __builtin_bit_cast(float, __builtin_amdgcn_ds_swizzle(__builtin_bit_cast(int, v), 0x101F)); }
__device__ __forceinline__ float dpp_xor2(float v)  { return __builtin_bit_cast(float, __builtin_amdgcn_mov_dpp(__builtin_bit_cast(int, v), 0x4E, 0xf, 0xf, true)); }
__device__ __forceinline__ float dpp_xor1(float v)  { return __builtin_bit_cast(float, __builtin_amdgcn_mov_dpp(__builtin_bit_cast(int, v), 0xB1, 0xf, 0xf, true)); }
__device__ __forceinline__ float half_sum(float v) {
    v += dpp_xor1(v); v += dpp_xor2(v); v += swz_xor4(v); v += swz_xor8(v); v += swz_xor16(v); return v; }
__device__ __forceinline__ float wave_sum(float v) {
    v = half_sum(v); auto rr = __builtin_amdgcn_permlane32_swap(__float_as_uint(v), __float_as_uint(v), false, false); return __uint_as_float(rr[0]) + __uint_as_float(rr[1]); }
__device__ __forceinline__ int lane_id() { int l; asm volatile("v_mbcnt_lo_u32_b32 %0, -1, 0\n\tv_mbcnt_hi_u32_b32 %0, -1, %0" : "=v"(l)); return l; }
__device__ __forceinline__ float half_max(float v) {
    v = fmaxf(v, dpp_xor1(v)); v = fmaxf(v, dpp_xor2(v)); v = fmaxf(v, swz_xor4(v)); v = fmaxf(v, swz_xor8(v)); v = fmaxf(v, swz_xor16(v)); return v; }
__device__ __forceinline__ float wave_max(float v) {
    v = half_max(v); auto rr = __builtin_amdgcn_permlane32_swap(__float_as_uint(v), __float_as_uint(v), false, false); return fmaxf(__uint_as_float(rr[0]), __uint_as_float(rr[1])); }
__device__ __forceinline__ float rbf(float x) { return __builtin_bit_cast(float, ((__builtin_bit_cast(unsigned, x) + 0x7fffu + ((__builtin_bit_cast(unsigned, x) >> 16) & 1u)) & 0xffff0000u)); }

__device__ __forceinline__ void lds_barrier() { asm volatile("s_waitcnt lgkmcnt(0)\n\ts_barrier" ::: "memory"); }
#define XB_TMO      128
#define XB_XCNT(j)  (256  + 64 * (j))
#define XB_XSUB(j)  (1280 + 64 * (j))
#define XB_XGEN(j)  (2304 + 64 * (j))
#define XB_TOP      3328
#define XB_TOPGEN   3392
#define XCD_BAR_WORDS 3456
#define XB_SPIN_CAP (1u << 23)

__device__ __forceinline__ unsigned xb_ld(unsigned* p)              { return __hip_atomic_load(p, __ATOMIC_RELAXED, __HIP_MEMORY_SCOPE_AGENT); }
__device__ __forceinline__ unsigned xb_add(unsigned* p, unsigned v) { return __hip_atomic_fetch_add(p, v, __ATOMIC_RELAXED, __HIP_MEMORY_SCOPE_AGENT); }
__device__ __forceinline__ unsigned xb_xcc_id() { return (unsigned)__builtin_amdgcn_s_getreg((3 << 11) | 20) & 0xFu; }
#define XB_SPIN(cond, bar) do { unsigned _sp = 0; while (cond) { __builtin_amdgcn_s_sleep(1); \
    if ((++_sp & 255u) == 0u) { if (xb_ld(&(bar)[XB_TMO])) break; if (_sp > XB_SPIN_CAP) { atomicAdd(&(bar)[XB_TMO], 1u); break; } } } } while (0)

struct XcdBarrier {
    unsigned* bar; unsigned x;
    volatile LAS unsigned* st;
};

__device__ __forceinline__ XcdBarrier xcd_barrier_post(unsigned* bar, volatile LAS unsigned* st) {
    XcdBarrier b; b.bar = bar; b.x = xb_xcc_id(); b.st = st;
    if (threadIdx.x == 0) (void)xb_add(&bar[XB_XCNT(b.x)], 1u);
    return b;
}
__device__ __forceinline__ void xcd_barrier_complete(unsigned* bar, unsigned x, unsigned& nloc, unsigned& nx) {
    const unsigned G = gridDim.x * gridDim.y * gridDim.z;
    unsigned sum, cnt, mine, sp = 0u;
    for (;;) {
        sum = 0u; cnt = 0u; mine = 0u;
#pragma unroll
        for (unsigned j = 0; j < 16; ++j) { const unsigned c = xb_ld(&bar[XB_XCNT(j)]); sum += c; cnt += (c > 0u) ? 1u : 0u; mine = (j == x) ? c : mine; }
        if (sum == G) break;
        __builtin_amdgcn_s_sleep(1);
        if ((++sp & 255u) == 0u) { if (xb_ld(&bar[XB_TMO])) break; if (sp > XB_SPIN_CAP) { atomicAdd(&bar[XB_TMO], 1u); break; } }
    }
    nloc = mine > 0u ? mine : 1u; nx = cnt > 0u ? cnt : 1u;
}

__device__ __forceinline__ void xcd_barrier(const XcdBarrier& b) {
    asm volatile("s_waitcnt vmcnt(0)" ::: "memory");
    __syncthreads();
    if (threadIdx.x == 0) {
        unsigned* bar = b.bar;
        __builtin_amdgcn_s_waitcnt(0);
        unsigned nloc = b.st[0], nx = b.st[1];
        if (nloc == 0u) { xcd_barrier_complete(bar, b.x, nloc, nx); b.st[0] = nloc; b.st[1] = nx; }
        const unsigned old = xb_add(&bar[XB_XSUB(b.x)], 1u);
        const unsigned gen = old / nloc;
        if (old + 1u == (gen + 1u) * nloc) {
            __builtin_amdgcn_fence(__ATOMIC_RELEASE, "agent");
            asm volatile("s_waitcnt vmcnt(0)" ::: "memory");
            const unsigned og = xb_add(&bar[XB_TOP], 1u);
            const unsigned tg = og / nx;
            if (og + 1u == (tg + 1u) * nx) xb_add(&bar[XB_TOPGEN], 1u);
            else XB_SPIN(xb_ld(&bar[XB_TOPGEN]) == tg, bar);
            __builtin_amdgcn_fence(__ATOMIC_ACQUIRE, "agent");
            xb_add(&bar[XB_XGEN(b.x)], 1u);
            asm volatile("s_waitcnt vmcnt(0)" ::: "memory");
        } else {
            XB_SPIN(xb_ld(&bar[XB_XGEN(b.x)]) == gen, bar);
            __builtin_amdgcn_fence(__ATOMIC_ACQUIRE, "agent");
            asm volatile("s_waitcnt vmcnt(0)" ::: "memory");
        }
    }
    __syncthreads();
}
namespace pg8 {
__device__ __forceinline__ float row_rstd(const float* ss, int row) { return __builtin_amdgcn_rsqf(ss[row] * (1.f / DM) + EPS); }
struct EpiInProj {
    static constexpr bool PERM = true, AFTER_DRAIN = false;
    bf16_t* P; float* T; const float* ss;
    __device__ __forceinline__ void operator()(const f32x4 (&acc)[2][2][4][2], const Unit& u, int wr, int wc, int fr, int fq) const {
        const int row0 = u.pm * BM + wr * 64 + fr;
        float rsv[2][4];
#pragma unroll
        for (int ai = 0; ai < 2; ++ai)
#pragma unroll
            for (int m = 0; m < 4; ++m) rsv[ai][m] = ss[row0 + ai * HALF + m * 16];
#pragma unroll
        for (int ai = 0; ai < 2; ++ai)
#pragma unroll
            for (int m = 0; m < 4; ++m) rsv[ai][m] = __builtin_amdgcn_rsqf(rsv[ai][m] * (1.f / DM) + EPS);
        if (u.pn < 22) {
            const int col0 = u.pn * BM + wc * 32 + 8 * fq;
#pragma unroll
            for (int ai = 0; ai < 2; ++ai)
#pragma unroll
                for (int m = 0; m < 4; ++m) { const int row = row0 + ai * HALF + m * 16; bf16_t* rowp = P + (size_t)row * NPJ + col0; const float rs = rsv[ai][m];
#pragma unroll
                    for (int bj = 0; bj < 2; ++bj) { const f32x4 v0 = acc[ai][bj][m][0] * rs, v1 = acc[ai][bj][m][1] * rs;
                        u32x4 w; w.x = cvt_pk_bf16(v0[0], v0[1]); w.y = cvt_pk_bf16(v0[2], v0[3]); w.z = cvt_pk_bf16(v1[0], v1[1]); w.w = cvt_pk_bf16(v1[2], v1[3]);
                        *(u32x4*)(rowp + bj * HALF) = w; } }
        } else if (wc == 0) {
#pragma unroll
            for (int ai = 0; ai < 2; ++ai)
#pragma unroll
                for (int m = 0; m < 4; ++m) { const int row = row0 + ai * HALF + m * 16; float* rp = T + (size_t)row * 32 + 8 * fq; const float rs = rsv[ai][m];
                    *(f32x4*)(rp) = acc[ai][0][m][0] * rs; *(f32x4*)(rp + 4) = acc[ai][0][m][1] * rs; }
        }
    }
};
struct EpiResid {
    static constexpr bool PERM = true, AFTER_DRAIN = false;
    const float* xa; const float* xb; const bf16_t* xin; float* out; bf16_t* xbf; float* ssq; const float* ss2;
    __device__ __forceinline__ void operator()(const f32x4 (&acc)[2][2][4][2], const Unit& u, int wr, int wc, int fr, int fq) const {
        const int col0 = u.pn * BM + wc * 32 + 8 * fq, rbase = u.pm * BM + wr * 64 + fr;
        float r2v[2][4];
#pragma unroll
        for (int ai = 0; ai < 2; ++ai)
#pragma unroll
            for (int m = 0; m < 4; ++m) r2v[ai][m] = ss2 ? ss2[rbase + ai * HALF + m * 16] : 0.f;
        if (xin) {
#pragma unroll
            for (int ai = 0; ai < 2; ++ai) { u32x4 bw[1][4][2];
#pragma unroll
                for (int m = 0; m < 4; ++m)
#pragma unroll
                    for (int bj = 0; bj < 2; ++bj) bw[0][m][bj] = *(const u32x4*)(xin + (size_t)(rbase + ai * HALF + m * 16) * DM + col0 + bj * HALF);
#pragma unroll
                for (int m = 0; m < 4; ++m) { const int r = rbase + ai * HALF + m * 16; float sq = 0.f;
                    const float r2 = ss2 ? __builtin_amdgcn_rcpf(r2v[ai][m] * (1.f / DM) + EPS) : 1.f;
#pragma unroll
                    for (int bj = 0; bj < 2; ++bj) { const size_t eo = (size_t)r * DM + col0 + bj * HALF; f32x4 v0, v1; const u32x4 w = bw[0][m][bj];
                        v0[0] = __uint_as_float(w.x << 16); v0[1] = __uint_as_float(w.x & 0xffff0000u); v0[2] = __uint_as_float(w.y << 16); v0[3] = __uint_as_float(w.y & 0xffff0000u);
                        v1[0] = __uint_as_float(w.z << 16); v1[1] = __uint_as_float(w.z & 0xffff0000u); v1[2] = __uint_as_float(w.w << 16); v1[3] = __uint_as_float(w.w & 0xffff0000u);
                        v0 += acc[ai][bj][m][0] * r2; v1 += acc[ai][bj][m][1] * r2;
                        if (out) { *(f32x4*)(out + eo) = v0; *(f32x4*)(out + eo + 4) = v1; }
                        if (xbf) { u32x4 o; o.x = cvt_pk_bf16(v0[0], v0[1]); o.y = cvt_pk_bf16(v0[2], v0[3]); o.z = cvt_pk_bf16(v1[0], v1[1]); o.w = cvt_pk_bf16(v1[2], v1[3]); *(u32x4*)(xbf + eo) = o;
                            sq += ((v0[0] * v0[0] + v0[1] * v0[1]) + (v0[2] * v0[2] + v0[3] * v0[3])) + ((v1[0] * v1[0] + v1[1] * v1[1]) + (v1[2] * v1[2] + v1[3] * v1[3])); } }
                    if (xbf) { sq += swz_xor16(sq); { auto rr = __builtin_amdgcn_permlane32_swap(__float_as_uint(sq), __float_as_uint(sq), false, false); sq = __uint_as_float(rr[0]) + __uint_as_float(rr[1]); }
                        if (fq == 0) atomicAdd(ssq + r, sq); } } }
            return; }
#pragma unroll
        for (int am = 0; am < 4; ++am) { const int ai = am >> 1;
            f32x4 bf[4][2][2];
#pragma unroll
            for (int m = 2 * (am & 1); m < 2 * (am & 1) + 2; ++m) { const int r = rbase + ai * HALF + m * 16; const float* b = (r < SEQ ? xa + (size_t)r * DM : xb + (size_t)(r - SEQ) * DM) + col0;
#pragma unroll
                for (int bj = 0; bj < 2; ++bj) { bf[m][bj][0] = *(const f32x4*)(b + bj * HALF); bf[m][bj][1] = *(const f32x4*)(b + bj * HALF + 4); } }
#pragma unroll
            for (int m = 2 * (am & 1); m < 2 * (am & 1) + 2; ++m) { const int r = rbase + ai * HALF + m * 16; float sq = 0.f;
                const float r2 = ss2 ? __builtin_amdgcn_rcpf(r2v[ai][m] * (1.f / DM) + EPS) : 1.f;
#pragma unroll
                for (int bj = 0; bj < 2; ++bj) { const size_t eo = (size_t)r * DM + col0 + bj * HALF;
                    const f32x4 v0 = bf[m][bj][0] + acc[ai][bj][m][0] * r2, v1 = bf[m][bj][1] + acc[ai][bj][m][1] * r2;
                    if (out) { *(f32x4*)(out + eo) = v0; *(f32x4*)(out + eo + 4) = v1; }
                    if (xbf) { u32x4 o; o.x = cvt_pk_bf16(v0[0], v0[1]); o.y = cvt_pk_bf16(v0[2], v0[3]); o.z = cvt_pk_bf16(v1[0], v1[1]); o.w = cvt_pk_bf16(v1[2], v1[3]); *(u32x4*)(xbf + eo) = o;
                        sq += ((v0[0] * v0[0] + v0[1] * v0[1]) + (v0[2] * v0[2] + v0[3] * v0[3])) + ((v1[0] * v1[0] + v1[1] * v1[1]) + (v1[2] * v1[2] + v1[3] * v1[3])); } }
                if (xbf) { sq += swz_xor16(sq); { auto rr = __builtin_amdgcn_permlane32_swap(__float_as_uint(sq), __float_as_uint(sq), false, false); sq = __uint_as_float(rr[0]) + __uint_as_float(rr[1]); }
                    if (fq == 0) atomicAdd(ssq + r, sq); } } }
    }
};
struct EpiRelu2 {
    static constexpr bool PERM = true, AFTER_DRAIN = false;
    bf16_t* O; long ldc;
    __device__ __forceinline__ void operator()(const f32x4 (&acc)[2][2][4][2], const Unit& u, int wr, int wc, int fr, int fq) const {
        const int row0 = u.pm * BM + wr * 64 + fr, col0 = u.pn * BM + wc * 32 + 8 * fq;
#pragma unroll
        for (int ai = 0; ai < 2; ++ai)
#pragma unroll
            for (int m = 0; m < 4; ++m) { bf16_t* rowp = O + (size_t)(row0 + ai * HALF + m * 16) * ldc + col0;
#pragma unroll
                for (int bj = 0; bj < 2; ++bj) { f32x4 v0 = acc[ai][bj][m][0], v1 = acc[ai][bj][m][1];
#pragma unroll
                    for (int j = 0; j < 4; ++j) { const float a = fmaxf(v0[j], 0.f), b = fmaxf(v1[j], 0.f); v0[j] = a * a; v1[j] = b * b; }
                    u32x4 w; w.x = cvt_pk_bf16(v0[0], v0[1]); w.y = cvt_pk_bf16(v0[2], v0[3]); w.z = cvt_pk_bf16(v1[0], v1[1]); w.w = cvt_pk_bf16(v1[2], v1[3]);
                    *(u32x4*)(rowp + bj * HALF) = w; } }
    }
};
}
namespace att {
typedef short bf16x8 __attribute__((ext_vector_type(8)));
typedef short s16x4 __attribute__((ext_vector_type(4)));
typedef float f32x16 __attribute__((ext_vector_type(16)));
typedef short v4i16_t __attribute__((ext_vector_type(4)));
typedef LAS const unsigned char* lds_cptr;
constexpr int SLOT = 32768, K_OFF = 0, V_OFF = 16384, NSLOT = 4, WS_OFF = NSLOT * SLOT + 1024  , LDS_NEED = WS_OFF + 8 * 256 + 16;
constexpr int PART_FLOATS = 8 * 64 * 64 + 8 * 128;
constexpr float LOG2E = 1.4426950408889634f, QSCALE = 0.125f * LOG2E, THR = 8.0f;
__device__ __forceinline__ int crow(int r, int hi) { return (r & 3) + 8 * (r >> 2) + 4 * hi; }
__device__ __forceinline__ void glds16(const void* gsrc, unsigned lds_dst) { unsigned keep;
    asm volatile("s_mov_b32 %0, m0\n\ts_mov_b32 m0, %2\n\ts_nop 0\n\tglobal_load_lds_dwordx4 %1, off\n\ts_mov_b32 m0, %0" : "=&s"(keep) : "v"(gsrc), "s"(lds_dst) : "memory"); }
__device__ __forceinline__ unsigned cvtpk(float lo, float hi) { typedef float f2 __attribute__((ext_vector_type(2))); typedef __bf16 b2 __attribute__((ext_vector_type(2)));
    f2 v = {lo, hi}; b2 b = __builtin_convertvector(v, b2); return __builtin_bit_cast(unsigned, b); }
__device__ __forceinline__ s16x4 vtr(lds_cptr p) { return __builtin_bit_cast(s16x4, __builtin_amdgcn_ds_read_tr16_b64_v4i16((LAS v4i16_t*)p)); }
#define ATT_MFMA(a, b, c) __builtin_amdgcn_mfma_f32_32x32x16_bf16(a, b, c, 0, 0, 0)
__device__ __forceinline__ int tile_lo(int h, int chunkA, float bound) {
    const float slope2_ = exp2f(-2.f * (float)(h + 1)) * LOG2E, dth = (2.f * bound + THR + 160.f) / slope2_; const float qmin = 64.f * (float)chunkA;
    const float cl = ceilf((qmin - 63.f - dth) * (1.f / 64.f)); int c_lo = cl > 0.f ? (int)cl : 0; if (c_lo > chunkA) c_lo = chunkA; return c_lo;
}
__device__ __forceinline__ void convert_slice(const float* __restrict__ ck, const float* __restrict__ cv, bf16* __restrict__ kc, bf16* __restrict__ vc, int h, int c_lo, int tid) {
    const int tid_o = opaque_v(tid), sub = tid_o & 15, p0 = tid_o >> 4;
    const float* sk = ck + (size_t)h * 128 + sub * 8; const float* sv = cv + (size_t)h * 128 + sub * 8; bf16* dk = kc + (size_t)h * 128 + sub * 8; bf16* dv = vc + (size_t)h * 128 + sub * 8;
#pragma unroll 4
    for (int pos = 64 * c_lo + p0; pos < PAST; pos += 32) {
        const f32x4 a0 = *(const f32x4*)(sk + (size_t)pos * 512), a1 = *(const f32x4*)(sk + (size_t)pos * 512 + 4), b0 = *(const f32x4*)(sv + (size_t)pos * 512), b1 = *(const f32x4*)(sv + (size_t)pos * 512 + 4);
        u32x4 o; o.x = pk2(a0.x, a0.y); o.y = pk2(a0.z, a0.w); o.z = pk2(a1.x, a1.y); o.w = pk2(a1.z, a1.w); *(u32x4*)(dk + (size_t)pos * 512) = o;
        o.x = pk2(b0.x, b0.y); o.y = pk2(b0.z, b0.w); o.z = pk2(b1.x, b1.y); o.w = pk2(b1.z, b1.w); *(u32x4*)(dv + (size_t)pos * 512) = o; }
    asm volatile("s_waitcnt vmcnt(0)" ::: "memory"); __syncthreads();
    if (tid == 0) { __builtin_amdgcn_fence(__ATOMIC_ACQUIRE, "agent"); asm volatile("s_waitcnt vmcnt(0)" ::: "memory"); }
    __syncthreads();
}
struct Unit { const bf16* K; const bf16* V; int qrow0, chunkA, chunkB, h, nseg, seg, pidx, pad; };
struct Tensors { const bf16* QN; bf16* MIX; const float* out_g; float* part; unsigned* segcnt; float lam, lam_init_c, bound, kmax; };

__device__ __forceinline__ void attn_unit(const Unit& u, const Tensors& T, LAS unsigned char* shm, int tid_in) {
    const int tid = opaque_v(tid_in);
    const int lane = tid & 63, r32 = lane & 31, hi = lane >> 5, wid = __builtin_amdgcn_readfirstlane(tid >> 6), g = wid & 3, mp = wid >> 2;
    const int myChunk = g < 2 ? u.chunkA : u.chunkB, c_hi = u.chunkA > u.chunkB ? u.chunkA : u.chunkB, qi = 32 * (g & 1) + r32, h = u.h;
    const bool active = myChunk >= 0;
    int c_lo = tile_lo(u.h, u.chunkA, T.bound);
    int c_top = c_hi;
    if (u.nseg == 2) { const int c_mid = c_lo + ((c_hi - c_lo) >> 1); if (u.seg == 0) c_lo = c_mid + 1; else c_top = c_mid; }
    const unsigned lds0 = (unsigned)(uintptr_t)shm;
    LAS float* wsf = (LAS float*)(shm + WS_OFF) + wid * 64;
    const float slope2 = exp2f(-2.f * (float)(h + 1)) * LOG2E;
    const bf16* ksrc = u.K + (size_t)lane * 512 + h * 128 + wid * 8;
    const bf16* vsrc = u.V + (size_t)(16 * (wid & 3) + (lane >> 2)) * 512 + h * 128 + (wid >> 2) * 32 + (lane & 3) * 8;
#define ATT_DMA(tile, slot) do { const size_t to_ = (size_t)(tile) * 64 * 512; const unsigned sb_ = lds0 + (slot) * SLOT; \
        glds16(ksrc + to_, (unsigned)__builtin_amdgcn_readfirstlane(sb_ + K_OFF + wid * 1024)); glds16(ksrc + to_ + 64, (unsigned)__builtin_amdgcn_readfirstlane(sb_ + K_OFF + 8192 + wid * 1024)); \
        glds16(vsrc + to_, (unsigned)__builtin_amdgcn_readfirstlane(sb_ + V_OFF + (wid >> 2) * 4096 + (wid & 3) * 1024)); \
        glds16(vsrc + to_ + 64, (unsigned)__builtin_amdgcn_readfirstlane(sb_ + V_OFF + ((wid >> 2) + 2) * 4096 + (wid & 3) * 1024)); } while (0)
    ATT_DMA(c_top, 0);
    bf16x8 qr[4];
#pragma unroll
    for (int d0 = 0; d0 < 4; ++d0) qr[d0] = active ? *(const bf16x8*)(T.QN + (size_t)(u.qrow0 + 32 * g + r32) * 512 + h * 128 + mp * 64 + d0 * 16 + hi * 8) : (bf16x8){0, 0, 0, 0, 0, 0, 0, 0};
#pragma unroll
    for (int d0 = 0; d0 < 4; ++d0) asm volatile("" : "+v"(qr[d0]));
    f32x16 o[4];
#pragma unroll
    for (int d = 0; d < 4; ++d) o[d] = (f32x16){0.f, 0.f, 0.f, 0.f, 0.f, 0.f, 0.f, 0.f, 0.f, 0.f, 0.f, 0.f, 0.f, 0.f, 0.f, 0.f};
    const bool fixedref = T.bound < 40.f;
    float mhat = 0.f, l_reg = 0.f; bool first = true;
    if (fixedref) { float nq = 0.f;
#pragma unroll
        for (int d0 = 0; d0 < 4; ++d0)
#pragma unroll
            for (int e = 0; e < 8; ++e) { const float v = bf2f((bf16)qr[d0][e]); nq += v * v; }
        { auto rr = __builtin_amdgcn_permlane32_swap(__float_as_uint(nq), __float_as_uint(nq), false, false); nq = __uint_as_float(rr[0]) + __uint_as_float(rr[1]); }
        mhat = sqrtf(nq) * T.kmax * 1.01f + 0.01f; first = false; }
    const lds_cptr shm3 = (lds_cptr)shm;
    const int vlane = ((lane >> 4) & 1) * 32 + (lane & 3) * 8 + (4 * hi + ((lane & 15) >> 2)) * 64;
    const int n = c_top - c_lo + 1;
    bf16x8 pa[4];
#define ATT_SGB(mask, cnt) __builtin_amdgcn_sched_group_barrier(mask, cnt, 0)
#define ATT_SB() __builtin_amdgcn_sched_barrier(0)
#define ATT_VLD(I, B) do { vlo[B] = vtr(vp_ + ((I) >> 2) * 4096 + ((I) & 3) * 1024); vhi[B] = vtr(vp_ + ((I) >> 2) * 4096 + ((I) & 3) * 1024 + 512); } while (0)
#define ATT_PV_HEAD(SL) const lds_cptr vp_ = shm3 + opaque_s((SL) * SLOT) + V_OFF + vlane; s16x4 vlo[3], vhi[3]; ATT_VLD(0, 0); ATT_VLD(1, 1)
#define ATT_PV_STEP(I) do { if ((I) + 2 < 16) ATT_VLD((I) + 2, ((I) + 2) % 3); \
            const bf16x8 vf = {vlo[(I) % 3][0], vlo[(I) % 3][1], vlo[(I) % 3][2], vlo[(I) % 3][3], vhi[(I) % 3][0], vhi[(I) % 3][1], vhi[(I) % 3][2], vhi[(I) % 3][3]}; \
            o[(I) >> 2] = ATT_MFMA(pa[(I) & 3], vf, o[(I) >> 2]); } while (0)
#define ATT_STEP_BARRIER(I) do { if ((I) + 2 < n) asm volatile("s_waitcnt vmcnt(4) lgkmcnt(0)\n\ts_barrier" ::: "memory");     \
        else asm volatile("s_waitcnt vmcnt(0) lgkmcnt(0)\n\ts_barrier" ::: "memory");     \
        if ((I) + 3 < n) ATT_DMA(c_top - ((I) + 3), ((I) + 3) & 3); } while (0)
#define ATT_PACK(P0, P1) do { typedef unsigned u4 __attribute__((ext_vector_type(4))); \
        const u4 w0 = {cvtpk(P0[0], P0[1]), cvtpk(P0[2], P0[3]), cvtpk(P0[4], P0[5]), cvtpk(P0[6], P0[7])}, w1 = {cvtpk(P0[8], P0[9]), cvtpk(P0[10], P0[11]), cvtpk(P0[12], P0[13]), cvtpk(P0[14], P0[15])}; \
        const u4 w2 = {cvtpk(P1[0], P1[1]), cvtpk(P1[2], P1[3]), cvtpk(P1[4], P1[5]), cvtpk(P1[6], P1[7])}, w3 = {cvtpk(P1[8], P1[9]), cvtpk(P1[10], P1[11]), cvtpk(P1[12], P1[13]), cvtpk(P1[14], P1[15])}; \
        pa[0] = __builtin_bit_cast(bf16x8, w0); pa[1] = __builtin_bit_cast(bf16x8, w1); pa[2] = __builtin_bit_cast(bf16x8, w2); pa[3] = __builtin_bit_cast(bf16x8, w3); } while (0)
    if (n > 1) ATT_DMA(c_top - 1, 1);
    if (n > 2) ATT_DMA(c_top - 2, 2);
    const int nslow = (!fixedref || n <= 3) ? n : ((n & 1) ? 3 : 2);
    int i = 0;
    for (; i < nslow; ++i) {
        const int c = c_top - i, slot = i & 3;
        ATT_STEP_BARRIER(i);
        if (active && c <= myChunk) {
            const lds_cptr kp = shm3 + slot * SLOT + K_OFF + mp * 8192 + hi * 1024 + r32 * 16;
            f32x16 p0, p1;
            if (c == myChunk) {
#pragma unroll
                for (int r = 0; r < 16; ++r) { const float dq_ = (float)(qi - 4 * hi) - (float)((r & 3) + 8 * (r >> 2)); p0[r] = __builtin_fmaf(-slope2, fabsf(dq_), -mhat); p1[r] = __builtin_fmaf(-slope2, fabsf(dq_ - 32.f), -mhat); }
            } else { const float base = -mhat - slope2 * (float)(64 * (myChunk - c) + qi - 4 * hi), base1 = base + 32.f * slope2;
#pragma unroll
                for (int r = 0; r < 16; ++r) { const float kc_ = (float)((r & 3) + 8 * (r >> 2)); p0[r] = __builtin_fmaf(slope2, kc_, base); p1[r] = __builtin_fmaf(slope2, kc_, base1); } }
#pragma unroll
            for (int d0 = 0; d0 < 4; ++d0) { const bf16x8 k0 = *(const LAS bf16x8*)(kp + d0 * 2048), k1 = *(const LAS bf16x8*)(kp + d0 * 2048 + 512);
                p0 = ATT_MFMA(k0, qr[d0], p0); p1 = ATT_MFMA(k1, qr[d0], p1); }
            if (!fixedref) {
            float rm = fmaxf(p0[0], p1[0]);
#pragma unroll
            for (int r = 1; r < 16; ++r) rm = fmaxf(rm, fmaxf(p0[r], p1[r]));
            { auto rr = __builtin_amdgcn_permlane32_swap(__float_as_uint(rm), __float_as_uint(rm), false, false); rm = fmaxf(__uint_as_float(rr[0]), __uint_as_float(rr[1])); }
            if (first || __any(rm > THR)) {
                const float dl = first ? rm : fmaxf(rm, 0.f); mhat += dl;
#pragma unroll
                for (int r = 0; r < 16; ++r) { p0[r] -= dl; p1[r] -= dl; }
                if (!first) { const float f = __builtin_amdgcn_exp2f(-dl); l_reg *= f; if (hi == 0) wsf[r32] = f;
                    asm volatile("s_waitcnt lgkmcnt(0)" ::: "memory");
#pragma unroll
                    for (int r = 0; r < 16; ++r) { const float fr_ = wsf[crow(r, hi)];
#pragma unroll
                        for (int d = 0; d < 4; ++d) o[d][r] *= fr_; } }
                first = false;
            }
            }
            float sacc = 0.f;
#pragma unroll
            for (int r = 0; r < 16; ++r) { p0[r] = __builtin_amdgcn_exp2f(p0[r]); p1[r] = __builtin_amdgcn_exp2f(p1[r]); sacc += p0[r] + p1[r]; }
            l_reg += sacc;
            { typedef unsigned u4 __attribute__((ext_vector_type(4)));
              u4 w0 = {cvtpk(p0[0], p0[1]), cvtpk(p0[2], p0[3]), cvtpk(p0[4], p0[5]), cvtpk(p0[6], p0[7])}, w1 = {cvtpk(p0[8], p0[9]), cvtpk(p0[10], p0[11]), cvtpk(p0[12], p0[13]), cvtpk(p0[14], p0[15])};
              u4 w2 = {cvtpk(p1[0], p1[1]), cvtpk(p1[2], p1[3]), cvtpk(p1[4], p1[5]), cvtpk(p1[6], p1[7])}, w3 = {cvtpk(p1[8], p1[9]), cvtpk(p1[10], p1[11]), cvtpk(p1[12], p1[13]), cvtpk(p1[14], p1[15])};
              pa[0] = __builtin_bit_cast(bf16x8, w0); pa[1] = __builtin_bit_cast(bf16x8, w1); pa[2] = __builtin_bit_cast(bf16x8, w2); pa[3] = __builtin_bit_cast(bf16x8, w3); }
            { ATT_PV_HEAD(slot);
#pragma unroll
              for (int i_ = 0; i_ < 16; ++i_) { ATT_PV_STEP(i_); __builtin_amdgcn_sched_barrier(0); } }
        }
    }
    if (nslow < n) {
        f32x16 a0, a1, b0, b1;
        const float bq = -mhat - slope2 * (float)(64 * myChunk + qi - 4 * hi);
#define ATT_CINIT(P0, P1, CC) do { const float base_ = bq + slope2 * (float)(64 * (CC)), base1_ = base_ + 32.f * slope2; \
        _Pragma("unroll") for (int r = 0; r < 16; ++r) { const float kc_ = (float)((r & 3) + 8 * (r >> 2)); P0[r] = __builtin_fmaf(slope2, kc_, base_); P1[r] = __builtin_fmaf(slope2, kc_, base1_); } } while (0)
#define ATT_QK(P0, P1, SL) do { const lds_cptr kp_ = shm3 + opaque_s((SL) * SLOT) + K_OFF + mp * 8192 + hi * 1024 + r32 * 16; bf16x8 kfa[4], kfb[4]; \
        _Pragma("unroll") for (int d0 = 0; d0 < 4; ++d0) { kfa[d0] = *(const LAS bf16x8*)(kp_ + d0 * 2048); kfb[d0] = *(const LAS bf16x8*)(kp_ + d0 * 2048 + 512); } \
        _Pragma("unroll") for (int d0 = 0; d0 < 4; ++d0) { P0 = ATT_MFMA(kfa[d0], qr[d0], P0); P1 = ATT_MFMA(kfb[d0], qr[d0], P1); } } while (0)
#define ATT_EXP(P0, P1) do { _Pragma("unroll") for (int r = 0; r < 16; ++r) { P0[r] = __builtin_amdgcn_exp2f(P0[r]); P1[r] = __builtin_amdgcn_exp2f(P1[r]); } } while (0)
#define ATT_ROWSUM(P0, P1) do { float s0_ = 0.f, s1_ = 0.f; _Pragma("unroll") for (int r = 0; r < 16; ++r) { s0_ += P0[r]; s1_ += P1[r]; } l_reg += s0_ + s1_; } while (0)
#define ATT_PIN(x) asm volatile("" : "+v"(x))
#define ATT_FAST_STEP(I, PU0, PU1, WU0, WU1) do { ATT_STEP_BARRIER(I); if (active) { \
            const lds_cptr kp_ = shm3 + opaque_s((((I) + 1) & 3) * SLOT) + K_OFF + mp * 8192 + hi * 1024 + r32 * 16; bf16x8 kf[8]; \
            _Pragma("unroll") for (int d0 = 0; d0 < 4; ++d0) { kf[2 * d0] = *(const LAS bf16x8*)(kp_ + d0 * 2048); kf[2 * d0 + 1] = *(const LAS bf16x8*)(kp_ + d0 * 2048 + 512); } \
            float s0_ = 0.f, s1_ = 0.f; typedef unsigned u4_ __attribute__((ext_vector_type(4))); u4_ pw0, pw1, pw2, pw3; ATT_SB(); \
            WU0 = ATT_MFMA(kf[0], qr[0], WU0); s0_ += PU0[0]; s1_ += PU0[1]; s0_ += PU0[2]; s1_ += PU0[3]; pw0[0] = cvtpk(PU0[0], PU0[1]); pw0[1] = cvtpk(PU0[2], PU0[3]); ATT_PIN(s0_); ATT_PIN(s1_); ATT_PIN(pw0); ATT_SB(); \
            WU1 = ATT_MFMA(kf[1], qr[0], WU1); s0_ += PU0[4]; s1_ += PU0[5]; s0_ += PU0[6]; s1_ += PU0[7]; pw0[2] = cvtpk(PU0[4], PU0[5]); pw0[3] = cvtpk(PU0[6], PU0[7]); ATT_PIN(s0_); ATT_PIN(s1_); ATT_PIN(pw0); ATT_SB(); \
            WU0 = ATT_MFMA(kf[2], qr[1], WU0); s0_ += PU0[8]; s1_ += PU0[9]; s0_ += PU0[10]; s1_ += PU0[11]; pw1[0] = cvtpk(PU0[8], PU0[9]); pw1[1] = cvtpk(PU0[10], PU0[11]); ATT_PIN(s0_); ATT_PIN(s1_); ATT_PIN(pw1); ATT_SB(); \
            WU1 = ATT_MFMA(kf[3], qr[1], WU1); s0_ += PU0[12]; s1_ += PU0[13]; s0_ += PU0[14]; s1_ += PU0[15]; pw1[2] = cvtpk(PU0[12], PU0[13]); pw1[3] = cvtpk(PU0[14], PU0[15]); ATT_PIN(s0_); ATT_PIN(s1_); ATT_PIN(pw1); ATT_SB(); \
            WU0 = ATT_MFMA(kf[4], qr[2], WU0); s0_ += PU1[0]; s1_ += PU1[1]; s0_ += PU1[2]; s1_ += PU1[3]; pw2[0] = cvtpk(PU1[0], PU1[1]); pw2[1] = cvtpk(PU1[2], PU1[3]); ATT_PIN(s0_); ATT_PIN(s1_); ATT_PIN(pw2); ATT_SB(); \
            WU1 = ATT_MFMA(kf[5], qr[2], WU1); s0_ += PU1[4]; s1_ += PU1[5]; s0_ += PU1[6]; s1_ += PU1[7]; pw2[2] = cvtpk(PU1[4], PU1[5]); pw2[3] = cvtpk(PU1[6], PU1[7]); ATT_PIN(s0_); ATT_PIN(s1_); ATT_PIN(pw2); ATT_SB(); \
            WU0 = ATT_MFMA(kf[6], qr[3], WU0); s0_ += PU1[8]; s1_ += PU1[9]; s0_ += PU1[10]; s1_ += PU1[11]; pw3[0] = cvtpk(PU1[8], PU1[9]); pw3[1] = cvtpk(PU1[10], PU1[11]); ATT_PIN(s0_); ATT_PIN(s1_); ATT_PIN(pw3); ATT_SB(); \
            WU1 = ATT_MFMA(kf[7], qr[3], WU1); s0_ += PU1[12]; s1_ += PU1[13]; s0_ += PU1[14]; s1_ += PU1[15]; pw3[2] = cvtpk(PU1[12], PU1[13]); pw3[3] = cvtpk(PU1[14], PU1[15]); ATT_PIN(s0_); ATT_PIN(s1_); ATT_PIN(pw3); ATT_SB(); \
            l_reg += s0_ + s1_; pa[0] = __builtin_bit_cast(bf16x8, pw0); pa[1] = __builtin_bit_cast(bf16x8, pw1); pa[2] = __builtin_bit_cast(bf16x8, pw2); pa[3] = __builtin_bit_cast(bf16x8, pw3); \
            const float cb_ = bq + slope2 * (float)(64 * (c_top - ((I) + 2))), cb1_ = cb_ + 32.f * slope2; \
            ATT_PV_HEAD((I) & 3); ATT_SB(); \
            ATT_PV_STEP(0); WU0[0] = __builtin_amdgcn_exp2f(WU0[0]); WU0[1] = __builtin_amdgcn_exp2f(WU0[1]); PU0[0] = __builtin_fmaf(slope2, 0.f, cb_); PU0[1] = __builtin_fmaf(slope2, 1.f, cb_); ATT_PIN(WU0); ATT_PIN(PU0); ATT_SB(); \
            ATT_PV_STEP(1); WU0[2] = __builtin_amdgcn_exp2f(WU0[2]); WU0[3] = __builtin_amdgcn_exp2f(WU0[3]); PU0[2] = __builtin_fmaf(slope2, 2.f, cb_); PU0[3] = __builtin_fmaf(slope2, 3.f, cb_); ATT_PIN(WU0); ATT_PIN(PU0); ATT_SB(); \
            ATT_PV_STEP(2); WU0[4] = __builtin_amdgcn_exp2f(WU0[4]); WU0[5] = __builtin_amdgcn_exp2f(WU0[5]); PU0[4] = __builtin_fmaf(slope2, 8.f, cb_); PU0[5] = __builtin_fmaf(slope2, 9.f, cb_); ATT_PIN(WU0); ATT_PIN(PU0); ATT_SB(); \
            ATT_PV_STEP(3); WU0[6] = __builtin_amdgcn_exp2f(WU0[6]); WU0[7] = __builtin_amdgcn_exp2f(WU0[7]); PU0[6] = __builtin_fmaf(slope2, 10.f, cb_); PU0[7] = __builtin_fmaf(slope2, 11.f, cb_); ATT_PIN(WU0); ATT_PIN(PU0); ATT_SB(); \
            ATT_PV_STEP(4); WU0[8] = __builtin_amdgcn_exp2f(WU0[8]); WU0[9] = __builtin_amdgcn_exp2f(WU0[9]); PU0[8] = __builtin_fmaf(slope2, 16.f, cb_); PU0[9] = __builtin_fmaf(slope2, 17.f, cb_); ATT_PIN(WU0); ATT_PIN(PU0); ATT_SB(); \
            ATT_PV_STEP(5); WU0[10] = __builtin_amdgcn_exp2f(WU0[10]); WU0[11] = __builtin_amdgcn_exp2f(WU0[11]); PU0[10] = __builtin_fmaf(slope2, 18.f, cb_); PU0[11] = __builtin_fmaf(slope2, 19.f, cb_); ATT_PIN(WU0); ATT_PIN(PU0); ATT_SB(); \
            ATT_PV_STEP(6); WU0[12] = __builtin_amdgcn_exp2f(WU0[12]); WU0[13] = __builtin_amdgcn_exp2f(WU0[13]); PU0[12] = __builtin_fmaf(slope2, 24.f, cb_); PU0[13] = __builtin_fmaf(slope2, 25.f, cb_); ATT_PIN(WU0); ATT_PIN(PU0); ATT_SB(); \
            ATT_PV_STEP(7); WU0[14] = __builtin_amdgcn_exp2f(WU0[14]); WU0[15] = __builtin_amdgcn_exp2f(WU0[15]); PU0[14] = __builtin_fmaf(slope2, 26.f, cb_); PU0[15] = __builtin_fmaf(slope2, 27.f, cb_); ATT_PIN(WU0); ATT_PIN(PU0); ATT_SB(); \
            ATT_PV_STEP(8); WU1[0] = __builtin_amdgcn_exp2f(WU1[0]); WU1[1] = __builtin_amdgcn_exp2f(WU1[1]); PU1[0] = __builtin_fmaf(slope2, 0.f, cb1_); PU1[1] = __builtin_fmaf(slope2, 1.f, cb1_); ATT_PIN(WU1); ATT_PIN(PU1); ATT_SB(); \
            ATT_PV_STEP(9); WU1[2] = __builtin_amdgcn_exp2f(WU1[2]); WU1[3] = __builtin_amdgcn_exp2f(WU1[3]); PU1[2] = __builtin_fmaf(slope2, 2.f, cb1_); PU1[3] = __builtin_fmaf(slope2, 3.f, cb1_); ATT_PIN(WU1); ATT_PIN(PU1); ATT_SB(); \
            ATT_PV_STEP(10); WU1[4] = __builtin_amdgcn_exp2f(WU1[4]); WU1[5] = __builtin_amdgcn_exp2f(WU1[5]); PU1[4] = __builtin_fmaf(slope2, 8.f, cb1_); PU1[5] = __builtin_fmaf(slope2, 9.f, cb1_); ATT_PIN(WU1); ATT_PIN(PU1); ATT_SB(); \
            ATT_PV_STEP(11); WU1[6] = __builtin_amdgcn_exp2f(WU1[6]); WU1[7] = __builtin_amdgcn_exp2f(WU1[7]); PU1[6] = __builtin_fmaf(slope2, 10.f, cb1_); PU1[7] = __builtin_fmaf(slope2, 11.f, cb1_); ATT_PIN(WU1); ATT_PIN(PU1); ATT_SB(); \
            ATT_PV_STEP(12); WU1[8] = __builtin_amdgcn_exp2f(WU1[8]); WU1[9] = __builtin_amdgcn_exp2f(WU1[9]); PU1[8] = __builtin_fmaf(slope2, 16.f, cb1_); PU1[9] = __builtin_fmaf(slope2, 17.f, cb1_); ATT_PIN(WU1); ATT_PIN(PU1); ATT_SB(); \
            ATT_PV_STEP(13); WU1[10] = __builtin_amdgcn_exp2f(WU1[10]); WU1[11] = __builtin_amdgcn_exp2f(WU1[11]); PU1[10] = __builtin_fmaf(slope2, 18.f, cb1_); PU1[11] = __builtin_fmaf(slope2, 19.f, cb1_); ATT_PIN(WU1); ATT_PIN(PU1); ATT_SB(); \
            ATT_PV_STEP(14); WU1[12] = __builtin_amdgcn_exp2f(WU1[12]); WU1[13] = __builtin_amdgcn_exp2f(WU1[13]); PU1[12] = __builtin_fmaf(slope2, 24.f, cb1_); PU1[13] = __builtin_fmaf(slope2, 25.f, cb1_); ATT_PIN(WU1); ATT_PIN(PU1); ATT_SB(); \
            ATT_PV_STEP(15); WU1[14] = __builtin_amdgcn_exp2f(WU1[14]); WU1[15] = __builtin_amdgcn_exp2f(WU1[15]); PU1[14] = __builtin_fmaf(slope2, 26.f, cb1_); PU1[15] = __builtin_fmaf(slope2, 27.f, cb1_); ATT_PIN(WU1); ATT_PIN(PU1); ATT_SB(); \
        } } while (0)
        if (active) { ATT_CINIT(a0, a1, c_top - i); ATT_QK(a0, a1, i & 3); ATT_EXP(a0, a1); ATT_CINIT(b0, b1, c_top - (i + 1)); }
        ATT_FAST_STEP(i, a0, a1, b0, b1); ++i;
        for (; i + 1 < n; ) { ATT_FAST_STEP(i, b0, b1, a0, a1); ++i; ATT_FAST_STEP(i, a0, a1, b0, b1); ++i; }
        ATT_STEP_BARRIER(i);
        if (active) { ATT_ROWSUM(b0, b1); ATT_PACK(b0, b1);
            { ATT_PV_HEAD(i & 3);
#pragma unroll
              for (int i_ = 0; i_ < 16; ++i_) { ATT_PV_STEP(i_); __builtin_amdgcn_sched_barrier(0); } } }
#undef ATT_FAST_STEP
#undef ATT_PIN
#undef ATT_ROWSUM
#undef ATT_EXP
#undef ATT_QK
#undef ATT_CINIT
    }
#undef ATT_PACK
#undef ATT_STEP_BARRIER
#undef ATT_PV_STEP
#undef ATT_PV_HEAD
#undef ATT_VLD
#undef ATT_SGB
#undef ATT_SB
    { auto rr = __builtin_amdgcn_permlane32_swap(__float_as_uint(l_reg), __float_as_uint(l_reg), false, false); l_reg = __uint_as_float(rr[0]) + __uint_as_float(rr[1]); }
    if (u.nseg == 2) {
        if (first) mhat = -1e30f;
        float* pb = T.part + (size_t)(u.pidx * 2 + u.seg) * PART_FLOATS;
#pragma unroll
        for (int r = 0; r < 16; ++r)
#pragma unroll
            for (int dq = 0; dq < 4; ++dq) pb[(unsigned)(((wid * 16 + r) * 4 + dq) * 64 + lane)] = o[dq][r];
        pb[(unsigned)(32768 + wid * 128 + lane)] = mhat; pb[(unsigned)(32768 + wid * 128 + 64 + lane)] = l_reg;
        volatile LAS unsigned* sw = (volatile LAS unsigned*)(shm + WS_OFF + 8 * 256);
        asm volatile("s_waitcnt vmcnt(0)" ::: "memory"); __syncthreads();
        if (tid == 0) { __builtin_amdgcn_fence(__ATOMIC_RELEASE, "agent"); asm volatile("s_waitcnt vmcnt(0)" ::: "memory");
            sw[0] = __hip_atomic_fetch_add(T.segcnt + 64 * u.pidx, 1u, __ATOMIC_RELAXED, __HIP_MEMORY_SCOPE_AGENT); }
        __syncthreads();
        const bool last = sw[0] == 1u;
        __syncthreads();
        if (!last) return;
        if (tid == 0) { __builtin_amdgcn_fence(__ATOMIC_ACQUIRE, "agent"); asm volatile("s_waitcnt vmcnt(0)" ::: "memory"); }
        __syncthreads();
        const float* ob = T.part + (size_t)(u.pidx * 2 + (1 - u.seg)) * PART_FLOATS;
        const float m_o = ob[(unsigned)(32768 + wid * 128 + lane)], l_o = ob[(unsigned)(32768 + wid * 128 + 64 + lane)];
        const float M = fmaxf(mhat, m_o), fs = __builtin_amdgcn_exp2f(mhat - M), fo = __builtin_amdgcn_exp2f(m_o - M);
        l_reg = l_reg * fs + l_o * fo; mhat = M;
        if (hi == 0) { wsf[r32] = fs; wsf[32 + r32] = fo; }
        asm volatile("s_waitcnt lgkmcnt(0)" ::: "memory");
#pragma unroll
        for (int r = 0; r < 16; ++r) { const float a_ = wsf[crow(r, hi)], b_ = wsf[32 + crow(r, hi)];
#pragma unroll
            for (int dq = 0; dq < 4; ++dq) o[dq][r] = o[dq][r] * a_ + ob[(unsigned)(((wid * 16 + r) * 4 + dq) * 64 + lane)] * b_; }
        asm volatile("s_waitcnt lgkmcnt(0)" ::: "memory");
    }
    if (hi == 0) wsf[32 + r32] = active ? 1.0f / l_reg : 0.f;
    asm volatile("s_waitcnt lgkmcnt(0)\n\ts_barrier" ::: "memory");
    float rli[16];
#pragma unroll
    for (int r = 0; r < 16; ++r) rli[r] = wsf[32 + crow(r, hi)];
    LAS float* stg = (LAS float*)shm + g * 32 * 128;
    if (mp == 1) {
#pragma unroll
        for (int r = 0; r < 16; ++r)
#pragma unroll
            for (int dq = 0; dq < 4; ++dq) stg[crow(r, hi) * 128 + dq * 32 + r32] = T.lam * o[dq][r] * rli[r];
    }
    asm volatile("s_waitcnt lgkmcnt(0)\n\ts_barrier" ::: "memory");
    if (mp == 0 && active) {
        float gn[4];
#pragma unroll
        for (int dq = 0; dq < 4; ++dq) gn[dq] = T.out_g[dq * 32 + r32] * T.lam_init_c;
#pragma unroll
        for (int r = 0; r < 16; ++r) { float ss = 0.f;
#pragma unroll
            for (int dq = 0; dq < 4; ++dq) { const float v = o[dq][r] * rli[r] - stg[crow(r, hi) * 128 + dq * 32 + r32]; o[dq][r] = v; ss += v * v; }
            ss = half_sum(ss);
            const float rn = 1.0f / sqrtf(ss * (1.f / 128.f) + EPS);
            bf16* mrow = T.MIX + (size_t)(u.qrow0 + 32 * g + crow(r, hi)) * DM + 1024 + h * 128 + r32;
#pragma unroll
            for (int dq = 0; dq < 4; ++dq) mrow[dq * 32] = (bf16)f2bf(o[dq][r] * rn * gn[dq]); }
    }
    asm volatile("s_waitcnt lgkmcnt(0)\n\ts_barrier" ::: "memory");
#undef ATT_DMA
}
}
constexpr int ATT_NITEMS = 800, ATT_NSPLIT = 160;
__device__ const unsigned att_items[ATT_NITEMS] = {1305598,1309694,1297398,1301494,1289198,1293294,1280998,1285094,1272798,1276894,1264598,1268694,1256398,1260494,1248198,1252294,1239998,1244094,1231798,1235894,1223598,1227694,1215398,1219494,1207198,1211294,1198998,1203094,1190798,1194894,1182598,1186694,1174398,1178494,1166198,1170294,1157998,1162094,1149798,1153894,1141598,1145694,1133398,1137494,1125198,1129294,1116998,1121094,1108798,1112894,1100598,1104694,1092398,1096494,1084198,1088294,1075998,1080094,1067798,1071894,1059598,1063694,1051398,1055494,380,382,1043198,1047294,1034998,1039094,372,374,1026798,1030894,1018598,1022694,364,366,1010398,1014494,1002198,1006294,356,358,993998,998094,985798,989894,348,350,977598,981694,969398,973494,340,342,961198,965294,952998,957094,332,334,944798,948894,936598,940694,324,326,928398,932494,920198,924294,316,318,911998,916094,903798,907894,308,310,895598,899694,887398,891494,300,302,879198,883294,870998,875094,292,294,862798,866894,854598,858694,284,286,846398,850494,838198,842294,276,278,829998,834094,821798,825894,166436,170532,174636,178732,182836,186932,191036,195132,199236,203332,207436,211532,215636,219732,223836,227932,232036,236132,240236,244332,248436,252532,256636,260732,264836,268932,273036,277132,281236,285332,289436,293532,297636,301732,305836,309932,314036,318132,322236,326332,330436,334532,338636,342732,346836,350932,355036,359132,363236,367332,371436,375532,379636,383732,387836,391932,396036,400132,404236,408332,412436,416532,420636,424732,428836,432932,437036,441132,445236,449332,453436,457532,461636,465732,469836,473932,478036,482132,486236,490332,494436,498532,502636,506732,510836,514932,519036,523132,527236,531332,535436,539532,543636,547732,551836,555932,560036,564132,568236,572332,576436,580532,584636,588732,592836,596932,601036,605132,609236,613332,617436,621532,625636,629732,633836,637932,642036,646132,650236,654332,268,158236,162332,270,813598,817694,150036,154132,805398,809494,260,141836,145932,262,797198,801294,133636,137732,788998,793094,252,125436,129532,254,780798,784894,117236,121332,772598,776694,244,109036,113132,246,764398,768494,100836,104932,756198,760294,236,92636,96732,238,747998,752094,84436,88532,739798,743894,228,76236,80332,230,731598,735694,68036,72132,723398,727494,220,59836,63932,222,715198,719294,51636,55732,706998,711094,212,43436,47532,214,698798,702894,35236,39332,690598,694694,204,27036,31132,206,682398,686494,18836,22932,674198,678294,196,10636,14732,198,665998,670094,2436,6532,657798,661894,188,190,180,182,172,174,164,166,156,158,148,150,138,146,154,162,170,178,186,194,202,210,218,226,234,242,250,258,266,274,282,290,298,306,314,322,330,338,346,354,362,370,378,386,394,402,410,418,426,434,442,450,458,466,474,482,490,498,506,514,522,530,538,546,554,562,570,578,586,594,602,610,618,626,634,642,650,658,666,674,682,690,698,706,714,722,730,738,746,754,762,770,778,786,794,802,810,818,826,834,842,850,858,866,874,882,890,898,906,914,922,930,938,946,954,962,970,978,986,994,1002,1010,1018,140,142,130,132,134,122,124,126,114,116,118,106,108,110,3,5,7,11,13,15,19,21,23,27,29,31,35,37,39,43,45,47,51,53,55,59,61,63,67,69,71,75,77,79,83,85,87,91,93,95,99,101,103,107,109,111,115,117,119,123,125,127,131,133,135,139,141,143,147,149,151,155,157,159,163,165,167,171,173,175,179,181,183,187,189,191,195,197,199,203,205,207,211,213,215,219,221,223,227,229,231,235,237,239,243,245,247,251,253,255,98,100,102,90,92,94,82,84,86,74,76,78,66,68,70,58,60,62,50,52,54,42,44,46,40,48,56,64,72,80,88,96,104,112,120,128,136,144,152,160,168,176,184,192,200,208,216,224,232,240,248,256,264,272,280,288,296,304,312,320,328,336,344,352,360,368,376,384,392,400,408,416,424,432,440,448,456,464,472,480,488,496,504,512,520,528,536,544,552,560,568,576,584,592,600,608,616,624,632,640,648,656,664,672,680,688,696,704,712,720,728,736,744,752,760,768,776,784,792,800,808,816,824,832,840,848,856,864,872,880,888,896,904,912,920,928,936,944,952,960,968,976,984,992,1000,1008,1016,32,34,36,38,24,26,28,30,1,9,17,25,33,41,49,57,65,73,81,89,97,105,113,121,129,137,145,153,161,169,177,185,193,201,209,217,225,233,241,249,16,18,20,22,8,10,12,14,0,2,4,6};
namespace ssdc {
using att::bf16x8; using att::s16x4; using att::f32x16; using att::lds_cptr; using att::vtr; using att::cvtpk; using att::crow;
constexpr int L_XS = 0, L_B = 65536, L_C = 81920, L_DT = 98304, L_CS = 100352, L_RED = 102400, L_ECS = 104448, L_RDT = 106496, LDS_NEED = 108544;
struct Args { const bf16* proj; const float* dtga; const float* dt_bias; const float* conv_state; const float* conv_w; const float* conv_b; const float* a_log; const float* dpar; const float* norm_g;
              bf16* states; float* decay; const bf16* hin; bf16* mix; int layer, pad; };
__device__ __forceinline__ void conv8(const Args& a, const bf16* pbase  , int s, int t, bool isS, int b, int col, const float (&w)[4][8], const float (&bias)[8], float (&y)[8]) {
#pragma unroll
    for (int e = 0; e < 8; ++e) y[e] = bias[e];
    if (!isS) {
        bf16x8 v[4];
#pragma unroll
        for (int j = 0; j < 4; ++j) v[j] = *(const bf16x8*)(pbase + (unsigned)(((t - 3 + j) >= 0 ? s + j : 3) * NPJ + col));
#pragma unroll
        for (int j = 0; j < 4; ++j) { const float m = (t - 3 + j) >= 0 ? 1.f : 0.f;
#pragma unroll
            for (int e = 0; e < 8; ++e) y[e] += (bf2f((bf16)v[j][e]) * m) * w[j][e]; }
#pragma unroll
        for (int e = 0; e < 8; ++e) y[e] = silu_f(y[e]);
        return; }
#pragma unroll
    for (int j = 0; j < 4; ++j) { const int tt = t - 3 + j; float u[8];
        if (tt >= 0) { const bf16x8 v = *(const bf16x8*)(pbase + (unsigned)((s + j) * NPJ + col));
#pragma unroll
            for (int e = 0; e < 8; ++e) u[e] = bf2f((bf16)v[e]); }
        else if (isS) { const float* cs = a.conv_state + ((size_t)(a.layer * DB + b) * 3 + (3 + tt)) * CONV_DIM + col;
#pragma unroll
            for (int e = 0; e < 8; ++e) u[e] = cs[e]; }
        else {
#pragma unroll
            for (int e = 0; e < 8; ++e) u[e] = 0.f; }
#pragma unroll
        for (int e = 0; e < 8; ++e) y[e] += u[e] * w[j][e]; }
#pragma unroll
    for (int e = 0; e < 8; ++e) y[e] = silu_f(y[e]);
}
__device__ __forceinline__ void conv8_load(const bf16* pbase, int s, int t, int col, bf16x8 (&v)[4]) {
#pragma unroll
    for (int j = 0; j < 4; ++j) v[j] = *(const bf16x8*)(pbase + (unsigned)(((t - 3 + j) >= 0 ? s + j : 3) * NPJ + col));
}
__device__ __forceinline__ void conv8_calc(const bf16x8 (&v)[4], int t, const float (&w)[4][8], const float (&bias)[8], float (&y)[8]) {
#pragma unroll
    for (int e = 0; e < 8; ++e) y[e] = bias[e];
#pragma unroll
    for (int j = 0; j < 4; ++j) { const float m = (t - 3 + j) >= 0 ? 1.f : 0.f;
#pragma unroll
        for (int e = 0; e < 8; ++e) y[e] += (bf2f((bf16)v[j][e]) * m) * w[j][e]; }
#pragma unroll
    for (int e = 0; e < 8; ++e) y[e] = silu_f(y[e]);
}
__device__ __forceinline__ void load_w8(const Args& a, int col, float (&w)[4][8], float (&bias)[8]) {
#pragma unroll
    for (int j = 0; j < 4; ++j)
#pragma unroll
        for (int e = 0; e < 8; ++e) w[j][e] = a.conv_w[(size_t)(a.layer * 4 + j) * CONV_DIM + col + e];
#pragma unroll
    for (int e = 0; e < 8; ++e) bias[e] = a.conv_b[(size_t)a.layer * CONV_DIM + col + e];
}
__device__ __forceinline__ u32x4 pack8(const float (&y)[8]) { u32x4 o; o.x = pk2(y[0], y[1]); o.y = pk2(y[2], y[3]); o.z = pk2(y[4], y[5]); o.w = pk2(y[6], y[7]); return o; }
template <bool PRE> __device__ __forceinline__ void stage_s(const Args& a, int chunk, int g, LAS unsigned char* shm, int tid_) {
    int tid = opaque_v(tid_);
    const bool isS = chunk >= SEQ / 64; const int b = isS ? chunk - SEQ / 64 : 0, row0 = chunk * 64, t0 = isS ? 0 : row0;
    LAS float* dtab = (LAS float*)(shm + L_DT); LAS float* cstab = (LAS float*)(shm + L_CS);
    const bf16* pbase = a.proj + ((long)row0 - 3) * NPJ + C_XBC;
    { const int s = tid >> 3, h8 = tid & 7; dtab[s * 8 + h8] = softplus_f(a.dtga[(size_t)(row0 + s) * 32 + g * 8 + h8] + a.dt_bias[a.layer * 16 + g * 8 + h8]); }
    __syncthreads();
    { const int w = __builtin_amdgcn_readfirstlane(tid >> 6), ln = tid & 63;
      const float A = -__expf(a.a_log[a.layer * 16 + g * 8 + w]); const float dtv = dtab[ln * 8 + w]; float v = dtv * A;
#pragma unroll
      for (int d = 1; d < 64; d <<= 1) { const float t2 = __builtin_bit_cast(float, __builtin_amdgcn_ds_bpermute(((ln - d) & 63) << 2, __builtin_bit_cast(int, v))); if (ln >= d) v += t2; }
      cstab[ln * 8 + w] = v;
      const float vend = __builtin_bit_cast(float, __builtin_amdgcn_readlane(__builtin_bit_cast(int, v), 63));
      ((LAS float*)(shm + L_ECS))[ln * 8 + w] = PRE ? dtv * __expf(vend - v) : __expf(v);
      ((LAS float*)(shm + L_RDT))[ln * 8 + w] = __builtin_amdgcn_rcpf(dtv); }
    __syncthreads();
    tid = opaque_v(tid);
    { const int cg = tid & 63, col = g * 512 + cg * 8, h8 = cg >> 3; float w[4][8], bias[8]; load_w8(a, col, w, bias);
      if (!isS) {
#pragma unroll 1
          for (int ib = 0; ib < 2; ++ib) { bf16x8 v[4][4];
#pragma unroll
              for (int i = 0; i < 4; ++i) { const int s = (tid >> 6) + 8 * (4 * ib + i); conv8_load(pbase, s, t0 + s, col, v[i]); }
#pragma unroll
              for (int i = 0; i < 4; ++i) { const int s = (tid >> 6) + 8 * (4 * ib + i); float y[8]; conv8_calc(v[i], t0 + s, w, bias, y);
                  const float f = PRE ? ((LAS float*)(shm + L_ECS))[s * 8 + h8] : dtab[s * 8 + h8];
#pragma unroll
                  for (int e = 0; e < 8; ++e) y[e] *= f;
                  *(LAS u32x4*)(shm + L_XS + h8 * 8192 + ((cg & 7) >> 2) * 4096 + s * 64 + (cg & 3) * 16) = pack8(y); } } }
      else {
#pragma unroll 2
      for (int i = 0; i < 8; ++i) { const int s = (tid >> 6) + 8 * i; float y[8]; conv8(a, pbase, s, t0 + s, isS, b, col, w, bias, y);
          const float f = PRE ? ((LAS float*)(shm + L_ECS))[s * 8 + h8] : dtab[s * 8 + h8];
#pragma unroll
          for (int e = 0; e < 8; ++e) y[e] *= f;
          *(LAS u32x4*)(shm + L_XS + h8 * 8192 + ((cg & 7) >> 2) * 4096 + s * 64 + (cg & 3) * 16) = pack8(y); } } }
    tid = opaque_v(tid);
    { const int cg = tid & 15, colB = 1024 + g * 128 + cg * 8; float w[4][8], bias[8]; load_w8(a, colB, w, bias);
#pragma unroll
      for (int i = 0; i < 2; ++i) { const int s = (tid >> 4) + 32 * i; float y[8]; conv8(a, pbase, s, t0 + s, isS, b, colB, w, bias, y);
          if (PRE) *(LAS u32x4*)(shm + L_B + (cg >> 2) * 4096 + s * 64 + (cg & 3) * 16) = pack8(y);
          else     *(LAS u32x4*)(shm + L_B + cg * 1024 + s * 16) = pack8(y); } }
    tid = opaque_v(tid);
    if (!PRE) { const int cg = tid & 15, colC = 1280 + g * 128 + cg * 8; float w[4][8], bias[8]; load_w8(a, colC, w, bias);
#pragma unroll
      for (int i = 0; i < 2; ++i) { const int s = (tid >> 4) + 32 * i; float y[8]; conv8(a, pbase, s, t0 + s, isS, b, colC, w, bias, y);
          *(LAS u32x4*)(shm + L_C + cg * 1024 + s * 16) = pack8(y); } }
    __syncthreads();
}
template <bool PRE> __device__ __forceinline__ void stage_p(const Args& a, int chunk, int g, LAS unsigned char* shm, int tid_) {
    const int tid = opaque_v(tid_); const int row0 = chunk * 64, t0 = row0;
    LAS float* dtab = (LAS float*)(shm + L_DT); LAS float* cstab = (LAS float*)(shm + L_CS);
    const bf16* pbase = a.proj + ((long)row0 - 3) * NPJ + C_XBC;
    const float dt_raw = a.dtga[(size_t)(row0 + (tid >> 3)) * 32 + g * 8 + (tid & 7)], dt_b = a.dt_bias[a.layer * 16 + g * 8 + (tid & 7)];
    const float a_l = a.a_log[a.layer * 16 + g * 8 + __builtin_amdgcn_readfirstlane(tid >> 6)];
    const int cgx = tid & 63, colx = g * 512 + cgx * 8, h8 = cgx >> 3, wv = tid >> 6; float wx[4][8], bx[8]; load_w8(a, colx, wx, bx);
    bf16x8 vx[4][4];
#pragma unroll
    for (int i = 0; i < 4; ++i) { const int s = wv + 8 * i; conv8_load(pbase, s, t0 + s, colx, vx[i]); }
    const int cgb = tid & 15, colB = 1024 + g * 128 + cgb * 8, sb0 = tid >> 4; float wB[4][8], bB[8]; load_w8(a, colB, wB, bB);
    bf16x8 vB[2][4];
#pragma unroll
    for (int i = 0; i < 2; ++i) { const int s = sb0 + 32 * i; conv8_load(pbase, s, t0 + s, colB, vB[i]); }
    { const int s = tid >> 3, hh = tid & 7; dtab[s * 8 + hh] = softplus_f(dt_raw + dt_b); }
    __syncthreads();
    { const int w = __builtin_amdgcn_readfirstlane(tid >> 6), ln = tid & 63;
      const float A = -__expf(a_l); const float dtv = dtab[ln * 8 + w]; float v = dtv * A;
#pragma unroll
      for (int d = 1; d < 64; d <<= 1) { const float t2 = __builtin_bit_cast(float, __builtin_amdgcn_ds_bpermute(((ln - d) & 63) << 2, __builtin_bit_cast(int, v))); if (ln >= d) v += t2; }
      cstab[ln * 8 + w] = v;
      const float vend = __builtin_bit_cast(float, __builtin_amdgcn_readlane(__builtin_bit_cast(int, v), 63));
      ((LAS float*)(shm + L_ECS))[ln * 8 + w] = PRE ? dtv * __expf(vend - v) : __expf(v);
      ((LAS float*)(shm + L_RDT))[ln * 8 + w] = __builtin_amdgcn_rcpf(dtv); }
    __syncthreads();
#pragma unroll
    for (int i = 0; i < 4; ++i) { const int s = wv + 8 * i; float y[8]; conv8_calc(vx[i], t0 + s, wx, bx, y);
        const float f = PRE ? ((LAS float*)(shm + L_ECS))[s * 8 + h8] : dtab[s * 8 + h8];
#pragma unroll
        for (int e = 0; e < 8; ++e) y[e] *= f;
        *(LAS u32x4*)(shm + L_XS + h8 * 8192 + ((cgx & 7) >> 2) * 4096 + s * 64 + (cgx & 3) * 16) = pack8(y); }
#pragma unroll
    for (int i = 0; i < 4; ++i) { const int s = wv + 8 * (4 + i); conv8_load(pbase, s, t0 + s, colx, vx[i]); }
#pragma unroll
    for (int i = 0; i < 2; ++i) { const int s = sb0 + 32 * i; float y[8]; conv8_calc(vB[i], t0 + s, wB, bB, y);
        if (PRE) *(LAS u32x4*)(shm + L_B + (cgb >> 2) * 4096 + s * 64 + (cgb & 3) * 16) = pack8(y);
        else     *(LAS u32x4*)(shm + L_B + cgb * 1024 + s * 16) = pack8(y); }
    if (!PRE) { const int colC = 1280 + g * 128 + cgb * 8; load_w8(a, colC, wB, bB);
#pragma unroll
        for (int i = 0; i < 2; ++i) { const int s = sb0 + 32 * i; conv8_load(pbase, s, t0 + s, colC, vB[i]); } }
#pragma unroll
    for (int i = 0; i < 4; ++i) { const int s = wv + 8 * (4 + i); float y[8]; conv8_calc(vx[i], t0 + s, wx, bx, y);
        const float f = PRE ? ((LAS float*)(shm + L_ECS))[s * 8 + h8] : dtab[s * 8 + h8];
#pragma unroll
        for (int e = 0; e < 8; ++e) y[e] *= f;
        *(LAS u32x4*)(shm + L_XS + h8 * 8192 + ((cgx & 7) >> 2) * 4096 + s * 64 + (cgx & 3) * 16) = pack8(y); }
    if (!PRE) {
#pragma unroll
        for (int i = 0; i < 2; ++i) { const int s = sb0 + 32 * i; float y[8]; conv8_calc(vB[i], t0 + s, wB, bB, y);
            *(LAS u32x4*)(shm + L_C + cgb * 1024 + s * 16) = pack8(y); } }
    __syncthreads();
}
template <bool PRE> __device__ __forceinline__ void stage(const Args& a, int chunk, int g, LAS unsigned char* shm, int tid_) {
    if (PRE && chunk < SEQ / 64) stage_p<PRE>(a, chunk, g, shm, tid_); else stage_s<PRE>(a, chunk, g, shm, tid_);
}
__device__ __forceinline__ bf16x8 trfrag_nat(lds_cptr blk, int ks, int lane) {
    const int hi = lane >> 5; lds_cptr p = blk + (16 * ks + 8 * hi + ((lane & 15) >> 2)) * 64 + ((lane >> 4) & 1) * 32 + (lane & 3) * 8;
    const s16x4 lo = vtr(p), hh = vtr(p + 256); return (bf16x8){lo[0], lo[1], lo[2], lo[3], hh[0], hh[1], hh[2], hh[3]};
}
__device__ __forceinline__ bf16x8 trfrag_acc(lds_cptr blk, int ks, int lane) {
    const int hi = lane >> 5; lds_cptr p = blk + (16 * ks + 4 * hi + ((lane & 15) >> 2)) * 64 + ((lane >> 4) & 1) * 32 + (lane & 3) * 8;
    const s16x4 lo = vtr(p), hh = vtr(p + 512); return (bf16x8){lo[0], lo[1], lo[2], lo[3], hh[0], hh[1], hh[2], hh[3]};
}
__device__ __forceinline__ void pre_unit(const Args& a, int chunk, int g, LAS unsigned char* shm, int tid_) {
    stage<true>(a, chunk, g, shm, tid_);
    const int tid = opaque_v(tid_);
    const int lane = tid & 63, r32 = lane & 31, hi = lane >> 5, wid = __builtin_amdgcn_readfirstlane(tid >> 6), h = g * 8 + wid;
    const lds_cptr shm3 = (lds_cptr)shm; const lds_cptr xs = shm3 + L_XS + wid * 8192, bi = shm3 + L_B;
    bf16x8 af[2][4];
#pragma unroll
    for (int pb = 0; pb < 2; ++pb)
#pragma unroll
        for (int ks = 0; ks < 4; ++ks) af[pb][ks] = trfrag_nat(xs + pb * 4096, ks, lane);
    bf16* st = a.states + ((size_t)(chunk * 16 + h) * 64) * 128;
#pragma unroll
    for (int nb = 0; nb < 4; ++nb) { bf16x8 bfr[4];
#pragma unroll
        for (int ks = 0; ks < 4; ++ks) bfr[ks] = trfrag_nat(bi + nb * 4096, ks, lane);
#pragma unroll
        for (int pb = 0; pb < 2; ++pb) { f32x16 acc = {0.f, 0.f, 0.f, 0.f, 0.f, 0.f, 0.f, 0.f, 0.f, 0.f, 0.f, 0.f, 0.f, 0.f, 0.f, 0.f};
#pragma unroll
            for (int ks = 0; ks < 4; ++ks) acc = ATT_MFMA(bfr[ks], af[pb][ks], acc);
            bf16* sp = st + (unsigned)((32 * pb + r32) * 128 + 32 * nb + 4 * hi);
#pragma unroll
            for (int q = 0; q < 4; ++q) { u32x2 w; w.x = cvtpk(acc[4 * q], acc[4 * q + 1]); w.y = cvtpk(acc[4 * q + 2], acc[4 * q + 3]); *(u32x2*)(sp + 8 * q) = w; } } }
    if (tid < 8) a.decay[chunk * 16 + g * 8 + tid] = __expf(((LAS float*)(shm + L_CS))[63 * 8 + tid]);
    lds_barrier();
}
__device__ __forceinline__ void post_unit(const Args& a, int chunk, int g, LAS unsigned char* shm, int tid_) {
    bf16x8 hf[2][8];
    { const int tq = opaque_v(tid_), lq = tq & 63, wq = __builtin_amdgcn_readfirstlane(tq >> 6); const bf16* hq = a.hin + ((size_t)(chunk * 16 + g * 8 + wq) * 64) * 128;
#pragma unroll
      for (int dq = 0; dq < 2; ++dq)
#pragma unroll
          for (int d0 = 0; d0 < 8; ++d0) hf[dq][d0] = *(const bf16x8*)(hq + (unsigned)((32 * dq + (lq & 31)) * 128 + 16 * d0 + 8 * (lq >> 5))); }
    stage<false>(a, chunk, g, shm, tid_);
    const int tid = opaque_v(tid_);
    const int lane0 = tid & 63, wid = __builtin_amdgcn_readfirstlane(tid >> 6), h = g * 8 + wid, row0 = chunk * 64;
    bf16x8 zv[8];
    { const bf16* zb = a.proj + (size_t)row0 * NPJ + C_Z + g * 512 + lane0 * 8;
#pragma unroll
      for (int i = 0; i < 8; ++i) zv[i] = *(const bf16x8*)(zb + (unsigned)((wid * 8 + i) * NPJ)); }
    const lds_cptr shm3 = (lds_cptr)shm; const lds_cptr xs = shm3 + L_XS + wid * 8192;
    const LAS float* cstab = (const LAS float*)(shm + L_CS); const LAS float* ecs = (const LAS float*)(shm + L_ECS); const LAS float* rdt = (const LAS float*)(shm + L_RDT);
    const float Dh = a.dpar[a.layer * 16 + h];
#pragma unroll 1
    for (int qb = 1; qb >= 0; --qb) {
        const int lane = opaque_v(lane0), r32 = lane & 31, hi = lane >> 5;
        bf16x8 qr[8];
#pragma unroll
        for (int d0 = 0; d0 < 8; ++d0) qr[d0] = *(const LAS bf16x8*)(shm + L_C + (2 * d0 + hi) * 1024 + (32 * qb + r32) * 16);
        f32x16 o[2];
#pragma unroll
        for (int dq = 0; dq < 2; ++dq) o[dq] = (f32x16){0.f, 0.f, 0.f, 0.f, 0.f, 0.f, 0.f, 0.f, 0.f, 0.f, 0.f, 0.f, 0.f, 0.f, 0.f, 0.f};
        const float cs_t = cstab[(32 * qb + r32) * 8 + wid], dd_t = Dh * rdt[(32 * qb + r32) * 8 + wid];
#pragma unroll 1
        for (int sb = 0; sb <= qb; ++sb) {
            f32x16 x = {0.f, 0.f, 0.f, 0.f, 0.f, 0.f, 0.f, 0.f, 0.f, 0.f, 0.f, 0.f, 0.f, 0.f, 0.f, 0.f};
#pragma unroll
            for (int d0 = 0; d0 < 8; ++d0) { const bf16x8 kf = *(const LAS bf16x8*)(shm + L_B + (2 * d0 + hi) * 1024 + (32 * sb + r32) * 16); x = ATT_MFMA(kf, qr[d0], x); }
#pragma unroll
            for (int r = 0; r < 16; ++r) { const int s = 32 * sb + crow(r, hi), t = 32 * qb + r32;
                x[r] = (s < t) ? x[r] * __expf(cs_t - cstab[s * 8 + wid]) : (s == t ? x[r] + dd_t : 0.f); }
            typedef unsigned u4 __attribute__((ext_vector_type(4)));
            const u4 w0 = {cvtpk(x[0], x[1]), cvtpk(x[2], x[3]), cvtpk(x[4], x[5]), cvtpk(x[6], x[7])}, w1 = {cvtpk(x[8], x[9]), cvtpk(x[10], x[11]), cvtpk(x[12], x[13]), cvtpk(x[14], x[15])};
            const bf16x8 pa0 = __builtin_bit_cast(bf16x8, w0), pa1 = __builtin_bit_cast(bf16x8, w1);
#pragma unroll
            for (int dq = 0; dq < 2; ++dq) { o[dq] = ATT_MFMA(pa0, trfrag_acc(xs + dq * 4096, 2 * sb, lane), o[dq]); o[dq] = ATT_MFMA(pa1, trfrag_acc(xs + dq * 4096, 2 * sb + 1, lane), o[dq]); }
        }
        const LAS float* ecs_l = ecs + (32 * qb + 4 * hi) * 8 + wid;
#pragma unroll
        for (int dq = 0; dq < 2; ++dq) { f32x16 acc = {0.f, 0.f, 0.f, 0.f, 0.f, 0.f, 0.f, 0.f, 0.f, 0.f, 0.f, 0.f, 0.f, 0.f, 0.f, 0.f};
#pragma unroll
            for (int d0 = 0; d0 < 8; ++d0) acc = ATT_MFMA(qr[d0], hf[dq][d0], acc);
            asm volatile("s_waitcnt lgkmcnt(0)" ::: "memory");
            LAS bf16* yw = (LAS bf16*)(shm + L_XS + wid * 8192 + dq * 4096 + (32 * qb + 4 * hi) * 64 + r32 * 2);
#pragma unroll
            for (int r = 0; r < 16; ++r) { const int tc = (r & 3) + 8 * (r >> 2); yw[tc * 32] = (bf16)f2bf(o[dq][r] + ecs_l[tc * 8] * acc[r]); } }
    }
    __syncthreads();
    { const int lane = opaque_v(lane0), h8 = lane >> 3; float gn[8];
      { const f32x4 g0 = *(const f32x4*)(a.norm_g + a.layer * 1024 + g * 512 + lane * 8), g1 = *(const f32x4*)(a.norm_g + a.layer * 1024 + g * 512 + lane * 8 + 4);
        gn[0] = g0.x; gn[1] = g0.y; gn[2] = g0.z; gn[3] = g0.w; gn[4] = g1.x; gn[5] = g1.y; gn[6] = g1.z; gn[7] = g1.w; }
      bf16* mb = a.mix + (size_t)row0 * DM + g * 512 + lane * 8;
      const LAS unsigned char* yb = shm + L_XS + h8 * 8192 + ((lane & 7) >> 2) * 4096 + (lane & 3) * 16;
#pragma unroll
      for (int i = 0; i < 8; ++i) { const int t = wid * 8 + i;
          const bf16x8 yv = *(const LAS bf16x8*)(yb + t * 64); float v[8], ss = 0.f;
#pragma unroll
          for (int e = 0; e < 8; ++e) { v[e] = bf2f((bf16)yv[e]) * silu_f(bf2f((bf16)zv[i][e])); ss += v[e] * v[e]; }
          const float rn = __builtin_amdgcn_rsqf(wave_sum(ss) * (1.f / 512.f) + EPS);
          u32x4 o; o.x = pk2(v[0] * rn * gn[0], v[1] * rn * gn[1]); o.y = pk2(v[2] * rn * gn[2], v[3] * rn * gn[3]); o.z = pk2(v[4] * rn * gn[4], v[5] * rn * gn[5]); o.w = pk2(v[6] * rn * gn[6], v[7] * rn * gn[7]);
          *(u32x4*)(mb + (unsigned)(t * DM)) = o; } }
    lds_barrier();
}
struct ScanArgs { const bf16* states; const float* decay; const float* state_in; bf16* hin; float* out; int layer, pad; };
__device__ __forceinline__ f32x4 ld_bf4(const bf16* p) { const u32x2 w = *(const u32x2*)p; return (f32x4){__builtin_bit_cast(float, w.x << 16), __builtin_bit_cast(float, w.x & 0xffff0000u), __builtin_bit_cast(float, w.y << 16), __builtin_bit_cast(float, w.y & 0xffff0000u)}; }
__device__ __forceinline__ f32x4 bf4_to_f32(const u32x2 w) { return (f32x4){__builtin_bit_cast(float, w.x << 16), __builtin_bit_cast(float, w.x & 0xffff0000u), __builtin_bit_cast(float, w.y << 16), __builtin_bit_cast(float, w.y & 0xffff0000u)}; }
__device__ __forceinline__ void scan_prompt(const ScanArgs& a, int e4) {
    const int h = e4 >> 11; f32x4 hv = {0.f, 0.f, 0.f, 0.f};
#pragma unroll 1
    for (int c0 = 0; c0 < SEQ / 64; c0 += 16) { u32x2 sr[16]; float dv[16];
#pragma unroll
        for (int j = 0; j < 16; ++j) { sr[j] = *(const u32x2*)(a.states + (size_t)(c0 + j) * 131072 + e4 * 4); dv[j] = a.decay[(c0 + j) * 16 + h]; }
#pragma unroll
        for (int j = 0; j < 16; ++j) { u32x2 o; o.x = pk2(hv.x, hv.y); o.y = pk2(hv.z, hv.w); *(u32x2*)(a.hin + (size_t)(c0 + j) * 131072 + e4 * 4) = o;
            hv = hv * dv[j] + bf4_to_f32(sr[j]); } }
    *(f32x4*)(a.out + O_HP + (size_t)a.layer * 131072 + e4 * 4) = hv;
}
__device__ __forceinline__ void scan_sample8(const ScanArgs& a, int b0, int e4) {
    const int h = e4 >> 11; f32x4 h0[8]; u32x2 sr[8]; float dv[8];
#pragma unroll
    for (int j = 0; j < 8; ++j) { const int b = b0 + j, c = SEQ / 64 + b; h0[j] = *(const f32x4*)(a.state_in + (size_t)(a.layer * DB + b) * 131072 + e4 * 4);
        sr[j] = *(const u32x2*)(a.states + (size_t)c * 131072 + e4 * 4); dv[j] = a.decay[c * 16 + h]; }
#pragma unroll
    for (int j = 0; j < 8; ++j) { const int b = b0 + j, c = SEQ / 64 + b;
        u32x2 o; o.x = pk2(h0[j].x, h0[j].y); o.y = pk2(h0[j].z, h0[j].w); *(u32x2*)(a.hin + (size_t)c * 131072 + e4 * 4) = o;
        *(f32x4*)(a.out + O_HS + (size_t)(a.layer * DB + b) * 131072 + e4 * 4) = h0[j] * dv[j] + bf4_to_f32(sr[j]); }
}
}
namespace glac {
using att::bf16x8; using att::f32x16; using att::lds_cptr; using att::cvtpk; using att::crow; using ssdc::trfrag_nat; using ssdc::trfrag_acc; using ssdc::pack8;
constexpr int L_B = 0, L_QT = 16384, L_KT = 24576, L_V = 32768, L_RED = 49152, LDS_NEED = 51200;
struct Args { const bf16* proj; const float* dtga; const float* wa2; const float* ba; const float* norm_g; float* btab; bf16* states; float* decay; const bf16* hin; bf16* mix; int layer, pad; };
__device__ __forceinline__ void btable(const Args& a, int row0, int h, LAS unsigned char* shm, int tid) {
    LAS float* bt = (LAS float*)(shm + L_B); LAS float* gs = (LAS float*)(shm + L_RED);
    const int tg = __builtin_amdgcn_readfirstlane(tid >> 6), k = tid & 63;
    float w[16];
#pragma unroll
    for (int r = 0; r < 16; ++r) w[r] = a.wa2[(size_t)(a.layer * 16 + r) * 256 + h * 64 + k];
    const float bias = a.ba[a.layer * 256 + h * 64 + k]; const float* ga = a.dtga + (size_t)(row0 + 8 * tg) * 32 + 16; float acc = 0.f;
#pragma unroll
    for (int j = 0; j < 8; ++j) { float x = bias;
#pragma unroll
        for (int r = 0; r < 16; ++r) x += ga[j * 32 + r] * w[r];
        acc += logsigmoid_f(x) * (1.f / 16.f); bt[(8 * tg + j) * 64 + k] = acc; }
    gs[tg * 64 + k] = acc;
    __syncthreads();
    float off = 0.f;
    for (int g2 = 0; g2 < tg; ++g2) off += gs[g2 * 64 + k];
#pragma unroll
    for (int j = 0; j < 8; ++j) bt[(8 * tg + j) * 64 + k] += off;
    __syncthreads();
}
__device__ __forceinline__ void stage_v(const Args& a, int row0, int h, LAS unsigned char* shm, int tid) {
    const bf16* vb = a.proj + (size_t)row0 * NPJ + C_GV + h * 128;
#pragma unroll
    for (int i = 0; i < 2; ++i) { const int it = tid + 512 * i, s = it >> 4, vg = it & 15;
        *(LAS u32x4*)(shm + L_V + (vg >> 2) * 4096 + s * 64 + (vg & 3) * 16) = *(const u32x4*)(vb + (unsigned)(s * NPJ + vg * 8)); }
}
__device__ __forceinline__ void pre_unit(const Args& a, int chunk, int h, LAS unsigned char* shm, int tid_) {
    const int tid = opaque_v(tid_), row0 = chunk * 64;
    const bf16x8 kv = *(const bf16x8*)(a.proj + (size_t)row0 * NPJ + C_GK + h * 64 + (unsigned)((tid >> 3) * NPJ + (tid & 7) * 8)); u32x4 vv[2];
    { const bf16* vbp = a.proj + (size_t)row0 * NPJ + C_GV + h * 128;
#pragma unroll
      for (int i = 0; i < 2; ++i) { const int it = tid + 512 * i, s = it >> 4, vg = it & 15; vv[i] = *(const u32x4*)(vbp + (unsigned)(s * NPJ + vg * 8)); } }
    btable(a, row0, h, shm, tid);
    const LAS float* bt = (const LAS float*)(shm + L_B);
    { float* bg = a.btab + (size_t)row0 * 256 + h * 64;
#pragma unroll
      for (int i = 0; i < 2; ++i) { const int it = tid + 512 * i, s = it >> 4, c4 = (it & 15) * 4; *(f32x4*)(bg + (unsigned)(s * 256 + c4)) = *(const LAS f32x4*)(bt + s * 64 + c4); } }
    { const int s = tid >> 3, kg = tid & 7; float y[8];
#pragma unroll
      for (int e = 0; e < 8; ++e) y[e] = bf2f((bf16)kv[e]) * __expf(bt[63 * 64 + kg * 8 + e] - bt[s * 64 + kg * 8 + e]);
      *(LAS u32x4*)(shm + L_QT + (kg >> 2) * 4096 + s * 64 + (kg & 3) * 16) = pack8(y); }
#pragma unroll
    for (int i = 0; i < 2; ++i) { const int it = tid + 512 * i, s = it >> 4, vg = it & 15; *(LAS u32x4*)(shm + L_V + (vg >> 2) * 4096 + s * 64 + (vg & 3) * 16) = vv[i]; }
    __syncthreads();
    const int lane = tid & 63, r32 = lane & 31, hi = lane >> 5, wid = __builtin_amdgcn_readfirstlane(tid >> 6), kb = wid & 1, vb = wid >> 1;
    const lds_cptr shm3 = (lds_cptr)shm;
    f32x16 acc = {0.f, 0.f, 0.f, 0.f, 0.f, 0.f, 0.f, 0.f, 0.f, 0.f, 0.f, 0.f, 0.f, 0.f, 0.f, 0.f};
#pragma unroll
    for (int ks = 0; ks < 4; ++ks) acc = ATT_MFMA(trfrag_nat(shm3 + L_QT + kb * 4096, ks, lane), trfrag_nat(shm3 + L_V + vb * 4096, ks, lane), acc);
    bf16* st = a.states + ((size_t)(chunk * 4 + h) * 128 + 32 * vb + r32) * 64 + 32 * kb + 4 * hi;
#pragma unroll
    for (int q = 0; q < 4; ++q) { u32x2 w; w.x = cvtpk(acc[4 * q], acc[4 * q + 1]); w.y = cvtpk(acc[4 * q + 2], acc[4 * q + 3]); *(u32x2*)(st + 8 * q) = w; }
    if (tid < 64) a.decay[(chunk * 4 + h) * 64 + tid] = __expf(bt[63 * 64 + tid]);
    lds_barrier();
}
__device__ __forceinline__ void post_unit(const Args& a, int chunk, int h, LAS unsigned char* shm, int tid_) {
    const int tid = opaque_v(tid_), row0 = chunk * 64;
    const int lane = tid & 63, r32 = lane & 31, hi = lane >> 5, wid = __builtin_amdgcn_readfirstlane(tid >> 6), tb = wid & 1, vb = wid >> 1, rs = lane >> 4, cg = lane & 15;
    const LAS float* bt = (const LAS float*)(shm + L_B);
    f32x4 btv[2]; u32x4 vv[2]; bf16x8 hf[4], gv[2];
    { const float* bg = a.btab + (size_t)row0 * 256 + h * 64;
#pragma unroll
      for (int i = 0; i < 2; ++i) { const int it = tid + 512 * i, s = it >> 4, c4 = (it & 15) * 4; btv[i] = *(const f32x4*)(bg + (unsigned)(s * 256 + c4)); } }
    const bf16* pr = a.proj + (size_t)row0 * NPJ + h * 64;
    const bf16x8 qv = *(const bf16x8*)(pr + (unsigned)((tid >> 3) * NPJ + C_GQ + (tid & 7) * 8)), kv = *(const bf16x8*)(pr + (unsigned)((tid >> 3) * NPJ + C_GK + (tid & 7) * 8));
    { const bf16* vbp = a.proj + (size_t)row0 * NPJ + C_GV + h * 128;
#pragma unroll
      for (int i = 0; i < 2; ++i) { const int it = tid + 512 * i, s = it >> 4, vg = it & 15; vv[i] = *(const u32x4*)(vbp + (unsigned)(s * NPJ + vg * 8)); } }
    { const bf16* hin = a.hin + ((size_t)(chunk * 4 + h) * 128 + 32 * vb + r32) * 64 + 8 * hi;
#pragma unroll
      for (int d0 = 0; d0 < 4; ++d0) hf[d0] = *(const bf16x8*)(hin + 16 * d0); }
#pragma unroll
    for (int i = 0; i < 2; ++i) gv[i] = *(const bf16x8*)(a.proj + (size_t)(row0 + wid * 8 + i * 4 + rs) * NPJ + C_GG + h * 128 + cg * 8);
    const f32x4 g0 = *(const f32x4*)(a.norm_g + a.layer * 128 + cg * 8), g1 = *(const f32x4*)(a.norm_g + a.layer * 128 + cg * 8 + 4);
#pragma unroll
    for (int i = 0; i < 2; ++i) { const int it = tid + 512 * i, s = it >> 4, c4 = (it & 15) * 4; *(LAS f32x4*)((LAS float*)(shm + L_B) + s * 64 + c4) = btv[i]; }
    __syncthreads();
    { const int s = tid >> 3, kg = tid & 7; float yq[8], yk[8];
#pragma unroll
      for (int e = 0; e < 8; ++e) { const float bb = bt[s * 64 + kg * 8 + e]; yq[e] = bf2f((bf16)qv[e]) * 0.125f * __expf(bb); yk[e] = bf2f((bf16)kv[e]) * __expf(-bb); }
      *(LAS u32x4*)(shm + L_QT + kg * 1024 + s * 16) = pack8(yq); *(LAS u32x4*)(shm + L_KT + kg * 1024 + s * 16) = pack8(yk); }
#pragma unroll
    for (int i = 0; i < 2; ++i) { const int it = tid + 512 * i, s = it >> 4, vg = it & 15; *(LAS u32x4*)(shm + L_V + (vg >> 2) * 4096 + s * 64 + (vg & 3) * 16) = vv[i]; }
    __syncthreads();
    const lds_cptr shm3 = (lds_cptr)shm;
    bf16x8 qr[4];
#pragma unroll
    for (int d0 = 0; d0 < 4; ++d0) qr[d0] = *(const LAS bf16x8*)(shm + L_QT + (2 * d0 + hi) * 1024 + (32 * tb + r32) * 16);
    f32x16 o = {0.f, 0.f, 0.f, 0.f, 0.f, 0.f, 0.f, 0.f, 0.f, 0.f, 0.f, 0.f, 0.f, 0.f, 0.f, 0.f};
#pragma unroll
    for (int d0 = 0; d0 < 4; ++d0) o = ATT_MFMA(qr[d0], hf[d0], o);
#pragma unroll 1
    for (int sb = 0; sb <= tb; ++sb) {
        f32x16 x = {0.f, 0.f, 0.f, 0.f, 0.f, 0.f, 0.f, 0.f, 0.f, 0.f, 0.f, 0.f, 0.f, 0.f, 0.f, 0.f};
#pragma unroll
        for (int d0 = 0; d0 < 4; ++d0) x = ATT_MFMA(*(const LAS bf16x8*)(shm + L_KT + (2 * d0 + hi) * 1024 + (32 * sb + r32) * 16), qr[d0], x);
#pragma unroll
        for (int r = 0; r < 16; ++r) { const int s = 32 * sb + crow(r, hi), t = 32 * tb + r32; x[r] = (s <= t) ? x[r] : 0.f; }
        typedef unsigned u4 __attribute__((ext_vector_type(4)));
        const u4 w0 = {cvtpk(x[0], x[1]), cvtpk(x[2], x[3]), cvtpk(x[4], x[5]), cvtpk(x[6], x[7])}, w1 = {cvtpk(x[8], x[9]), cvtpk(x[10], x[11]), cvtpk(x[12], x[13]), cvtpk(x[14], x[15])};
        o = ATT_MFMA(__builtin_bit_cast(bf16x8, w0), trfrag_acc(shm3 + L_V + vb * 4096, 2 * sb, lane), o);
        o = ATT_MFMA(__builtin_bit_cast(bf16x8, w1), trfrag_acc(shm3 + L_V + vb * 4096, 2 * sb + 1, lane), o);
    }
    __syncthreads();
    { LAS float* ot = (LAS float*)shm + (32 * tb + 4 * hi) * 128 + 32 * vb + r32;
#pragma unroll
      for (int r = 0; r < 16; ++r) ot[((r & 3) + 8 * (r >> 2)) * 128] = o[r]; }
    __syncthreads();
    { const float gn[8] = {g0.x, g0.y, g0.z, g0.w, g1.x, g1.y, g1.z, g1.w};
#pragma unroll
      for (int i = 0; i < 2; ++i) { const int t = wid * 8 + i * 4 + rs;
          const f32x4 a0 = *(const LAS f32x4*)((LAS float*)shm + t * 128 + cg * 8), a1 = *(const LAS f32x4*)((LAS float*)shm + t * 128 + cg * 8 + 4);
          float v[8] = {a0.x, a0.y, a0.z, a0.w, a1.x, a1.y, a1.z, a1.w}; float ss = 0.f;
#pragma unroll
          for (int e = 0; e < 8; ++e) ss += v[e] * v[e];
          ss += dpp_xor1(ss); ss += dpp_xor2(ss); ss += swz_xor4(ss); ss += swz_xor8(ss);
          const float rn = __builtin_amdgcn_rsqf(ss * (1.f / 128.f) + EPS);
#pragma unroll
          for (int e = 0; e < 8; ++e) v[e] = v[e] * rn * gn[e] * silu_f(bf2f((bf16)gv[i][e]));
          *(u32x4*)(a.mix + (size_t)(row0 + t) * DM + 1536 + h * 128 + cg * 8) = pack8(v); } }
    lds_barrier();
}
struct ScanArgs { const bf16* states; const float* decay; const float* state_in; bf16* hin; float* out; int layer, pad; };
__device__ __forceinline__ void scan_prompt(const ScanArgs& a, int e4) {
    const int h = e4 >> 11, k = (e4 * 4) & 63, v = (e4 >> 4) & 127; f32x4 sv = {0.f, 0.f, 0.f, 0.f};
#pragma unroll 1
    for (int c0 = 0; c0 < SEQ / 64; c0 += 8) { u32x2 sr[8]; f32x4 dv[8];
#pragma unroll
        for (int j = 0; j < 8; ++j) { sr[j] = *(const u32x2*)(a.states + (size_t)(c0 + j) * 32768 + e4 * 4); dv[j] = *(const f32x4*)(a.decay + ((c0 + j) * 4 + h) * 64 + k); }
#pragma unroll
        for (int j = 0; j < 8; ++j) { u32x2 o; o.x = pk2(sv.x, sv.y); o.y = pk2(sv.z, sv.w); *(u32x2*)(a.hin + (size_t)(c0 + j) * 32768 + e4 * 4) = o;
            sv = sv * dv[j] + ssdc::bf4_to_f32(sr[j]); } }
    float* op = a.out + O_SP + ((size_t)(a.layer * 4 + h) * 64 + k) * 128 + v; op[0] = sv.x; op[128] = sv.y; op[256] = sv.z; op[384] = sv.w;
}
__device__ __forceinline__ void scan_sample8(const ScanArgs& a, int b0, int e4) {
    const int h = e4 >> 11, k = (e4 * 4) & 63, v = (e4 >> 4) & 127; f32x4 s0[8], dv[8]; u32x2 sr[8];
#pragma unroll
    for (int j = 0; j < 8; ++j) { const int b = b0 + j, c = SEQ / 64 + b; const float* ip = a.state_in + ((size_t)((a.layer * DB + b) * 4 + h) * 64 + k) * 128 + v; s0[j] = (f32x4){ip[0], ip[128], ip[256], ip[384]};
        sr[j] = *(const u32x2*)(a.states + (size_t)c * 32768 + e4 * 4); dv[j] = *(const f32x4*)(a.decay + (c * 4 + h) * 64 + k); }
#pragma unroll
    for (int j = 0; j < 8; ++j) { const int b = b0 + j, c = SEQ / 64 + b;
        u32x2 o; o.x = pk2(s0[j].x, s0[j].y); o.y = pk2(s0[j].z, s0[j].w); *(u32x2*)(a.hin + (size_t)c * 32768 + e4 * 4) = o;
        const f32x4 sv = s0[j] * dv[j] + ssdc::bf4_to_f32(sr[j]);
        float* op = a.out + O_SS + ((size_t)((a.layer * DB + b) * 4 + h) * 64 + k) * 128 + v; op[0] = sv.x; op[128] = sv.y; op[256] = sv.z; op[384] = sv.w; }
}
}
__device__ __forceinline__ int win_orig_col(int n) {
    if (n < 2560) return n;
    if (n < 5120) return n + 16;
    if (n < 5632) return n + 32;
    if (n < 5648) return 2560 + (n - 5632);
    if (n < 5664) return 5136 + (n - 5648);
    return -1;
}
__device__ __forceinline__ void tw_load(const float* __restrict__ W, const float* __restrict__ gk, int N, int nblk, int mode, int item, int lane, f32x4 (&v)[8]) {
    const int kb = item / nblk, nb = item % nblk, k0 = 64 * kb, n0 = 32 * nb + (lane & 7) * 4; const int oc = mode ? win_orig_col(n0) : n0;
#pragma unroll
    for (int i = 0; i < 8; ++i) { const int kk = k0 + 8 * i + (lane >> 3);
        if (oc >= 0) { const f32x4 w = *(const f32x4*)(W + (size_t)kk * N + oc); v[i] = gk ? w * gk[kk] : w; } else v[i] = (f32x4){0.f, 0.f, 0.f, 0.f}; }
}
__device__ __forceinline__ void transpose_w(const float* __restrict__ W, const float* __restrict__ gk  , int K, int N, bf16* __restrict__ WT, int Nout, int mode, LAS float* scr, int gw, int ngw, int lane) {
    const int nblk = Nout / 32, nitems = (K / 64) * nblk;
    f32x4 cur[8], nxt[8];
    if (gw < nitems) tw_load(W, gk, N, nblk, mode, gw, lane, cur);
    for (int item = gw; item < nitems; item += ngw) {
        const bool more = item + ngw < nitems;
        if (more) tw_load(W, gk, N, nblk, mode, item + ngw, lane, nxt);
        const int kb = item / nblk, nb = item % nblk, k0 = 64 * kb, n0 = 32 * nb;
#pragma unroll
        for (int i = 0; i < 8; ++i) { LAS float* d = scr + (8 * i + (lane >> 3)) * 33 + (lane & 7) * 4; d[0] = cur[i].x; d[1] = cur[i].y; d[2] = cur[i].z; d[3] = cur[i].w; }
        __builtin_amdgcn_s_waitcnt(0xC07F); __builtin_amdgcn_wave_barrier();
        const int c = lane & 7;
#pragma unroll
        for (int j = 0; j < 4; ++j) { const int n = (lane >> 3) + 8 * j; const LAS float* s = scr + (8 * c) * 33 + n;
            u32x4 o; o.x = pk2(s[0 * 33], s[1 * 33]); o.y = pk2(s[2 * 33], s[3 * 33]); o.z = pk2(s[4 * 33], s[5 * 33]); o.w = pk2(s[6 * 33], s[7 * 33]);
            *(u32x4*)(WT + (size_t)(n0 + n) * K + k0 + 8 * c) = o; }
        __builtin_amdgcn_s_waitcnt(0xC07F); __builtin_amdgcn_wave_barrier();
        if (more) {
#pragma unroll
            for (int i = 0; i < 8; ++i) cur[i] = nxt[i]; }
    }
}
__device__ __forceinline__ void transpose_w4(const float* __restrict__ W, const float* __restrict__ gk, int K, int N, bf16* __restrict__ WT, int Nout, int mode, LAS float* scr, int gw, int ngw, int lane) {
    const int nblk = Nout / 32, nitems = (K / 64) * nblk;
    for (int base = gw; base < nitems; base += 4 * ngw) {
        f32x4 t[4][8]; float gv[4][8], msk[4];
#pragma unroll
        for (int q = 0; q < 4; ++q) { int item = base + q * ngw; if (item >= nitems) item = base;
            const int kb = item / nblk, nb = item % nblk, k0 = 64 * kb, n0 = 32 * nb + (lane & 7) * 4; const int oc = mode ? win_orig_col(n0) : n0; msk[q] = oc >= 0 ? 1.f : 0.f; const int ocs = oc >= 0 ? oc : 0;
#pragma unroll
            for (int i = 0; i < 8; ++i) { const int kk = k0 + 8 * i + (lane >> 3); t[q][i] = *(const f32x4*)(W + (size_t)kk * N + ocs); gv[q][i] = gk ? gk[kk] : 1.f; } }
#pragma unroll
        for (int q = 0; q < 4; ++q) { const int item = base + q * ngw; if (item >= nitems) break;
            const int kb = item / nblk, nb = item % nblk, k0 = 64 * kb, n0 = 32 * nb;
#pragma unroll
            for (int i = 0; i < 8; ++i) { LAS float* d = scr + (8 * i + (lane >> 3)) * 33 + (lane & 7) * 4; const float gg = gv[q][i] * msk[q]; d[0] = t[q][i].x * gg; d[1] = t[q][i].y * gg; d[2] = t[q][i].z * gg; d[3] = t[q][i].w * gg; }
            __builtin_amdgcn_s_waitcnt(0xC07F); __builtin_amdgcn_wave_barrier();
            const int c = lane & 7;
#pragma unroll
            for (int j = 0; j < 4; ++j) { const int n = (lane >> 3) + 8 * j; const LAS float* s = scr + (8 * c) * 33 + n;
                u32x4 o; o.x = pk2(s[0 * 33], s[1 * 33]); o.y = pk2(s[2 * 33], s[3 * 33]); o.z = pk2(s[4 * 33], s[5 * 33]); o.w = pk2(s[6 * 33], s[7 * 33]);
                *(u32x4*)(WT + (size_t)(n0 + n) * K + k0 + 8 * c) = o; }
            __builtin_amdgcn_s_waitcnt(0xC07F); __builtin_amdgcn_wave_barrier(); }
    }
}
__device__ __forceinline__ void scalars_body(const float* __restrict__ diff_lambda, float* ctlf, int l) {
    const float* p = diff_lambda + l * 256; float s1 = 0.f, s2 = 0.f;
    for (int i = 0; i < 64; ++i) { s1 += p[i] * p[64 + i]; s2 += p[128 + i] * p[192 + i]; }
    ctlf[l] = expf(s1) - expf(s2) + (0.8f - 0.6f * expf(-0.3f * (float)l));
}
__device__ __forceinline__ void xrow_to_bf16(const float* __restrict__ xa, const float* __restrict__ xb, bf16* __restrict__ XB, float* __restrict__ ssq, int row, int lane) {
    const float* x = row < SEQ ? xa + (size_t)row * DM : xb + (size_t)(row - SEQ) * DM;
    f32x4 v[8]; float s = 0.f;
#pragma unroll
    for (int j = 0; j < 8; ++j) { v[j] = ((const f32x4*)x)[lane + 64 * j]; s += (v[j].x * v[j].x + v[j].y * v[j].y) + (v[j].z * v[j].z + v[j].w * v[j].w); }
    s = wave_sum(s);
#pragma unroll
    for (int j = 0; j < 8; ++j) { u32x2 o; o.x = pk2(v[j].x, v[j].y); o.y = pk2(v[j].z, v[j].w); ((u32x2*)(XB + (size_t)row * DM))[lane + 64 * j] = o; }
    if (lane == 0) ssq[row] = s;
}
struct PrepArgs { const bf16* proj; const float* dtga; const float* conv_state; const float* conv_w; const float* conv_b; const float* dt_bias; const float* wa2; const float* ba;
                  const float* qn_g; const float* kn_g; float* xc; float* dt; float* loga; bf16* qn; bf16* kp; bf16* vp; bf16* kc; bf16* vc; float* out; int layer, pad; };
__device__ __forceinline__ float sum8(float v) { v += dpp_xor1(v); v += dpp_xor2(v); v += swz_xor4(v); return v; }
__device__ __forceinline__ void prep_row(const PrepArgs& a, int row, int lane, float& qmax2, float& kmax2) {
    typedef short bf16x8 __attribute__((ext_vector_type(8)));
    const int l = a.layer; const bool isS = row >= SEQ; const int b = isS ? (row - SEQ) >> 6 : 0, t = isS ? (row - SEQ) & 63 : row, L = isS ? DS : SEQ;
    const bf16* pr = a.proj + (size_t)row * NPJ; const int c0 = 8 * lane, d = c0 & 63;
    const bf16x8 qv = *(const bf16x8*)(pr + C_DQ + c0), kv = *(const bf16x8*)(pr + C_DK + c0); const u32x4 vv = *(const u32x4*)(pr + C_DV + c0);
    float q[8], k[8], sq = 0.f, sk = 0.f;
#pragma unroll
    for (int e = 0; e < 8; ++e) { q[e] = bf2f((bf16)qv[e]); k[e] = bf2f((bf16)kv[e]); sq += q[e] * q[e]; sk += k[e] * k[e]; }
    sq = sum8(sq); sk = sum8(sk);
    const float rq = __builtin_amdgcn_rsqf(sq * (1.f / 64.f) + EPS) * att::QSCALE, rk = __builtin_amdgcn_rsqf(sk * (1.f / 64.f) + EPS);
    const f32x4 gq0 = *(const f32x4*)(a.qn_g + l * 64 + d), gq1 = *(const f32x4*)(a.qn_g + l * 64 + d + 4), gk0 = *(const f32x4*)(a.kn_g + l * 64 + d), gk1 = *(const f32x4*)(a.kn_g + l * 64 + d + 4);
    const float gq[8] = {gq0.x, gq0.y, gq0.z, gq0.w, gq1.x, gq1.y, gq1.z, gq1.w}, gk[8] = {gk0.x, gk0.y, gk0.z, gk0.w, gk1.x, gk1.y, gk1.z, gk1.w};
    float nq = 0.f, nk = 0.f;
#pragma unroll
    for (int e = 0; e < 8; ++e) { q[e] *= rq * gq[e]; k[e] *= rk * gk[e]; const float qr = rbf(q[e]), kr = rbf(k[e]); nq += qr * qr; nk += kr * kr; }
    qmax2 = fmaxf(qmax2, sum8(nq)); kmax2 = fmaxf(kmax2, sum8(nk));
    u32x4 qo, ko; qo.x = pk2(q[0], q[1]); qo.y = pk2(q[2], q[3]); qo.z = pk2(q[4], q[5]); qo.w = pk2(q[6], q[7]); ko.x = pk2(k[0], k[1]); ko.y = pk2(k[2], k[3]); ko.z = pk2(k[4], k[5]); ko.w = pk2(k[6], k[7]);
    *(u32x4*)(a.qn + (size_t)row * 512 + c0) = qo;
    const size_t kvrow = isS ? (size_t)b * (PAST + DS) + PAST + t : (size_t)row; bf16* kd = isS ? a.kc : a.kp; bf16* vd = isS ? a.vc : a.vp;
    *(u32x4*)(kd + kvrow * 512 + c0) = ko; *(u32x4*)(vd + kvrow * 512 + c0) = vv;
    float* ko_f = a.out + (isS ? O_KS + ((size_t)(l * DB + b) * DS + t) * 512 : O_KP + ((size_t)l * SEQ + t) * 512) + c0;
    float* vo_f = a.out + (isS ? O_VS + ((size_t)(l * DB + b) * DS + t) * 512 : O_VP + ((size_t)l * SEQ + t) * 512) + c0;
    *(f32x4*)(ko_f) = (f32x4){k[0], k[1], k[2], k[3]}; *(f32x4*)(ko_f + 4) = (f32x4){k[4], k[5], k[6], k[7]};
    *(f32x4*)(vo_f) = (f32x4){bf2f((bf16)(vv.x & 0xffff)), bf2f((bf16)(vv.x >> 16)), bf2f((bf16)(vv.y & 0xffff)), bf2f((bf16)(vv.y >> 16))};
    *(f32x4*)(vo_f + 4) = (f32x4){bf2f((bf16)(vv.z & 0xffff)), bf2f((bf16)(vv.z >> 16)), bf2f((bf16)(vv.w & 0xffff)), bf2f((bf16)(vv.w >> 16))};
    if (t >= L - 3) { const int idx = t - (L - 3);
        float* dst = a.out + (isS ? O_CS + ((size_t)(l * DB + b) * 3 + idx) * CONV_DIM : O_CP + (size_t)(l * 3 + idx) * CONV_DIM);
        for (int c = lane; c < CONV_DIM; c += 64) dst[c] = bf2f(pr[C_XBC + c]); }
}
__device__ __forceinline__ void cache_convert(const float* __restrict__ ck, const float* __restrict__ cv, bf16* __restrict__ kc, bf16* __restrict__ vc, int layer, int gtid, int ngt, float& kmax2) {
    const size_t n8 = (size_t)DB * PAST * 512 / 8; const float* sk = ck + (size_t)layer * DB * PAST * 512; const float* sv = cv + (size_t)layer * DB * PAST * 512;
    for (size_t i = gtid; i < n8; i += ngt) { const size_t e = i * 8, row = e >> 9, col = e & 511, b = row / PAST, pos = row % PAST; const size_t d = (b * (PAST + DS) + pos) * 512 + col;
        const f32x4 a0 = *(const f32x4*)(sk + e), a1 = *(const f32x4*)(sk + e + 4), b0 = *(const f32x4*)(sv + e), b1 = *(const f32x4*)(sv + e + 4);
        u32x4 o; o.x = pk2(a0.x, a0.y); o.y = pk2(a0.z, a0.w); o.z = pk2(a1.x, a1.y); o.w = pk2(a1.z, a1.w); *(u32x4*)(kc + d) = o;
        { float ss = 0.f; const float v8[8] = {a0.x, a0.y, a0.z, a0.w, a1.x, a1.y, a1.z, a1.w};
#pragma unroll
          for (int j = 0; j < 8; ++j) { const float r = rbf(v8[j]); ss += r * r; }
          ss += dpp_xor1(ss); ss += dpp_xor2(ss); ss += swz_xor4(ss); kmax2 = fmaxf(kmax2, ss); }
        o.x = pk2(b0.x, b0.y); o.y = pk2(b0.z, b0.w); o.z = pk2(b1.x, b1.y); o.w = pk2(b1.z, b1.w); *(u32x4*)(vc + d) = o; }
}
__device__ __forceinline__ void cache_convert_queue(const float* __restrict__ ck, const float* __restrict__ cv, bf16* __restrict__ kc, bf16* __restrict__ vc, int layer, unsigned* qword, unsigned* kmax_word,
                                                    volatile LAS unsigned* qw, int tid, int lane, unsigned ch0 = 0u, unsigned nch = 512u) {
    const float* sk = ck + (size_t)layer * DB * PAST * 512; const float* sv = cv + (size_t)layer * DB * PAST * 512; float kmax2 = 0.f;
    for (;;) {
        if (tid == 0) qw[0] = atomicAdd(qword, 1u);
        __syncthreads(); const unsigned cq = qw[0]; __syncthreads();
        if (cq >= nch) break;
        const unsigned ch = ch0 + cq;
#pragma unroll 1
        for (int it0 = 0; it0 < 16; it0 += 4) { f32x4 A0[4], A1[4], B0[4], B1[4];
#pragma unroll
            for (int j = 0; j < 4; ++j) { const size_t e = ((size_t)ch * 8192 + (it0 + j) * 512 + tid) * 8; A0[j] = *(const f32x4*)(sk + e); A1[j] = *(const f32x4*)(sk + e + 4); B0[j] = *(const f32x4*)(sv + e); B1[j] = *(const f32x4*)(sv + e + 4); }
#pragma unroll
            for (int j = 0; j < 4; ++j) { const size_t e = ((size_t)ch * 8192 + (it0 + j) * 512 + tid) * 8, row = e >> 9, col = e & 511, b = row / PAST, pos = row % PAST; const size_t d = (b * (PAST + DS) + pos) * 512 + col;
                const f32x4 a0 = A0[j], a1 = A1[j], b0 = B0[j], b1 = B1[j];
                u32x4 o; o.x = pk2(a0.x, a0.y); o.y = pk2(a0.z, a0.w); o.z = pk2(a1.x, a1.y); o.w = pk2(a1.z, a1.w); *(u32x4*)(kc + d) = o;
                { float ss = 0.f; const float v8[8] = {a0.x, a0.y, a0.z, a0.w, a1.x, a1.y, a1.z, a1.w};
#pragma unroll
                  for (int q = 0; q < 8; ++q) { const float r = rbf(v8[q]); ss += r * r; }
                  ss += dpp_xor1(ss); ss += dpp_xor2(ss); ss += swz_xor4(ss); kmax2 = fmaxf(kmax2, ss); }
                o.x = pk2(b0.x, b0.y); o.y = pk2(b0.z, b0.w); o.z = pk2(b1.x, b1.y); o.w = pk2(b1.z, b1.w); *(u32x4*)(vc + d) = o; } }
    }
    kmax2 = wave_max(kmax2); if (lane == 0 && kmax2 > 0.f) atomicMax(kmax_word, __float_as_uint(kmax2));
}
constexpr int NCONV = 160;
#ifndef WGM_IN
#define WGM_IN 4
#endif
#ifndef WGM_M1
#define WGM_M1 4
#endif
constexpr int RING_OFF = 0, RING_BYTES = 131072, LDSCTL_OFF = RING_BYTES, MISC_OFF = LDSCTL_OFF + 320, LDS_BYTES = 147456;
constexpr int CW_GSL = 65536;
constexpr int CW_TMO = 0, CW_CODE = 1, CW_BAR = 4096, CW_LAM = 8192, CW_QMAX = 8320, CW_KMAX = 8448, CW_QSCAN = 8576, CW_QATT = 8704, CW_QCONV = 12288  , CW_QPRE = 8832  , CW_SEG = 16384;
constexpr int NWAVES = 8;
__device__ int probe_reps[12] = {1, 1, 1, 1, 1, 1, 1, 1, 1, 1, 1, 1};
#define REPS(k) __builtin_amdgcn_readfirstlane(probe_reps[k])
__device__ int probe_scan = 1;
struct Params { const float* in[26]; float* out; unsigned char* ws; };
enum { I_XP = 0, I_XS, I_CK, I_CV, I_STCONV, I_STSSD, I_STGLA, I_N1G, I_WIN, I_CONVW, I_CONVB, I_DTB, I_ALOG, I_SSDD, I_SSDNG, I_QNG, I_KNG, I_DLAM, I_DOUTG, I_WA2, I_GBA, I_GLANG, I_WOUT, I_N2G, I_W1, I_W2, I_OUT, I_WS };
typedef const float* cfp;
typedef const __attribute__((address_space(4))) cfp* kargp;
__device__ __forceinline__ kargp kargs_opaque() { kargp p = (kargp)__builtin_amdgcn_kernarg_segment_ptr(); asm volatile("" : "+s"(p)); return p; }
#define PHASE_ENTER() \
    const kargp ka = kargs_opaque(); const int wave = opaque_s(wave_s), lane = opaque_v(lane_id()), tid = wave * 64 + lane; \
    const int bx = opaque_s((int)blockIdx.x), G = (int)gridDim.x; const int gw = bx * NWAVES + wave, ngw = G * NWAVES, vb = tid >> 8, vt = tid & 255, nvb = 2 * G; \
    unsigned char* const ws = (unsigned char*)ka[I_WS]; float* const out = (float*)ka[I_OUT]; \
    (void)lane; (void)gw; (void)ngw; (void)vb; (void)vt; (void)nvb; (void)ws; (void)out
#define WSP(T, off) ((T*)(ws + (off)))

__global__ void __launch_bounds__(NWAVES * 64, 2) fwd_kernel(Params P) {
    extern __shared__ __attribute__((aligned(16))) unsigned char lds[];
    LAS unsigned char* const ldsp = (LAS unsigned char*)lds;
    XcdBarrier bar;
    const int wave_s = __builtin_amdgcn_readfirstlane((int)threadIdx.x >> 6);
    {
        PHASE_ENTER();
        volatile LAS unsigned* const MISC = (volatile LAS unsigned*)(ldsp + MISC_OFF);
        for (int u = tid; u < (LDS_BYTES - LDSCTL_OFF) / 4; u += NWAVES * 64) ((LAS unsigned*)(ldsp + LDSCTL_OFF))[u] = 0u;
        __syncthreads();
        bar = xcd_barrier_post((unsigned*)(WSP(unsigned, WS_CTL) + CW_BAR), MISC + 8);
        LAS float* scr = (LAS float*)(ldsp + RING_OFF + wave * 16384);
        for (int rep = REPS(0) - 1; rep >= 0; --rep) {
        transpose_w(ka[I_WIN], ka[I_N1G], DM, IN_COLS, WSP(bf16, WS_WIN), NPAD, 1, scr, gw, ngw, lane);
        if (gw == 0 && lane < DEPTH) scalars_body(ka[I_DLAM], WSP(float, WS_CTL) + CW_LAM, lane);
        for (int row = gw; row < NROW; row += ngw) xrow_to_bf16(ka[I_XP], ka[I_XS], WSP(bf16, WS_H), WSP(float, WS_SUMSQ), row, lane);
        }
        for (int i = bx * (NWAVES * 64) + tid; i < 3 * NROW; i += G * NWAVES * 64) (WSP(float, WS_SUMSQ) + NROW)[i] = 0.f;
    }
#define GRID_BAR() do { XcdBarrier b_ = bar; asm volatile("" : "+s"(b_.bar), "+s"(b_.x)); xcd_barrier(b_); } while (0)
    GRID_BAR();
    for (int rep = REPS(3) - 1; rep > 0; --rep) GRID_BAR();
    for (int l = 0; l < DEPTH; ++l) {
        for (int rep = REPS(1) - 1; rep >= 0; --rep) {
        { PHASE_ENTER();
          pg8::Gemm g{WSP(bf16, WS_H), WSP(bf16, WS_WIN) + (size_t)l * NPAD * DM, NROW, NPAD, DM}; pg8::StaticOrder S; S.init(NROW, NPAD, G, bx, DM); S.wgm = WGM_IN;
          pg8::EpiInProj E{WSP(bf16, WS_PROJ), WSP(float, WS_DTGA), WSP(float, WS_SUMSQ) + (size_t)(2 * l) * NROW};
          pg8::gemm_phase<pg8::EpiInProj, pg8::StaticOrder, true, true>(ldsp + RING_OFF, g, S, E, tid);
          if (rep == 0) { if (l == 0) cache_convert_queue(ka[I_CK], ka[I_CV], WSP(bf16, WS_KC), WSP(bf16, WS_VC), 0, WSP(unsigned, WS_CTL) + CW_QCONV, WSP(unsigned, WS_CTL) + CW_KMAX,
                                                      (volatile LAS unsigned*)(ldsp + MISC_OFF) + 12, tid, lane);
                          else cache_convert_queue(ka[I_CK], ka[I_CV], WSP(bf16, WS_KC), WSP(bf16, WS_VC), l, WSP(unsigned, WS_CTL) + CW_QCONV + 16 * l + 8, WSP(unsigned, WS_CTL) + CW_KMAX + 64 * l,
                                                      (volatile LAS unsigned*)(ldsp + MISC_OFF) + 12, tid, lane, 256u, 256u); } }
                if (rep > 0) GRID_BAR(); }
        GRID_BAR();
        { PHASE_ENTER();
          PrepArgs pa; pa.proj = WSP(bf16, WS_PROJ); pa.dtga = WSP(float, WS_DTGA); pa.conv_state = ka[I_STCONV]; pa.conv_w = ka[I_CONVW]; pa.conv_b = ka[I_CONVB]; pa.dt_bias = ka[I_DTB]; pa.wa2 = ka[I_WA2]; pa.ba = ka[I_GBA];
          pa.qn_g = ka[I_QNG]; pa.kn_g = ka[I_KNG]; pa.xc = nullptr; pa.dt = nullptr; pa.loga = nullptr; pa.qn = WSP(bf16, WS_QN); pa.kp = WSP(bf16, WS_KP); pa.vp = WSP(bf16, WS_VP); pa.kc = WSP(bf16, WS_KC); pa.vc = WSP(bf16, WS_VC); pa.out = out; pa.layer = l; pa.pad = 0;
          float qmax2 = 0.f, kmax2 = 0.f;
          for (int rep = REPS(6) - 1; rep >= 0; --rep)
#pragma unroll 3
          for (int row = gw; row < NROW; row += ngw) prep_row(pa, row, lane, qmax2, kmax2);
          qmax2 = wave_max(qmax2); kmax2 = wave_max(kmax2);
          if (lane == 0) { atomicMax(WSP(unsigned, WS_CTL) + CW_QMAX + 64 * l, __float_as_uint(qmax2)); atomicMax(WSP(unsigned, WS_CTL) + CW_KMAX + 64 * l, __float_as_uint(kmax2)); } }
        { PHASE_ENTER();
          ssdc::Args sa; sa.proj = WSP(bf16, WS_PROJ); sa.dtga = WSP(float, WS_DTGA); sa.dt_bias = ka[I_DTB]; sa.conv_state = ka[I_STCONV]; sa.conv_w = ka[I_CONVW]; sa.conv_b = ka[I_CONVB]; sa.a_log = ka[I_ALOG]; sa.dpar = ka[I_SSDD];
          sa.norm_g = ka[I_SSDNG]; sa.states = WSP(bf16, WS_SSTATE); sa.decay = WSP(float, WS_SDECAY); sa.hin = WSP(bf16, WS_HIN); sa.mix = WSP(bf16, WS_MIX); sa.layer = l; sa.pad = 0;
          for (int rep = REPS(8) - 1; rep >= 0; --rep)
          { volatile LAS unsigned* qw = (volatile LAS unsigned*)(ldsp + MISC_OFF) + 12;
            for (;;) { if (tid == 0) qw[0] = atomicAdd(WSP(unsigned, WS_CTL) + CW_QPRE + 0 + 64 * l + 1024 * rep, 1u);
                lds_barrier(); const int u = (int)qw[0]; lds_barrier(); if (u >= 576) break; ssdc::pre_unit(sa, u >> 1, u & 1, ldsp + RING_OFF, tid); } } }
        { PHASE_ENTER();
          glac::Args ga; ga.proj = WSP(bf16, WS_PROJ); ga.dtga = WSP(float, WS_DTGA); ga.wa2 = ka[I_WA2]; ga.ba = ka[I_GBA]; ga.norm_g = ka[I_GLANG]; ga.btab = out  ; ga.states = WSP(bf16, WS_GSTATE); ga.decay = WSP(float, WS_GDECAY); ga.hin = WSP(bf16, WS_GHIN); ga.mix = WSP(bf16, WS_MIX); ga.layer = l; ga.pad = 0;
          for (int rep = REPS(9) - 1; rep >= 0; --rep)
          { volatile LAS unsigned* qw = (volatile LAS unsigned*)(ldsp + MISC_OFF) + 12;
            for (;;) { if (tid == 0) qw[0] = atomicAdd(WSP(unsigned, WS_CTL) + CW_QPRE + 16 + 64 * l + 1024 * rep, 1u);
                lds_barrier(); const int u = (int)qw[0]; lds_barrier(); if (u >= 1152) break; glac::pre_unit(ga, u >> 2, u & 3, ldsp + RING_OFF, tid); } } }
        GRID_BAR();
        for (int rep = (int)__builtin_amdgcn_readfirstlane(probe_scan) - 1; rep >= 0; --rep) {
        { PHASE_ENTER();
          ssdc::ScanArgs sc; sc.states = WSP(bf16, WS_SSTATE); sc.decay = WSP(float, WS_SDECAY); sc.state_in = ka[I_STSSD]; sc.hin = WSP(bf16, WS_HIN); sc.out = out; sc.layer = l; sc.pad = 0;
          glac::ScanArgs gc; gc.states = WSP(bf16, WS_GSTATE); gc.decay = WSP(float, WS_GDECAY); gc.state_in = ka[I_STGLA]; gc.hin = WSP(bf16, WS_GHIN); gc.out = out; gc.layer = l; gc.pad = 0;
          volatile LAS unsigned* qw = (volatile LAS unsigned*)(ldsp + MISC_OFF) + 12;
          for (;;) {
              if (tid == 0) qw[0] = atomicAdd(WSP(unsigned, WS_CTL) + CW_QSCAN + 64 * l + 32 * rep, 1u);
              lds_barrier(); const int it = (int)qw[0]; lds_barrier();
              if (it >= 160) break;
              if (it < 64) ssdc::scan_prompt(sc, it * 512 + tid);
              else if (it < 80) glac::scan_prompt(gc, (it - 64) * 512 + tid);
              else if (it < 144) { for (int b = 0; b < DB; b += 8) ssdc::scan_sample8(sc, b, (it - 80) * 512 + tid); }
              else { for (int b = 0; b < DB; b += 8) glac::scan_sample8(gc, b, (it - 144) * 512 + tid); } } }
        if (rep > 0) GRID_BAR(); }
        for (;;) { int conv_item = -1;
        { PHASE_ENTER();
          att::Tensors T; T.QN = WSP(bf16, WS_QN); T.MIX = WSP(bf16, WS_MIX); T.out_g = ka[I_DOUTG] + l * 128; T.lam = (WSP(float, WS_CTL) + CW_LAM)[l]; T.lam_init_c = 1.f - (0.8f - 0.6f * expf(-0.3f * (float)l));
          T.part = WSP(float, WS_APART); T.segcnt = WSP(unsigned, WS_CTL) + CW_SEG + 16384 * l; T.bound = sqrtf((WSP(float, WS_CTL) + CW_QMAX)[64 * l] * (WSP(float, WS_CTL) + CW_KMAX)[64 * l]) * 1.01f + 0.01f; T.kmax = sqrtf((WSP(float, WS_CTL) + CW_KMAX)[64 * l]);
          volatile LAS unsigned* qw = (volatile LAS unsigned*)(ldsp + MISC_OFF) + 12;
          for (;;) {
              if (tid == 0) qw[0] = atomicAdd(WSP(unsigned, WS_CTL) + CW_QATT + 64 * l, 1u);
              lds_barrier(); int it = (int)qw[0]; lds_barrier();
              if (it >= ATT_NITEMS + (l == 0 ? NCONV : 0)) break;
              if (l == 0) { if (it < 5 * NCONV) { if (it % 5 == 4) { conv_item = it / 5; break; } it -= it / 5; } else it -= NCONV; }
              const unsigned w = att_items[it]; const int jb = (w >> 3) & 255;
              att::Unit u; u.h = (w >> 1) & 3; u.nseg = 1 + ((w >> 11) & 1); u.seg = (w >> 12) & 1; u.pidx = (w >> 13) & 255; u.pad = 0;
              if (w & 1) { u.K = WSP(bf16, WS_KC) + (size_t)jb * (PAST + DS) * 512; u.V = WSP(bf16, WS_VC) + (size_t)jb * (PAST + DS) * 512; u.qrow0 = SEQ + DS * jb; u.chunkA = PAST / 64; u.chunkB = -1; }
              else { u.K = WSP(bf16, WS_KP); u.V = WSP(bf16, WS_VP); u.qrow0 = 128 * jb; u.chunkA = 2 * jb; u.chunkB = 2 * jb + 1; }
              att::attn_unit(u, T, ldsp + RING_OFF, tid); } }
        if (conv_item < 0) break;
        { PHASE_ENTER();
          const int cg = conv_item * NWAVES + wave, cn = NCONV * NWAVES; LAS float* scr = (LAS float*)(ldsp + RING_OFF + wave * 16384);
          transpose_w4(ka[I_WOUT], nullptr, DM, DM, WSP(bf16, WS_WOUT), DM, 0, scr, cg, cn, lane);
          transpose_w4(ka[I_W1], ka[I_N2G], DM, DFF, WSP(bf16, WS_W1), DFF, 0, scr, cg, cn, lane);
          transpose_w4(ka[I_W2], nullptr, DFF, DM, WSP(bf16, WS_W2), DM, 0, scr, cg, cn, lane);
          transpose_w4(ka[I_WIN] + (size_t)DM * IN_COLS, ka[I_N1G] + DM, DM, IN_COLS, WSP(bf16, WS_WIN) + (size_t)NPAD * DM, NPAD, 1, scr, cg, cn, lane);
          transpose_w4(ka[I_WOUT] + (size_t)DM * DM, nullptr, DM, DM, WSP(bf16, WS_WOUT) + (size_t)DM * DM, DM, 0, scr, cg, cn, lane);
          transpose_w4(ka[I_W1] + (size_t)DM * DFF, ka[I_N2G] + DM, DM, DFF, WSP(bf16, WS_W1) + (size_t)DFF * DM, DFF, 0, scr, cg, cn, lane);
          transpose_w4(ka[I_W2] + (size_t)DFF * DM, nullptr, DFF, DM, WSP(bf16, WS_W2) + (size_t)DM * DFF, DM, 0, scr, cg, cn, lane);
          __syncthreads(); } }
        GRID_BAR();
        { PHASE_ENTER();
          ssdc::Args sa; sa.proj = WSP(bf16, WS_PROJ); sa.dtga = WSP(float, WS_DTGA); sa.dt_bias = ka[I_DTB]; sa.conv_state = ka[I_STCONV]; sa.conv_w = ka[I_CONVW]; sa.conv_b = ka[I_CONVB]; sa.a_log = ka[I_ALOG]; sa.dpar = ka[I_SSDD];
          sa.norm_g = ka[I_SSDNG]; sa.states = WSP(bf16, WS_SSTATE); sa.decay = WSP(float, WS_SDECAY); sa.hin = WSP(bf16, WS_HIN); sa.mix = WSP(bf16, WS_MIX); sa.layer = l; sa.pad = 0;
          for (int rep = REPS(10) - 1; rep >= 0; --rep)
          { volatile LAS unsigned* qw = (volatile LAS unsigned*)(ldsp + MISC_OFF) + 12;
            for (;;) { if (tid == 0) qw[0] = atomicAdd(WSP(unsigned, WS_CTL) + CW_QPRE + 32 + 64 * l + 1024 * rep, 1u);
                lds_barrier(); const int u = (int)qw[0]; lds_barrier(); if (u >= 576) break; ssdc::post_unit(sa, u >> 1, u & 1, ldsp + RING_OFF, tid); } } }
        { PHASE_ENTER();
          glac::Args ga; ga.proj = WSP(bf16, WS_PROJ); ga.dtga = WSP(float, WS_DTGA); ga.wa2 = ka[I_WA2]; ga.ba = ka[I_GBA]; ga.norm_g = ka[I_GLANG]; ga.btab = out  ; ga.states = WSP(bf16, WS_GSTATE); ga.decay = WSP(float, WS_GDECAY); ga.hin = WSP(bf16, WS_GHIN); ga.mix = WSP(bf16, WS_MIX); ga.layer = l; ga.pad = 0;
          for (int rep = REPS(11) - 1; rep >= 0; --rep)
          { volatile LAS unsigned* qw = (volatile LAS unsigned*)(ldsp + MISC_OFF) + 12;
            for (;;) { if (tid == 0) qw[0] = atomicAdd(WSP(unsigned, WS_CTL) + CW_QPRE + 48 + 64 * l + 1024 * rep, 1u);
                lds_barrier(); const int u = (int)qw[0]; lds_barrier(); if (u >= 1152) break; glac::post_unit(ga, u >> 2, u & 3, ldsp + RING_OFF, tid); } } }
        GRID_BAR();
        for (int rep = REPS(2) - 1; rep >= 0; --rep) {
        { PHASE_ENTER();
          pg8::Gemm g{WSP(bf16, WS_MIX), WSP(bf16, WS_WOUT) + (size_t)l * DM * DM, NROW, DM, DM}; pg8::StaticOrder S; S.init(NROW, DM, G, bx, DM, (float*)(ws + 623 * MiB)  , WSP(unsigned, WS_CTL) + CW_GSL + (4 * l + 1) * 8192 + (rep > 0 ? 65536 : 0));
          pg8::EpiResid E{ka[I_XP], ka[I_XS], l == 0 ? nullptr : WSP(bf16, WS_H), nullptr, rep > 0 ? (bf16*)(ws + 623 * MiB) : WSP(bf16, WS_H), WSP(float, WS_SUMSQ) + (size_t)(2 * l + 1) * NROW, nullptr};
          pg8::gemm_phase<pg8::EpiResid, pg8::StaticOrder, true, true>(ldsp + RING_OFF, g, S, E, tid);
          if (l + 1 < DEPTH && rep == 0) cache_convert_queue(ka[I_CK], ka[I_CV], WSP(bf16, WS_KC), WSP(bf16, WS_VC), l + 1, WSP(unsigned, WS_CTL) + CW_QCONV + 16 * (l + 1), WSP(unsigned, WS_CTL) + CW_KMAX + 64 * (l + 1),
                                                              (volatile LAS unsigned*)(ldsp + MISC_OFF) + 12, tid, lane, 0u, 256u); }
                if (rep > 0) GRID_BAR(); }
        GRID_BAR();
        for (int rep = REPS(4) - 1; rep >= 0; --rep) {
        { PHASE_ENTER();
          pg8::Gemm g{WSP(bf16, WS_H), WSP(bf16, WS_W1) + (size_t)l * DFF * DM, NROW, DFF, DM}; pg8::StaticOrder S; S.init(NROW, DFF, G, bx, DM); S.wgm = WGM_M1;
          pg8::EpiRelu2 E{WSP(bf16, WS_HID), (long)DFF};
          pg8::gemm_phase<pg8::EpiRelu2, pg8::StaticOrder, true, true>(ldsp + RING_OFF, g, S, E, tid); }
                if (rep > 0) GRID_BAR(); }
        GRID_BAR();
        for (int rep = REPS(5) - 1; rep >= 0; --rep) {
        { PHASE_ENTER();
          pg8::Gemm g{WSP(bf16, WS_HID), WSP(bf16, WS_W2) + (size_t)l * DM * DFF, NROW, DM, DFF}; pg8::StaticOrder S; S.init(NROW, DM, G, bx, DFF, (float*)(ws + 623 * MiB)  , WSP(unsigned, WS_CTL) + CW_GSL + (4 * l + 3) * 8192 + (rep > 0 ? 65536 : 0));
          pg8::EpiResid E{nullptr, nullptr, WSP(bf16, WS_H), l + 1 == DEPTH ? out : nullptr, l + 1 == DEPTH ? nullptr : (rep > 0 ? WSP(bf16, WS_MIX) : WSP(bf16, WS_H)), WSP(float, WS_SUMSQ) + (size_t)(2 * l + 2) * NROW, WSP(float, WS_SUMSQ) + (size_t)(2 * l + 1) * NROW};
          pg8::gemm_phase<pg8::EpiResid, pg8::StaticOrder, true, true>(ldsp + RING_OFF, g, S, E, tid); }
        if (rep > 0) GRID_BAR(); }
        if (l + 1 < DEPTH) GRID_BAR();
    }
}

extern "C" void kernel_launch(void* const* d_in, const int* in_sizes, int n_in, void* d_out, int out_size, void* d_ws, size_t ws_size, hipStream_t stream) {
    static int grid = 0;
    if (grid == 0) {
        if (n_in != 26 || out_size != (int)O_END || ws_size < WS_END) { fprintf(stderr, "kernel_launch: unexpected shapes (n_in %d out %d ws %zu)\n", n_in, out_size, ws_size); grid = -1; return; }
        int dev = 0, cus = 0, per_cu = 0;
        if (hipGetDevice(&dev) != hipSuccess || hipDeviceGetAttribute(&cus, hipDeviceAttributeMultiprocessorCount, dev) != hipSuccess) { grid = -1; return; }
        if (hipFuncSetAttribute((const void*)fwd_kernel, hipFuncAttributeMaxDynamicSharedMemorySize, LDS_BYTES) != hipSuccess) { fprintf(stderr, "kernel_launch: hipFuncSetAttribute failed\n"); grid = -1; return; }
        if (hipOccupancyMaxActiveBlocksPerMultiprocessor(&per_cu, (const void*)fwd_kernel, NWAVES * 64, LDS_BYTES) != hipSuccess || per_cu < 1) fprintf(stderr, "kernel_launch: occupancy query says %d\n", per_cu);
        (void)hipGetLastError();
        grid = cus;
    }
    if (grid < 0) return;
    (void)hipMemsetAsync((char*)d_ws + WS_CTL, 0, 1 * MiB, stream);
    Params p{};
    for (int i = 0; i < 26; ++i) p.in[i] = (const float*)d_in[i];
    p.out = (float*)d_out; p.ws = (unsigned char*)d_ws;
    hipLaunchKernelGGL(fwd_kernel, dim3(grid), dim3(NWAVES * 64), LDS_BYTES, stream, p);
}
```

```cpp
#include <hip/hip_runtime.h>
#include <cstdio>
#include <cstdint>
namespace pg8 {
#define PG8_LAS __attribute__((address_space(3)))
typedef unsigned short bf16_t;
typedef short bf16x8 __attribute__((ext_vector_type(8)));
typedef float f32x4 __attribute__((ext_vector_type(4)));
typedef unsigned u32x4 __attribute__((ext_vector_type(4)));
constexpr int BM = 256, BK = 64, HALF = 128, HTB = HALF * BK * 2  , STAGE_BYTES = 8 * HTB, NXCD = 8, WGM = 8;

__host__ __device__ __forceinline__ int lds_byte(int r, int c) { const int st = (r >> 4) * 2 + (c >> 5), rr = r & 15, cc = c & 31, ob = rr * 64 + cc * 2; return st * 1024 + (ob ^ (((ob >> 9) & 1) << 5)); }
__host__ __device__ __forceinline__ void stage_rc(int b, int& R, int& C) { const int st = b / 1024, sb = b % 1024, swz = sb ^ (((sb >> 9) & 1) << 5); R = (st >> 1) * 16 + swz / 64; C = (st & 1) * 32 + (swz % 64) / 2; }
__host__ __device__ __forceinline__ int perm32(int rho) { const int n = rho >> 4, i = rho & 15; return 8 * (i >> 2) + 4 * n + (i & 3); }

struct Unit { int pm, pn, k0, nt, ns, sl, ti; };
struct Gemm { const bf16_t* A; const bf16_t* Bt; int M, N, K; };

struct StaticOrder {
    int nM, nN, nwg, G, c, K, R, T, Sn, wgm; float* slabs; unsigned* cnt;
    __host__ __device__ __forceinline__ void init(int M, int N, int G_, int c_, int K_ = 0, float* slabs_ = nullptr, unsigned* cnt_ = nullptr) { nM = M / BM; nN = N / BM; nwg = nM * nN; G = G_; c = c_; K = K_; slabs = slabs_; cnt = cnt_;
        R = nwg / G; T = nwg - R * G; Sn = 1; wgm = 4;
        if (T > 0 && slabs_) { Sn = G / T; while (Sn > 1 && ((K / Sn) % 128 != 0 || K / Sn < 256)) --Sn; }
        if (!slabs_ || Sn <= 1) { Sn = 1; } }
    __host__ __device__ __forceinline__ void tile(int L, Unit& u) const {
        int wgid = L; { const int q = nwg / NXCD, r = nwg % NXCD, xcd = wgid % NXCD, off = wgid / NXCD; wgid = (xcd < r ? xcd * (q + 1) : r * (q + 1) + (xcd - r) * q) + off; }
        const int nig = wgm * nN, gid = wgid / nig, fm = gid * wgm, gsz = (nM - fm) < wgm ? (nM - fm) : wgm;
        u.pm = fm + ((wgid % nig) % gsz); u.pn = (wgid % nig) / gsz; }
    __host__ __device__ __forceinline__ bool next(int i, Unit& u) const {
        u.k0 = 0; u.nt = K / BK; u.ns = 1; u.sl = 0; u.ti = 0;
        if (Sn > 1 && i >= R) { if (i > R || c >= T * Sn) return false; u.ti = c % T; u.sl = c / T; u.ns = Sn; u.nt = K / BK / Sn; u.k0 = u.sl * (K / Sn); tile(R * G + u.ti, u); return true; }
        const long L = (long)i * G + c; if (L >= nwg) return false;
        tile((int)L, u); return true;
    }
    __device__ __forceinline__ void a_ready(const Unit&) const {}
    __device__ __forceinline__ void done(const Unit&) const {}
};

__device__ __forceinline__ unsigned cvt_pk_bf16(float lo, float hi) { unsigned r; asm volatile("v_cvt_pk_bf16_f32 %0, %1, %2" : "=v"(r) : "v"(lo), "v"(hi)); return r; }
typedef float f32x2 __attribute__((ext_vector_type(2)));
template <class Epi, class Sched, bool ALIGN_EPI = false, bool SP2 = false>
__device__ __forceinline__ void gemm_phase(PG8_LAS unsigned char* lds, const Gemm g, const Sched& S, const Epi& E, int tid_in) {
    int tid_ = tid_in; asm volatile("" : "+v"(tid_));
    const int tid = tid_, wid = __builtin_amdgcn_readfirstlane(tid >> 6), lane = tid & 63, wr = wid >> 2, wc = wid & 3, fr = lane & 15, fq = lane >> 4;
    const int K = g.K;
    unsigned voffA[2], voffB[2];
#pragma unroll
    for (int i = 0; i < 2; ++i) { int R, C; stage_rc(tid * 16 + i * 8192, R, C); const int Rb = Epi::PERM ? ((R & ~31) + perm32(R & 31)) : R;
        voffA[i] = (unsigned)(R * K + C) * 2u; voffB[i] = (unsigned)(Rb * K + C) * 2u; }
    const size_t kstep = (size_t)(BK * 2);
    const size_t hstep = (size_t)HALF * K * 2;
    const size_t tstep = 2 * hstep;
    const unsigned ldsw = (unsigned)wid * 1024u;
    const int aoff = lds_byte(wr * 64 + fr, fq * 8), boff = lds_byte(wc * 32 + fr, fq * 8);
#define PG8_SA(b, h) (((b) * 2 + (h)) * HTB)
#define PG8_SB(b, h) ((4 + (b) * 2 + (h)) * HTB)
#define PG8_STAGE(bufoff, gbase, voff) do { _Pragma("unroll") for (int _i = 0; _i < 2; ++_i) \
        __builtin_amdgcn_global_load_lds((const unsigned*)((const char*)(gbase) + (voff)[_i]), (PG8_LAS unsigned*)(lds + (bufoff) + ldsw + _i * 8192), 16, 0, 0); } while (0)
#define PG8_LDA(dst, b, h) do { _Pragma("unroll") for (int m = 0; m < 4; ++m) _Pragma("unroll") for (int k = 0; k < 2; ++k) dst[m][k] = *(const PG8_LAS bf16x8*)(lds + PG8_SA(b, h) + aoff + m * 2048 + k * 1024); } while (0)
#define PG8_LDB(dst, b, h) do { _Pragma("unroll") for (int n = 0; n < 2; ++n) _Pragma("unroll") for (int k = 0; k < 2; ++k) dst[n][k] = *(const PG8_LAS bf16x8*)(lds + PG8_SB(b, h) + boff + n * 2048 + k * 1024); } while (0)
#define PG8_MMA(ai, bj, At, Bt) do { __builtin_amdgcn_s_setprio(1); _Pragma("unroll") for (int m = 0; m < 4; ++m) _Pragma("unroll") for (int n = 0; n < 2; ++n) _Pragma("unroll") for (int k = 0; k < 2; ++k) \
        acc[ai][bj][m][n] = __builtin_amdgcn_mfma_f32_16x16x32_bf16(Bt[n][k], At[m][k], acc[ai][bj][m][n], 0, 0, 0); __builtin_amdgcn_s_setprio(0); } while (0)
#define PG8_WAIT_V(n) asm volatile("s_waitcnt vmcnt(" #n ")" ::: "memory")
#define PG8_WAIT_L(n) asm volatile("s_waitcnt lgkmcnt(" #n ")" ::: "memory")
#define PG8_BAR __builtin_amdgcn_s_barrier()
#define PG8_SCHED __builtin_amdgcn_sched_barrier(0)
    Unit cur, nxt; int ui = 0;
    if (!S.next(0, cur)) return;
    f32x4 acc[2][2][4][2];
#pragma unroll
    for (int a = 0; a < 2; ++a)
#pragma unroll
        for (int b = 0; b < 2; ++b)
#pragma unroll
            for (int m = 0; m < 4; ++m)
#pragma unroll
                for (int n = 0; n < 2; ++n) acc[a][b][m][n] = (f32x4){0.f, 0.f, 0.f, 0.f};
    bf16x8 At[4][2], B0[2][2], B1[2][2];
    const char* cA = (const char*)g.A + (size_t)cur.pm * tstep + (size_t)cur.k0 * 2; const char* cB = (const char*)g.Bt + (size_t)cur.pn * tstep + (size_t)cur.k0 * 2;
    S.a_ready(cur);
    if constexpr (SP2) {
        PG8_STAGE(PG8_SB(0, 0), cB, voffB); PG8_STAGE(PG8_SB(0, 1), cB + hstep, voffB); PG8_STAGE(PG8_SA(0, 0), cA, voffA); PG8_STAGE(PG8_SA(0, 1), cA + hstep, voffA);
        if (wr == 1) PG8_BAR;
        PG8_WAIT_V(2); PG8_BAR;
        PG8_STAGE(PG8_SB(1, 0), cB + kstep, voffB); PG8_STAGE(PG8_SA(1, 0), cA + kstep, voffA); PG8_STAGE(PG8_SB(1, 1), cB + hstep + kstep, voffB);
        PG8_WAIT_V(6); PG8_BAR;
    } else {
        PG8_STAGE(PG8_SB(0, 0), cB, voffB); PG8_STAGE(PG8_SA(0, 0), cA, voffA); PG8_STAGE(PG8_SB(0, 1), cB + hstep, voffB); PG8_STAGE(PG8_SA(0, 1), cA + hstep, voffA);
        if (wr == 1) PG8_BAR;
        PG8_WAIT_V(4); PG8_BAR;
        PG8_STAGE(PG8_SB(1, 0), cB + kstep, voffB); PG8_STAGE(PG8_SA(1, 0), cA + kstep, voffA); PG8_STAGE(PG8_SB(1, 1), cB + hstep + kstep, voffB);
        PG8_WAIT_V(6); PG8_BAR;
    }
    for (;;) {
        const bool has_next = S.next(ui + 1, nxt);
        const char* nA = has_next ? (const char*)g.A + (size_t)nxt.pm * tstep + (size_t)nxt.k0 * 2 : cA; const char* nB = has_next ? (const char*)g.Bt + (size_t)nxt.pn * tstep + (size_t)nxt.k0 * 2 : cB;
        const int nt = cur.nt;
        for (int t = 0; t < nt; t += 2) {
            const bool last = (t == nt - 2);
            const char* a1 = cA + (size_t)(t + 1) * kstep;
            const char* a2 = last ? nA : cA + (size_t)(t + 2) * kstep; const char* b2 = last ? nB : cB + (size_t)(t + 2) * kstep;
            const char* a3 = a2 + kstep; const char* b3 = b2 + kstep;
            if (last && has_next) S.a_ready(nxt);
            if constexpr (SP2) {
            PG8_LDB(B0, 0, 0); PG8_LDB(B1, 0, 1); PG8_SCHED; PG8_LDA(At, 0, 0); PG8_STAGE(PG8_SA(1, 1), a1 + hstep, voffA);
            PG8_WAIT_V(8); PG8_WAIT_L(0); PG8_BAR; PG8_MMA(0, 0, At, B0); PG8_MMA(0, 1, At, B1); PG8_BAR; PG8_SCHED;
            PG8_LDA(At, 0, 1); PG8_STAGE(PG8_SB(0, 0), b2, voffB); PG8_STAGE(PG8_SB(0, 1), b2 + hstep, voffB); PG8_STAGE(PG8_SA(0, 0), a2, voffA);
            PG8_WAIT_V(8); PG8_WAIT_L(0); PG8_BAR; PG8_MMA(1, 0, At, B0); PG8_MMA(1, 1, At, B1); PG8_BAR; PG8_SCHED;
            PG8_LDB(B0, 1, 0); PG8_LDB(B1, 1, 1); PG8_SCHED; PG8_LDA(At, 1, 0); PG8_STAGE(PG8_SA(0, 1), a2 + hstep, voffA);
            PG8_WAIT_V(8); PG8_WAIT_L(0); PG8_BAR; PG8_MMA(0, 0, At, B0); PG8_MMA(0, 1, At, B1); PG8_BAR; PG8_SCHED;
            PG8_LDA(At, 1, 1); PG8_STAGE(PG8_SB(1, 0), b3, voffB); PG8_STAGE(PG8_SB(1, 1), b3 + hstep, voffB); PG8_STAGE(PG8_SA(1, 0), a3, voffA);
            PG8_WAIT_V(8); PG8_WAIT_L(0); PG8_BAR; PG8_MMA(1, 0, At, B0); PG8_MMA(1, 1, At, B1); PG8_BAR; PG8_SCHED;
            } else {
            PG8_LDB(B0, 0, 0); PG8_SCHED; PG8_LDA(At, 0, 0); PG8_STAGE(PG8_SA(1, 1), a1 + hstep, voffA);
            PG8_WAIT_L(8); PG8_BAR; PG8_WAIT_L(0); PG8_MMA(0, 0, At, B0); PG8_BAR; PG8_SCHED;
            PG8_LDB(B1, 0, 1); PG8_STAGE(PG8_SB(0, 0), b2, voffB);
            PG8_BAR; PG8_WAIT_L(0); PG8_MMA(0, 1, At, B1); PG8_BAR;
            PG8_LDA(At, 0, 1); PG8_STAGE(PG8_SA(0, 0), a2, voffA);
            PG8_BAR; PG8_WAIT_L(0); PG8_MMA(1, 0, At, B0); PG8_BAR; PG8_SCHED;
            PG8_STAGE(PG8_SB(0, 1), b2 + hstep, voffB);
            PG8_WAIT_V(6); PG8_BAR; PG8_MMA(1, 1, At, B1); PG8_BAR;
            PG8_LDB(B0, 1, 0); PG8_SCHED; PG8_LDA(At, 1, 0); PG8_STAGE(PG8_SA(0, 1), a2 + hstep, voffA);
            PG8_WAIT_L(8); PG8_BAR; PG8_WAIT_L(0); PG8_MMA(0, 0, At, B0); PG8_BAR; PG8_SCHED;
            PG8_LDB(B1, 1, 1); PG8_STAGE(PG8_SB(1, 0), b3, voffB);
            PG8_BAR; PG8_WAIT_L(0); PG8_MMA(0, 1, At, B1); PG8_BAR;
            PG8_LDA(At, 1, 1); PG8_STAGE(PG8_SA(1, 0), a3, voffA);
            PG8_BAR; PG8_WAIT_L(0); PG8_MMA(1, 0, At, B0); PG8_BAR; PG8_SCHED;
            PG8_STAGE(PG8_SB(1, 1), b3 + hstep, voffB);
            PG8_WAIT_V(6); PG8_BAR; PG8_MMA(1, 1, At, B1); PG8_BAR;
            }
        }
        if constexpr (ALIGN_EPI) { if (wr == 0) PG8_BAR; }
        if constexpr (!Epi::AFTER_DRAIN) { if (cur.ns == 1) { E(acc, cur, wr, wc, fr, fq); S.done(cur); } }
        if (!has_next) break;
#pragma unroll
        for (int a = 0; a < 2; ++a)
#pragma unroll
            for (int b = 0; b < 2; ++b)
#pragma unroll
                for (int m = 0; m < 4; ++m)
#pragma unroll
                    for (int n = 0; n < 2; ++n) acc[a][b][m][n] = (f32x4){0.f, 0.f, 0.f, 0.f};
        cur = nxt; cA = nA; cB = nB; ++ui;
        if constexpr (ALIGN_EPI) { if (wr == 1) PG8_BAR; }
    }
    PG8_WAIT_V(0);
    if constexpr (!ALIGN_EPI) { if (wr == 0) PG8_BAR; }
    PG8_BAR;
    if constexpr (Epi::AFTER_DRAIN) { E.fused(acc, cur, wr, wc, fr, fq, lds, wid, lane); S.done(cur); }
    else if (cur.ns > 1) {
        float* slab = S.slabs + ((size_t)cur.ti * cur.ns + cur.sl) * (BM * BM);
        { const __amdgpu_buffer_rsrc_t rsrc = __builtin_amdgcn_make_buffer_rsrc(slab, 0, BM * BM * 4, 0x00020000);
#pragma unroll
          for (int a = 0; a < 2; ++a)
#pragma unroll
              for (int b = 0; b < 2; ++b)
#pragma unroll
                  for (int m = 0; m < 4; ++m)
#pragma unroll
                      for (int n = 0; n < 2; ++n) __builtin_amdgcn_raw_buffer_store_b128(__builtin_bit_cast(u32x4, acc[a][b][m][n]), rsrc, ((((a * 2 + b) * 4 + m) * 2 + n) * 512 + tid) * 16, 0, 16); }
        asm volatile("s_waitcnt vmcnt(0)" ::: "memory"); __syncthreads();
        volatile PG8_LAS unsigned* flag = (volatile PG8_LAS unsigned*)lds;
        if (tid == 0) { flag[0] = __hip_atomic_fetch_add(S.cnt + 64 * cur.ti, 1u, __ATOMIC_RELAXED, __HIP_MEMORY_SCOPE_AGENT); }
        __syncthreads();
        const bool lastarr = flag[0] == (unsigned)(cur.ns - 1);
        if (lastarr) {
            if (tid == 0) { __builtin_amdgcn_fence(__ATOMIC_ACQUIRE, "agent"); asm volatile("s_waitcnt vmcnt(0)" ::: "memory"); }
            __syncthreads();
            for (int s2 = 0; s2 < cur.ns; ++s2) if (s2 != cur.sl) { const float* os = S.slabs + ((size_t)cur.ti * cur.ns + s2) * (BM * BM);
#pragma unroll
                for (int ab = 0; ab < 4; ++ab) { f32x4 t[4][2];
#pragma unroll
                    for (int m = 0; m < 4; ++m)
#pragma unroll
                        for (int n = 0; n < 2; ++n) t[m][n] = *(const f32x4*)(os + (unsigned)((((ab * 4 + m) * 2 + n) * 512 + tid) * 4));
                    __builtin_amdgcn_sched_barrier(0);
#pragma unroll
                    for (int m = 0; m < 4; ++m)
#pragma unroll
                        for (int n = 0; n < 2; ++n) acc[ab >> 1][ab & 1][m][n] += t[m][n];
                    __builtin_amdgcn_sched_barrier(0); } }
            E(acc, cur, wr, wc, fr, fq); S.done(cur);
        }
        __syncthreads();
    }
#undef PG8_SA
#undef PG8_SB
#undef PG8_STAGE
#undef PG8_LDA
#undef PG8_LDB
#undef PG8_MMA
#undef PG8_WAIT_V
#undef PG8_WAIT_L
#undef PG8_BAR
#undef PG8_SCHED
}
}
constexpr int DM = 2048, SEQ = 16384, DEPTH = 2, DB = 32, DS = 64, PAST = 2048;
constexpr int NROW = SEQ + DB * DS;
constexpr int SSD_H = 16, SSD_P = 64, SSD_N = 128, CONV_DIM = 1536;
constexpr int NPJ = 5632, NPAD = 5888, DFF = 8192, IN_COLS = 5664;
constexpr float EPS = 1e-6f;
constexpr int C_Z = 0, C_XBC = 1024, C_DQ = 2560, C_DK = 3072, C_DV = 3584, C_GQ = 4096, C_GK = 4352, C_GV = 4608, C_GG = 5120;
constexpr size_t O_Y = 0, O_KP = 37748736, O_VP = 54525952, O_CP = 71303168, O_HP = 71312384, O_SP = 71574528, O_KS = 71640064, O_VS = 73737216,
                 O_CS = 75834368, O_HS = 76129280, O_SS = 84517888, O_END = 86615040;
constexpr size_t MiB = 1u << 20;
constexpr size_t WS_CTL = 0, WS_WIN = 1 * MiB, WS_WOUT = 47 * MiB, WS_W1 = 63 * MiB, WS_W2 = 127 * MiB, WS_H = 191 * MiB, WS_MIX = 263 * MiB,
                 WS_PROJ = 335 * MiB, WS_HID = 335 * MiB  , WS_SSTATE = 533 * MiB, WS_HIN = 677 * MiB, WS_KP = 749 * MiB, WS_VP = 765 * MiB,
                 WS_QN = 785 * MiB, WS_GSTATE = 821 * MiB, WS_DTGA = 857 * MiB, WS_SDECAY = 860 * MiB, WS_KC = 861 * MiB, WS_VC = 927 * MiB, WS_GHIN = 993 * MiB, WS_GDECAY = 1011 * MiB, WS_APART = 1012 * MiB, WS_SUMSQ = 1054 * MiB, WS_END = 1056 * MiB;
typedef unsigned short bf16;
typedef float f32x4 __attribute__((ext_vector_type(4)));
typedef unsigned u32x4 __attribute__((ext_vector_type(4)));
typedef unsigned u32x2 __attribute__((ext_vector_type(2)));
__device__ __forceinline__ unsigned f2bf(float f) { unsigned u = __builtin_bit_cast(unsigned, f); return (u + 0x7fffu + ((u >> 16) & 1u)) >> 16; }
__device__ __forceinline__ unsigned pk2(float lo, float hi) { return f2bf(lo) | (f2bf(hi) << 16); }
__device__ __forceinline__ float bf2f(bf16 b) { return __builtin_bit_cast(float, (unsigned)b << 16); }
__device__ __forceinline__ float silu_f(float x) { return x * __builtin_amdgcn_rcpf(1.f + __expf(-x)); }
__device__ __forceinline__ float softplus_f(float x) { return x > 15.f ? x : __logf(1.f + __expf(x)); }
__device__ __forceinline__ float logsigmoid_f(float x) { return fminf(x, 0.f) - __logf(1.f + __expf(-fabsf(x))); }

#define GAS __attribute__((address_space(1)))
#define LAS __attribute__((address_space(3)))
typedef GAS unsigned gu32;
#define RLX_AGENT __ATOMIC_RELAXED, __HIP_MEMORY_SCOPE_AGENT
__device__ __forceinline__ int opaque_s(int x) { asm volatile("" : "+s"(x)); return x; }
__device__ __forceinline__ int opaque_v(int x) { asm volatile("" : "+v"(x)); return x; }
__device__ __forceinline__ float swz_xor16(float v) { return __builtin_bit_cast(float, __builtin_amdgcn_ds_swizzle(__builtin_bit_cast(int, v), 0x401F)); }
__device__ __forceinline__ float swz_xor8(float v)  { return __builtin_bit_cast(float, __builtin_amdgcn_ds_swizzle(__builtin_bit_cast(int, v), 0x201F)); }
__device__ __forceinline__ float swz_xor4(float v)  { return __builtin_bit_cast(float, __builtin_amdgcn_ds_swizzle(__builtin_bit_cast(int, v), 0x101F)); }
__device__ __forceinline__ float dpp_xor2(float v)  { return __builtin_bit_cast(float, __builtin_amdgcn_mov_dpp(__builtin_bit_cast(int, v), 0x4E, 0xf, 0xf, true)); }
__device__ __forceinline__ float dpp_xor1(float v)  { return __builtin_bit_cast(float, __builtin_amdgcn_mov_dpp(__builtin_bit_cast(int, v), 0xB1, 0xf, 0xf, true)); }
__device__ __forceinline__ float half_sum(float v) {
    v += dpp_xor1(v); v += dpp_xor2(v); v += swz_xor4(v); v += swz_xor8(v); v += swz_xor16(v); return v; }
__device__ __forceinline__ float wave_sum(float v) {
    v = half_sum(v); auto rr = __builtin_amdgcn_permlane32_swap(__float_as_uint(v), __float_as_uint(v), false, false); return __uint_as_float(rr[0]) + __uint_as_float(rr[1]); }
__device__ __forceinline__ int lane_id() { int l; asm volatile("v_mbcnt_lo_u32_b32 %0, -1, 0\n\tv_mbcnt_hi_u32_b32 %0, -1, %0" : "=v"(l)); return l; }
__device__ __forceinline__ float half_max(float v) {
    v = fmaxf(v, dpp_xor1(v)); v = fmaxf(v, dpp_xor2(v)); v = fmaxf(v, swz_xor4(v)); v = fmaxf(v, swz_xor8(v)); v = fmaxf(v, swz_xor16(v)); return v; }
__device__ __forceinline__ float wave_max(float v) {
    v = half_max(v); auto rr = __builtin_amdgcn_permlane32_swap(__float_as_uint(v), __float_as_uint(v), false, false); return fmaxf(__uint_as_float(rr[0]), __uint_as_float(rr[1])); }
__device__ __forceinline__ float rbf(float x) { return __builtin_bit_cast(float, ((__builtin_bit_cast(unsigned, x) + 0x7fffu + ((__builtin_bit_cast(unsigned, x) >> 16) & 1u)) & 0xffff0000u)); }

__device__ __forceinline__ void lds_barrier() { asm volatile("s_waitcnt lgkmcnt(0)\n\ts_barrier" ::: "memory"); }
#define XB_TMO      128
#define XB_XCNT(j)  (256  + 64 * (j))
#define XB_XSUB(j)  (1280 + 64 * (j))
#define XB_XGEN(j)  (2304 + 64 * (j))
#define XB_TOP      3328
#define XB_TOPGEN   3392
#define XCD_BAR_WORDS 3456
#define XB_SPIN_CAP (1u << 23)

__device__ __forceinline__ unsigned xb_ld(unsigned* p)              { return __hip_atomic_load(p, __ATOMIC_RELAXED, __HIP_MEMORY_SCOPE_AGENT); }
__device__ __forceinline__ unsigned xb_add(unsigned* p, unsigned v) { return __hip_atomic_fetch_add(p, v, __ATOMIC_RELAXED, __HIP_MEMORY_SCOPE_AGENT); }
__device__ __forceinline__ unsigned xb_xcc_id() { return (unsigned)__builtin_amdgcn_s_getreg((3 << 11) | 20) & 0xFu; }
#define XB_SPIN(cond, bar) do { unsigned _sp = 0; while (cond) { __builtin_amdgcn_s_sleep(1); \
    if ((++_sp & 255u) == 0u) { if (xb_ld(&(bar)[XB_TMO])) break; if (_sp > XB_SPIN_CAP) { atomicAdd(&(bar)[XB_TMO], 1u); break; } } } } while (0)

struct XcdBarrier {
    unsigned* bar; unsigned x;
    volatile LAS unsigned* st;
};

__device__ __forceinline__ XcdBarrier xcd_barrier_post(unsigned* bar, volatile LAS unsigned* st) {
    XcdBarrier b; b.bar = bar; b.x = xb_xcc_id(); b.st = st;
    if (threadIdx.x == 0) (void)xb_add(&bar[XB_XCNT(b.x)], 1u);
    return b;
}
__device__ __forceinline__ void xcd_barrier_complete(unsigned* bar, unsigned x, unsigned& nloc, unsigned& nx) {
    const unsigned G = gridDim.x * gridDim.y * gridDim.z;
    unsigned sum, cnt, mine, sp = 0u;
    for (;;) {
        sum = 0u; cnt = 0u; mine = 0u;
#pragma unroll
        for (unsigned j = 0; j < 16; ++j) { const unsigned c = xb_ld(&bar[XB_XCNT(j)]); sum += c; cnt += (c > 0u) ? 1u : 0u; mine = (j == x) ? c : mine; }
        if (sum == G) break;
        __builtin_amdgcn_s_sleep(1);
        if ((++sp & 255u) == 0u) { if (xb_ld(&bar[XB_TMO])) break; if (sp > XB_SPIN_CAP) { atomicAdd(&bar[XB_TMO], 1u); break; } }
    }
    nloc = mine > 0u ? mine : 1u; nx = cnt > 0u ? cnt : 1u;
}

__device__ __forceinline__ void xcd_barrier(const XcdBarrier& b) {
    asm volatile("s_waitcnt vmcnt(0)" ::: "memory");
    __syncthreads();
    if (threadIdx.x == 0) {
        unsigned* bar = b.bar;
        __builtin_amdgcn_s_waitcnt(0);
        unsigned nloc = b.st[0], nx = b.st[1];
        if (nloc == 0u) { xcd_barrier_complete(bar, b.x, nloc, nx); b.st[0] = nloc; b.st[1] = nx; }
        const unsigned old = xb_add(&bar[XB_XSUB(b.x)], 1u);
        const unsigned gen = old / nloc;
        if (old + 1u == (gen + 1u) * nloc) {
            __builtin_amdgcn_fence(__ATOMIC_RELEASE, "agent");
            asm volatile("s_waitcnt vmcnt(0)" ::: "memory");
            const unsigned og = xb_add(&bar[XB_TOP], 1u);
            const unsigned tg = og / nx;
            if (og + 1u == (tg + 1u) * nx) xb_add(&bar[XB_TOPGEN], 1u);
            else XB_SPIN(xb_ld(&bar[XB_TOPGEN]) == tg, bar);
            __builtin_amdgcn_fence(__ATOMIC_ACQUIRE, "agent");
            xb_add(&bar[XB_XGEN(b.x)], 1u);
            asm volatile("s_waitcnt vmcnt(0)" ::: "memory");
        } else {
            XB_SPIN(xb_ld(&bar[XB_XGEN(b.x)]) == gen, bar);
            __builtin_amdgcn_fence(__ATOMIC_ACQUIRE, "agent");
            asm volatile("s_waitcnt vmcnt(0)" ::: "memory");
        }
    }
    __syncthreads();
}
namespace pg8 {
__device__ __forceinline__ float row_rstd(const float* ss, int row) { return __builtin_amdgcn_rsqf(ss[row] * (1.f / DM) + EPS); }
struct EpiInProj {
    static constexpr bool PERM = true, AFTER_DRAIN = false;
    bf16_t* P; float* T; const float* ss;
    __device__ __forceinline__ void operator()(const f32x4 (&acc)[2][2][4][2], const Unit& u, int wr, int wc, int fr, int fq) const {
        const int row0 = u.pm * BM + wr * 64 + fr;
        float rsv[2][4];
#pragma unroll
        for (int ai = 0; ai < 2; ++ai)
#pragma unroll
            for (int m = 0; m < 4; ++m) rsv[ai][m] = ss[row0 + ai * HALF + m * 16];
#pragma unroll
        for (int ai = 0; ai < 2; ++ai)
#pragma unroll
            for (int m = 0; m < 4; ++m) rsv[ai][m] = __builtin_amdgcn_rsqf(rsv[ai][m] * (1.f / DM) + EPS);
        if (u.pn < 22) {
            const int col0 = u.pn * BM + wc * 32 + 8 * fq;
#pragma unroll
            for (int ai = 0; ai < 2; ++ai)
#pragma unroll
                for (int m = 0; m < 4; ++m) { const int row = row0 + ai * HALF + m * 16; bf16_t* rowp = P + (size_t)row * NPJ + col0; const float rs = rsv[ai][m];
#pragma unroll
                    for (int bj = 0; bj < 2; ++bj) { const f32x4 v0 = acc[ai][bj][m][0] * rs, v1 = acc[ai][bj][m][1] * rs;
                        u32x4 w; w.x = cvt_pk_bf16(v0[0], v0[1]); w.y = cvt_pk_bf16(v0[2], v0[3]); w.z = cvt_pk_bf16(v1[0], v1[1]); w.w = cvt_pk_bf16(v1[2], v1[3]);
                        *(u32x4*)(rowp + bj * HALF) = w; } }
        } else if (wc == 0) {
#pragma unroll
            for (int ai = 0; ai < 2; ++ai)
#pragma unroll
                for (int m = 0; m < 4; ++m) { const int row = row0 + ai * HALF + m * 16; float* rp = T + (size_t)row * 32 + 8 * fq; const float rs = rsv[ai][m];
                    *(f32x4*)(rp) = acc[ai][0][m][0] * rs; *(f32x4*)(rp + 4) = acc[ai][0][m][1] * rs; }
        }
    }
};
struct EpiResid {
    static constexpr bool PERM = true, AFTER_DRAIN = false;
    const float* xa; const float* xb; const bf16_t* xin; float* out; bf16_t* xbf; float* ssq; const float* ss2;
    __device__ __forceinline__ void operator()(const f32x4 (&acc)[2][2][4][2], const Unit& u, int wr, int wc, int fr, int fq) const {
        const int col0 = u.pn * BM + wc * 32 + 8 * fq, rbase = u.pm * BM + wr * 64 + fr;
        float r2v[2][4];
#pragma unroll
        for (int ai = 0; ai < 2; ++ai)
#pragma unroll
            for (int m = 0; m < 4; ++m) r2v[ai][m] = ss2 ? ss2[rbase + ai * HALF + m * 16] : 0.f;
        if (xin) {
#pragma unroll
            for (int ai = 0; ai < 2; ++ai) { u32x4 bw[1][4][2];
#pragma unroll
                for (int m = 0; m < 4; ++m)
#pragma unroll
                    for (int bj = 0; bj < 2; ++bj) bw[0][m][bj] = *(const u32x4*)(xin + (size_t)(rbase + ai * HALF + m * 16) * DM + col0 + bj * HALF);
#pragma unroll
                for (int m = 0; m < 4; ++m) { const int r = rbase + ai * HALF + m * 16; float sq = 0.f;
                    const float r2 = ss2 ? __builtin_amdgcn_rcpf(r2v[ai][m] * (1.f / DM) + EPS) : 1.f;
#pragma unroll
                    for (int bj = 0; bj < 2; ++bj) { const size_t eo = (size_t)r * DM + col0 + bj * HALF; f32x4 v0, v1; const u32x4 w = bw[0][m][bj];
                        v0[0] = __uint_as_float(w.x << 16); v0[1] = __uint_as_float(w.x & 0xffff0000u); v0[2] = __uint_as_float(w.y << 16); v0[3] = __uint_as_float(w.y & 0xffff0000u);
                        v1[0] = __uint_as_float(w.z << 16); v1[1] = __uint_as_float(w.z & 0xffff0000u); v1[2] = __uint_as_float(w.w << 16); v1[3] = __uint_as_float(w.w & 0xffff0000u);
                        v0 += acc[ai][bj][m][0] * r2; v1 += acc[ai][bj][m][1] * r2;
                        if (out) { *(f32x4*)(out + eo) = v0; *(f32x4*)(out + eo + 4) = v1; }
                        if (xbf) { u32x4 o; o.x = cvt_pk_bf16(v0[0], v0[1]); o.y = cvt_pk_bf16(v0[2], v0[3]); o.z = cvt_pk_bf16(v1[0], v1[1]); o.w = cvt_pk_bf16(v1[2], v1[3]); *(u32x4*)(xbf + eo) = o;
                            sq += ((v0[0] * v0[0] + v0[1] * v0[1]) + (v0[2] * v0[2] + v0[3] * v0[3])) + ((v1[0] * v1[0] + v1[1] * v1[1]) + (v1[2] * v1[2] + v1[3] * v1[3])); } }
                    if (xbf) { sq += swz_xor16(sq); { auto rr = __builtin_amdgcn_permlane32_swap(__float_as_uint(sq), __float_as_uint(sq), false, false); sq = __uint_as_float(rr[0]) + __uint_as_float(rr[1]); }
                        if (fq == 0) atomicAdd(ssq + r, sq); } } }
            return; }
#pragma unroll
        for (int am = 0; am < 4; ++am) { const int ai = am >> 1;
            f32x4 bf[4][2][2];
#pragma unroll
            for (int m = 2 * (am & 1); m < 2 * (am & 1) + 2; ++m) { const int r = rbase + ai * HALF + m * 16; const float* b = (r < SEQ ? xa + (size_t)r * DM : xb + (size_t)(r - SEQ) * DM) + col0;
#pragma unroll
                for (int bj = 0; bj < 2; ++bj) { bf[m][bj][0] = *(const f32x4*)(b + bj * HALF); bf[m][bj][1] = *(const f32x4*)(b + bj * HALF + 4); } }
#pragma unroll
            for (int m = 2 * (am & 1); m < 2 * (am & 1) + 2; ++m) { const int r = rbase + ai * HALF + m * 16; float sq = 0.f;
                const float r2 = ss2 ? __builtin_amdgcn_rcpf(r2v[ai][m] * (1.f / DM) + EPS) : 1.f;
#pragma unroll
                for (int bj = 0; bj < 2; ++bj) { const size_t eo = (size_t)r * DM + col0 + bj * HALF;
                    const f32x4 v0 = bf[m][bj][0] + acc[ai][bj][m][0] * r2, v1 = bf[m][bj][1] + acc[ai][bj][m][1] * r2;
                    if (out) { *(f32x4*)(out + eo) = v0; *(f32x4*)(out + eo + 4) = v1; }
                    if (xbf) { u32x4 o; o.x = cvt_pk_bf16(v0[0], v0[1]); o.y = cvt_pk_bf16(v0[2], v0[3]); o.z = cvt_pk_bf16(v1[0], v1[1]); o.w = cvt_pk_bf16(v1[2], v1[3]); *(u32x4*)(xbf + eo) = o;
                        sq += ((v0[0] * v0[0] + v0[1] * v0[1]) + (v0[2] * v0[2] + v0[3] * v0[3])) + ((v1[0] * v1[0] + v1[1] * v1[1]) + (v1[2] * v1[2] + v1[3] * v1[3])); } }
                if (xbf) { sq += swz_xor16(sq); { auto rr = __builtin_amdgcn_permlane32_swap(__float_as_uint(sq), __float_as_uint(sq), false, false); sq = __uint_as_float(rr[0]) + __uint_as_float(rr[1]); }
                    if (fq == 0) atomicAdd(ssq + r, sq); } } }
    }
};
struct EpiRelu2 {
    static constexpr bool PERM = true, AFTER_DRAIN = false;
    bf16_t* O; long ldc;
    __device__ __forceinline__ void operator()(const f32x4 (&acc)[2][2][4][2], const Unit& u, int wr, int wc, int fr, int fq) const {
        const int row0 = u.pm * BM + wr * 64 + fr, col0 = u.pn * BM + wc * 32 + 8 * fq;
#pragma unroll
        for (int ai = 0; ai < 2; ++ai)
#pragma unroll
            for (int m = 0; m < 4; ++m) { bf16_t* rowp = O + (size_t)(row0 + ai * HALF + m * 16) * ldc + col0;
#pragma unroll
                for (int bj = 0; bj < 2; ++bj) { f32x4 v0 = acc[ai][bj][m][0], v1 = acc[ai][bj][m][1];
#pragma unroll
                    for (int j = 0; j < 4; ++j) { const float a = fmaxf(v0[j], 0.f), b = fmaxf(v1[j], 0.f); v0[j] = a * a; v1[j] = b * b; }
                    u32x4 w; w.x = cvt_pk_bf16(v0[0], v0[1]); w.y = cvt_pk_bf16(v0[2], v0[3]); w.z = cvt_pk_bf16(v1[0], v1[1]); w.w = cvt_pk_bf16(v1[2], v1[3]);
                    *(u32x4*)(rowp + bj * HALF) = w; } }
    }
};
}
namespace att {
typedef short bf16x8 __attribute__((ext_vector_type(8)));
typedef short s16x4 __attribute__((ext_vector_type(4)));
typedef float f32x16 __attribute__((ext_vector_type(16)));
typedef short v4i16_t __attribute__((ext_vector_type(4)));
typedef LAS const unsigned char* lds_cptr;
constexpr int SLOT = 32768, K_OFF = 0, V_OFF = 16384, NSLOT = 4, WS_OFF = NSLOT * SLOT + 1024  , LDS_NEED = WS_OFF + 8 * 256 + 16;
constexpr int PART_FLOATS = 8 * 64 * 64 + 8 * 128;
constexpr float LOG2E = 1.4426950408889634f, QSCALE = 0.125f * LOG2E, THR = 8.0f;
__device__ __forceinline__ int crow(int r, int hi) { return (r & 3) + 8 * (r >> 2) + 4 * hi; }
__device__ __forceinline__ void glds16(const void* gsrc, unsigned lds_dst) { unsigned keep;
    asm volatile("s_mov_b32 %0, m0\n\ts_mov_b32 m0, %2\n\ts_nop 0\n\tglobal_load_lds_dwordx4 %1, off\n\ts_mov_b32 m0, %0" : "=&s"(keep) : "v"(gsrc), "s"(lds_dst) : "memory"); }
__device__ __forceinline__ unsigned cvtpk(float lo, float hi) { typedef float f2 __attribute__((ext_vector_type(2))); typedef __bf16 b2 __attribute__((ext_vector_type(2)));
    f2 v = {lo, hi}; b2 b = __builtin_convertvector(v, b2); return __builtin_bit_cast(unsigned, b); }
__device__ __forceinline__ s16x4 vtr(lds_cptr p) { return __builtin_bit_cast(s16x4, __builtin_amdgcn_ds_read_tr16_b64_v4i16((LAS v4i16_t*)p)); }
#define ATT_MFMA(a, b, c) __builtin_amdgcn_mfma_f32_32x32x16_bf16(a, b, c, 0, 0, 0)
__device__ __forceinline__ int tile_lo(int h, int chunkA, float bound) {
    const float slope2_ = exp2f(-2.f * (float)(h + 1)) * LOG2E, dth = (2.f * bound + THR + 160.f) / slope2_; const float qmin = 64.f * (float)chunkA;
    const float cl = ceilf((qmin - 63.f - dth) * (1.f / 64.f)); int c_lo = cl > 0.f ? (int)cl : 0; if (c_lo > chunkA) c_lo = chunkA; return c_lo;
}
__device__ __forceinline__ void convert_slice(const float* __restrict__ ck, const float* __restrict__ cv, bf16* __restrict__ kc, bf16* __restrict__ vc, int h, int c_lo, int tid) {
    const int tid_o = opaque_v(tid), sub = tid_o & 15, p0 = tid_o >> 4;
    const float* sk = ck + (size_t)h * 128 + sub * 8; const float* sv = cv + (size_t)h * 128 + sub * 8; bf16* dk = kc + (size_t)h * 128 + sub * 8; bf16* dv = vc + (size_t)h * 128 + sub * 8;
#pragma unroll 4
    for (int pos = 64 * c_lo + p0; pos < PAST; pos += 32) {
        const f32x4 a0 = *(const f32x4*)(sk + (size_t)pos * 512), a1 = *(const f32x4*)(sk + (size_t)pos * 512 + 4), b0 = *(const f32x4*)(sv + (size_t)pos * 512), b1 = *(const f32x4*)(sv + (size_t)pos * 512 + 4);
        u32x4 o; o.x = pk2(a0.x, a0.y); o.y = pk2(a0.z, a0.w); o.z = pk2(a1.x, a1.y); o.w = pk2(a1.z, a1.w); *(u32x4*)(dk + (size_t)pos * 512) = o;
        o.x = pk2(b0.x, b0.y); o.y = pk2(b0.z, b0.w); o.z = pk2(b1.x, b1.y); o.w = pk2(b1.z, b1.w); *(u32x4*)(dv + (size_t)pos * 512) = o; }
    asm volatile("s_waitcnt vmcnt(0)" ::: "memory"); __syncthreads();
    if (tid == 0) { __builtin_amdgcn_fence(__ATOMIC_ACQUIRE, "agent"); asm volatile("s_waitcnt vmcnt(0)" ::: "memory"); }
    __syncthreads();
}
struct Unit { const bf16* K; const bf16* V; int qrow0, chunkA, chunkB, h, nseg, seg, pidx, pad; };
struct Tensors { const bf16* QN; bf16* MIX; const float* out_g; float* part; unsigned* segcnt; float lam, lam_init_c, bound, kmax; };

__device__ __forceinline__ void attn_unit(const Unit& u, const Tensors& T, LAS unsigned char* shm, int tid_in) {
    const int tid = opaque_v(tid_in);
    const int lane = tid & 63, r32 = lane & 31, hi = lane >> 5, wid = __builtin_amdgcn_readfirstlane(tid >> 6), g = wid & 3, mp = wid >> 2;
    const int myChunk = g < 2 ? u.chunkA : u.chunkB, c_hi = u.chunkA > u.chunkB ? u.chunkA : u.chunkB, qi = 32 * (g & 1) + r32, h = u.h;
    const bool active = myChunk >= 0;
    int c_lo = tile_lo(u.h, u.chunkA, T.bound);
    int c_top = c_hi;
    if (u.nseg == 2) { const int c_mid = c_lo + ((c_hi - c_lo) >> 1); if (u.seg == 0) c_lo = c_mid + 1; else c_top = c_mid; }
    const unsigned lds0 = (unsigned)(uintptr_t)shm;
    LAS float* wsf = (LAS float*)(shm + WS_OFF) + wid * 64;
    const float slope2 = exp2f(-2.f * (float)(h + 1)) * LOG2E;
    const bf16* ksrc = u.K + (size_t)lane * 512 + h * 128 + wid * 8;
    const bf16* vsrc = u.V + (size_t)(16 * (wid & 3) + (lane >> 2)) * 512 + h * 128 + (wid >> 2) * 32 + (lane & 3) * 8;
#define ATT_DMA(tile, slot) do { const size_t to_ = (size_t)(tile) * 64 * 512; const unsigned sb_ = lds0 + (slot) * SLOT; \
        glds16(ksrc + to_, (unsigned)__builtin_amdgcn_readfirstlane(sb_ + K_OFF + wid * 1024)); glds16(ksrc + to_ + 64, (unsigned)__builtin_amdgcn_readfirstlane(sb_ + K_OFF + 8192 + wid * 1024)); \
        glds16(vsrc + to_, (unsigned)__builtin_amdgcn_readfirstlane(sb_ + V_OFF + (wid >> 2) * 4096 + (wid & 3) * 1024)); \
        glds16(vsrc + to_ + 64, (unsigned)__builtin_amdgcn_readfirstlane(sb_ + V_OFF + ((wid >> 2) + 2) * 4096 + (wid & 3) * 1024)); } while (0)
    ATT_DMA(c_top, 0);
    bf16x8 qr[4];
#pragma unroll
    for (int d0 = 0; d0 < 4; ++d0) qr[d0] = active ? *(const bf16x8*)(T.QN + (size_t)(u.qrow0 + 32 * g + r32) * 512 + h * 128 + mp * 64 + d0 * 16 + hi * 8) : (bf16x8){0, 0, 0, 0, 0, 0, 0, 0};
#pragma unroll
    for (int d0 = 0; d0 < 4; ++d0) asm volatile("" : "+v"(qr[d0]));
    f32x16 o[4];
#pragma unroll
    for (int d = 0; d < 4; ++d) o[d] = (f32x16){0.f, 0.f, 0.f, 0.f, 0.f, 0.f, 0.f, 0.f, 0.f, 0.f, 0.f, 0.f, 0.f, 0.f, 0.f, 0.f};
    const bool fixedref = T.bound < 40.f;
    float mhat = 0.f, l_reg = 0.f; bool first = true;
    if (fixedref) { float nq = 0.f;
#pragma unroll
        for (int d0 = 0; d0 < 4; ++d0)
#pragma unroll
            for (int e = 0; e < 8; ++e) { const float v = bf2f((bf16)qr[d0][e]); nq += v * v; }
        { auto rr = __builtin_amdgcn_permlane32_swap(__float_as_uint(nq), __float_as_uint(nq), false, false); nq = __uint_as_float(rr[0]) + __uint_as_float(rr[1]); }
        mhat = sqrtf(nq) * T.kmax * 1.01f + 0.01f; first = false; }
    const lds_cptr shm3 = (lds_cptr)shm;
    const int vlane = ((lane >> 4) & 1) * 32 + (lane & 3) * 8 + (4 * hi + ((lane & 15) >> 2)) * 64;
    const int n = c_top - c_lo + 1;
    bf16x8 pa[4];
#define ATT_SGB(mask, cnt) __builtin_amdgcn_sched_group_barrier(mask, cnt, 0)
#define ATT_SB() __builtin_amdgcn_sched_barrier(0)
#define ATT_VLD(I, B) do { vlo[B] = vtr(vp_ + ((I) >> 2) * 4096 + ((I) & 3) * 1024); vhi[B] = vtr(vp_ + ((I) >> 2) * 4096 + ((I) & 3) * 1024 + 512); } while (0)
#define ATT_PV_HEAD(SL) const lds_cptr vp_ = shm3 + opaque_s((SL) * SLOT) + V_OFF + vlane; s16x4 vlo[3], vhi[3]; ATT_VLD(0, 0); ATT_VLD(1, 1)
#define ATT_PV_STEP(I) do { if ((I) + 2 < 16) ATT_VLD((I) + 2, ((I) + 2) % 3); \
            const bf16x8 vf = {vlo[(I) % 3][0], vlo[(I) % 3][1], vlo[(I) % 3][2], vlo[(I) % 3][3], vhi[(I) % 3][0], vhi[(I) % 3][1], vhi[(I) % 3][2], vhi[(I) % 3][3]}; \
            o[(I) >> 2] = ATT_MFMA(pa[(I) & 3], vf, o[(I) >> 2]); } while (0)
#define ATT_STEP_BARRIER(I) do { if ((I) + 2 < n) asm volatile("s_waitcnt vmcnt(4) lgkmcnt(0)\n\ts_barrier" ::: "memory");     \
        else asm volatile("s_waitcnt vmcnt(0) lgkmcnt(0)\n\ts_barrier" ::: "memory");     \
        if ((I) + 3 < n) ATT_DMA(c_top - ((I) + 3), ((I) + 3) & 3); } while (0)
#define ATT_PACK(P0, P1) do { typedef unsigned u4 __attribute__((ext_vector_type(4))); \
        const u4 w0 = {cvtpk(P0[0], P0[1]), cvtpk(P0[2], P0[3]), cvtpk(P0[4], P0[5]), cvtpk(P0[6], P0[7])}, w1 = {cvtpk(P0[8], P0[9]), cvtpk(P0[10], P0[11]), cvtpk(P0[12], P0[13]), cvtpk(P0[14], P0[15])}; \
        const u4 w2 = {cvtpk(P1[0], P1[1]), cvtpk(P1[2], P1[3]), cvtpk(P1[4], P1[5]), cvtpk(P1[6], P1[7])}, w3 = {cvtpk(P1[8], P1[9]), cvtpk(P1[10], P1[11]), cvtpk(P1[12], P1[13]), cvtpk(P1[14], P1[15])}; \
        pa[0] = __builtin_bit_cast(bf16x8, w0); pa[1] = __builtin_bit_cast(bf16x8, w1); pa[2] = __builtin_bit_cast(bf16x8, w2); pa[3] = __builtin_bit_cast(bf16x8, w3); } while (0)
    if (n > 1) ATT_DMA(c_top - 1, 1);
    if (n > 2) ATT_DMA(c_top - 2, 2);
    const int nslow = (!fixedref || n <= 3) ? n : ((n & 1) ? 3 : 2);
    int i = 0;
    for (; i < nslow; ++i) {
        const int c = c_top - i, slot = i & 3;
        ATT_STEP_BARRIER(i);
        if (active && c <= myChunk) {
            const lds_cptr kp = shm3 + slot * SLOT + K_OFF + mp * 8192 + hi * 1024 + r32 * 16;
            f32x16 p0, p1;
            if (c == myChunk) {
#pragma unroll
                for (int r = 0; r < 16; ++r) { const float dq_ = (float)(qi - 4 * hi) - (float)((r & 3) + 8 * (r >> 2)); p0[r] = __builtin_fmaf(-slope2, fabsf(dq_), -mhat); p1[r] = __builtin_fmaf(-slope2, fabsf(dq_ - 32.f), -mhat); }
            } else { const float base = -mhat - slope2 * (float)(64 * (myChunk - c) + qi - 4 * hi), base1 = base + 32.f * slope2;
#pragma unroll
                for (int r = 0; r < 16; ++r) { const float kc_ = (float)((r & 3) + 8 * (r >> 2)); p0[r] = __builtin_fmaf(slope2, kc_, base); p1[r] = __builtin_fmaf(slope2, kc_, base1); } }
#pragma unroll
            for (int d0 = 0; d0 < 4; ++d0) { const bf16x8 k0 = *(const LAS bf16x8*)(kp + d0 * 2048), k1 = *(const LAS bf16x8*)(kp + d0 * 2048 + 512);
                p0 = ATT_MFMA(k0, qr[d0], p0); p1 = ATT_MFMA(k1, qr[d0], p1); }
            if (!fixedref) {
            float rm = fmaxf(p0[0], p1[0]);
#pragma unroll
            for (int r = 1; r < 16; ++r) rm = fmaxf(rm, fmaxf(p0[r], p1[r]));
            { auto rr = __builtin_amdgcn_permlane32_swap(__float_as_uint(rm), __float_as_uint(rm), false, false); rm = fmaxf(__uint_as_float(rr[0]), __uint_as_float(rr[1])); }
            if (first || __any(rm > THR)) {
                const float dl = first ? rm : fmaxf(rm, 0.f); mhat += dl;
#pragma unroll
                for (int r = 0; r < 16; ++r) { p0[r] -= dl; p1[r] -= dl; }
                if (!first) { const float f = __builtin_amdgcn_exp2f(-dl); l_reg *= f; if (hi == 0) wsf[r32] = f;
                    asm volatile("s_waitcnt lgkmcnt(0)" ::: "memory");
#pragma unroll
                    for (int r = 0; r < 16; ++r) { const float fr_ = wsf[crow(r, hi)];
#pragma unroll
                        for (int d = 0; d < 4; ++d) o[d][r] *= fr_; } }
                first = false;
            }
            }
            float sacc = 0.f;
#pragma unroll
            for (int r = 0; r < 16; ++r) { p0[r] = __builtin_amdgcn_exp2f(p0[r]); p1[r] = __builtin_amdgcn_exp2f(p1[r]); sacc += p0[r] + p1[r]; }
            l_reg += sacc;
            { typedef unsigned u4 __attribute__((ext_vector_type(4)));
              u4 w0 = {cvtpk(p0[0], p0[1]), cvtpk(p0[2], p0[3]), cvtpk(p0[4], p0[5]), cvtpk(p0[6], p0[7])}, w1 = {cvtpk(p0[8], p0[9]), cvtpk(p0[10], p0[11]), cvtpk(p0[12], p0[13]), cvtpk(p0[14], p0[15])};
              u4 w2 = {cvtpk(p1[0], p1[1]), cvtpk(p1[2], p1[3]), cvtpk(p1[4], p1[5]), cvtpk(p1[6], p1[7])}, w3 = {cvtpk(p1[8], p1[9]), cvtpk(p1[10], p1[11]), cvtpk(p1[12], p1[13]), cvtpk(p1[14], p1[15])};
              pa[0] = __builtin_bit_cast(bf16x8, w0); pa[1] = __builtin_bit_cast(bf16x8, w1); pa[2] = __builtin_bit_cast(bf16x8, w2); pa[3] = __builtin_bit_cast(bf16x8, w3); }
            { ATT_PV_HEAD(slot);
#pragma unroll
              for (int i_ = 0; i_ < 16; ++i_) { ATT_PV_STEP(i_); __builtin_amdgcn_sched_barrier(0); } }
        }
    }
    if (nslow < n) {
        f32x16 a0, a1, b0, b1;
        const float bq = -mhat - slope2 * (float)(64 * myChunk + qi - 4 * hi);
#define ATT_CINIT(P0, P1, CC) do { const float base_ = bq + slope2 * (float)(64 * (CC)), base1_ = base_ + 32.f * slope2; \
        _Pragma("unroll") for (int r = 0; r < 16; ++r) { const float kc_ = (float)((r & 3) + 8 * (r >> 2)); P0[r] = __builtin_fmaf(slope2, kc_, base_); P1[r] = __builtin_fmaf(slope2, kc_, base1_); } } while (0)
#define ATT_QK(P0, P1, SL) do { const lds_cptr kp_ = shm3 + opaque_s((SL) * SLOT) + K_OFF + mp * 8192 + hi * 1024 + r32 * 16; bf16x8 kfa[4], kfb[4]; \
        _Pragma("unroll") for (int d0 = 0; d0 < 4; ++d0) { kfa[d0] = *(const LAS bf16x8*)(kp_ + d0 * 2048); kfb[d0] = *(const LAS bf16x8*)(kp_ + d0 * 2048 + 512); } \
        _Pragma("unroll") for (int d0 = 0; d0 < 4; ++d0) { P0 = ATT_MFMA(kfa[d0], qr[d0], P0); P1 = ATT_MFMA(kfb[d0], qr[d0], P1); } } while (0)
#define ATT_EXP(P0, P1) do { _Pragma("unroll") for (int r = 0; r < 16; ++r) { P0[r] = __builtin_amdgcn_exp2f(P0[r]); P1[r] = __builtin_amdgcn_exp2f(P1[r]); } } while (0)
#define ATT_ROWSUM(P0, P1) do { float s0_ = 0.f, s1_ = 0.f; _Pragma("unroll") for (int r = 0; r < 16; ++r) { s0_ += P0[r]; s1_ += P1[r]; } l_reg += s0_ + s1_; } while (0)
#define ATT_PIN(x) asm volatile("" : "+v"(x))
#define ATT_FAST_STEP(I, PU0, PU1, WU0, WU1) do { ATT_STEP_BARRIER(I); if (active) { \
            const lds_cptr kp_ = shm3 + opaque_s((((I) + 1) & 3) * SLOT) + K_OFF + mp * 8192 + hi * 1024 + r32 * 16; bf16x8 kf[8]; \
            _Pragma("unroll") for (int d0 = 0; d0 < 4; ++d0) { kf[2 * d0] = *(const LAS bf16x8*)(kp_ + d0 * 2048); kf[2 * d0 + 1] = *(const LAS bf16x8*)(kp_ + d0 * 2048 + 512); } \
            float s0_ = 0.f, s1_ = 0.f; typedef unsigned u4_ __attribute__((ext_vector_type(4))); u4_ pw0, pw1, pw2, pw3; ATT_SB(); \
            WU0 = ATT_MFMA(kf[0], qr[0], WU0); s0_ += PU0[0]; s1_ += PU0[1]; s0_ += PU0[2]; s1_ += PU0[3]; pw0[0] = cvtpk(PU0[0], PU0[1]); pw0[1] = cvtpk(PU0[2], PU0[3]); ATT_PIN(s0_); ATT_PIN(s1_); ATT_PIN(pw0); ATT_SB(); \
            WU1 = ATT_MFMA(kf[1], qr[0], WU1); s0_ += PU0[4]; s1_ += PU0[5]; s0_ += PU0[6]; s1_ += PU0[7]; pw0[2] = cvtpk(PU0[4], PU0[5]); pw0[3] = cvtpk(PU0[6], PU0[7]); ATT_PIN(s0_); ATT_PIN(s1_); ATT_PIN(pw0); ATT_SB(); \
            WU0 = ATT_MFMA(kf[2], qr[1], WU0); s0_ += PU0[8]; s1_ += PU0[9]; s0_ += PU0[10]; s1_ += PU0[11]; pw1[0] = cvtpk(PU0[8], PU0[9]); pw1[1] = cvtpk(PU0[10], PU0[11]); ATT_PIN(s0_); ATT_PIN(s1_); ATT_PIN(pw1); ATT_SB(); \
            WU1 = ATT_MFMA(kf[3], qr[1], WU1); s0_ += PU0[12]; s1_ += PU0[13]; s0_ += PU0[14]; s1_ += PU0[15]; pw1[2] = cvtpk(PU0[12], PU0[13]); pw1[3] = cvtpk(PU0[14], PU0[15]); ATT_PIN(s0_); ATT_PIN(s1_); ATT_PIN(pw1); ATT_SB(); \
            WU0 = ATT_MFMA(kf[4], qr[2], WU0); s0_ += PU1[0]; s1_ += PU1[1]; s0_ += PU1[2]; s1_ += PU1[3]; pw2[0] = cvtpk(PU1[0], PU1[1]); pw2[1] = cvtpk(PU1[2], PU1[3]); ATT_PIN(s0_); ATT_PIN(s1_); ATT_PIN(pw2); ATT_SB(); \
            WU1 = ATT_MFMA(kf[5], qr[2], WU1); s0_ += PU1[4]; s1_ += PU1[5]; s0_ += PU1[6]; s1_ += PU1[7]; pw2[2] = cvtpk(PU1[4], PU1[5]); pw2[3] = cvtpk(PU1[6], PU1[7]); ATT_PIN(s0_); ATT_PIN(s1_); ATT_PIN(pw2); ATT_SB(); \
            WU0 = ATT_MFMA(kf[6], qr[3], WU0); s0_ += PU1[8]; s1_ += PU1[9]; s0_ += PU1[10]; s1_ += PU1[11]; pw3[0] = cvtpk(PU1[8], PU1[9]); pw3[1] = cvtpk(PU1[10], PU1[11]); ATT_PIN(s0_); ATT_PIN(s1_); ATT_PIN(pw3); ATT_SB(); \
            WU1 = ATT_MFMA(kf[7], qr[3], WU1); s0_ += PU1[12]; s1_ += PU1[13]; s0_ += PU1[14]; s1_ += PU1[15]; pw3[2] = cvtpk(PU1[12], PU1[13]); pw3[3] = cvtpk(PU1[14], PU1[15]); ATT_PIN(s0_); ATT_PIN(s1_); ATT_PIN(pw3); ATT_SB(); \
            l_reg += s0_ + s1_; pa[0] = __builtin_bit_cast(bf16x8, pw0); pa[1] = __builtin_bit_cast(bf16x8, pw1); pa[2] = __builtin_bit_cast(bf16x8, pw2); pa[3] = __builtin_bit_cast(bf16x8, pw3); \
            const float cb_ = bq + slope2 * (float)(64 * (c_top - ((I) + 2))), cb1_ = cb_ + 32.f * slope2; \
            ATT_PV_HEAD((I) & 3); ATT_SB(); \
            ATT_PV_STEP(0); WU0[0] = __builtin_amdgcn_exp2f(WU0[0]); WU0[1] = __builtin_amdgcn_exp2f(WU0[1]); PU0[0] = __builtin_fmaf(slope2, 0.f, cb_); PU0[1] = __builtin_fmaf(slope2, 1.f, cb_); ATT_PIN(WU0); ATT_PIN(PU0); ATT_SB(); \
            ATT_PV_STEP(1); WU0[2] = __builtin_amdgcn_exp2f(WU0[2]); WU0[3] = __builtin_amdgcn_exp2f(WU0[3]); PU0[2] = __builtin_fmaf(slope2, 2.f, cb_); PU0[3] = __builtin_fmaf(slope2, 3.f, cb_); ATT_PIN(WU0); ATT_PIN(PU0); ATT_SB(); \
            ATT_PV_STEP(2); WU0[4] = __builtin_amdgcn_exp2f(WU0[4]); WU0[5] = __builtin_amdgcn_exp2f(WU0[5]); PU0[4] = __builtin_fmaf(slope2, 8.f, cb_); PU0[5] = __builtin_fmaf(slope2, 9.f, cb_); ATT_PIN(WU0); ATT_PIN(PU0); ATT_SB(); \
            ATT_PV_STEP(3); WU0[6] = __builtin_amdgcn_exp2f(WU0[6]); WU0[7] = __builtin_amdgcn_exp2f(WU0[7]); PU0[6] = __builtin_fmaf(slope2, 10.f, cb_); PU0[7] = __builtin_fmaf(slope2, 11.f, cb_); ATT_PIN(WU0); ATT_PIN(PU0); ATT_SB(); \
            ATT_PV_STEP(4); WU0[8] = __builtin_amdgcn_exp2f(WU0[8]); WU0[9] = __builtin_amdgcn_exp2f(WU0[9]); PU0[8] = __builtin_fmaf(slope2, 16.f, cb_); PU0[9] = __builtin_fmaf(slope2, 17.f, cb_); ATT_PIN(WU0); ATT_PIN(PU0); ATT_SB(); \
            ATT_PV_STEP(5); WU0[10] = __builtin_amdgcn_exp2f(WU0[10]); WU0[11] = __builtin_amdgcn_exp2f(WU0[11]); PU0[10] = __builtin_fmaf(slope2, 18.f, cb_); PU0[11] = __builtin_fmaf(slope2, 19.f, cb_); ATT_PIN(WU0); ATT_PIN(PU0); ATT_SB(); \
            ATT_PV_STEP(6); WU0[12] = __builtin_amdgcn_exp2f(WU0[12]); WU0[13] = __builtin_amdgcn_exp2f(WU0[13]); PU0[12] = __builtin_fmaf(slope2, 24.f, cb_); PU0[13] = __builtin_fmaf(slope2, 25.f, cb_); ATT_PIN(WU0); ATT_PIN(PU0); ATT_SB(); \
            ATT_PV_STEP(7); WU0[14] = __builtin_amdgcn_exp2f(WU0[14]); WU0[15] = __builtin_amdgcn_exp2f(WU0[15]); PU0[14] = __builtin_fmaf(slope2, 26.f, cb_); PU0[15] = __builtin_fmaf(slope2, 27.f, cb_); ATT_PIN(WU0); ATT_PIN(PU0); ATT_SB(); \
            ATT_PV_STEP(8); WU1[0] = __builtin_amdgcn_exp2f(WU1[0]); WU1[1] = __builtin_amdgcn_exp2f(WU1[1]); PU1[0] = __builtin_fmaf(slope2, 0.f, cb1_); PU1[1] = __builtin_fmaf(slope2, 1.f, cb1_); ATT_PIN(WU1); ATT_PIN(PU1); ATT_SB(); \
            ATT_PV_STEP(9); WU1[2] = __builtin_amdgcn_exp2f(WU1[2]); WU1[3] = __builtin_amdgcn_exp2f(WU1[3]); PU1[2] = __builtin_fmaf(slope2, 2.f, cb1_); PU1[3] = __builtin_fmaf(slope2, 3.f, cb1_); ATT_PIN(WU1); ATT_PIN(PU1); ATT_SB(); \
            ATT_PV_STEP(10); WU1[4] = __builtin_amdgcn_exp2f(WU1[4]); WU1[5] = __builtin_amdgcn_exp2f(WU1[5]); PU1[4] = __builtin_fmaf(slope2, 8.f, cb1_); PU1[5] = __builtin_fmaf(slope2, 9.f, cb1_); ATT_PIN(WU1); ATT_PIN(PU1); ATT_SB(); \
            ATT_PV_STEP(11); WU1[6] = __builtin_amdgcn_exp2f(WU1[6]); WU1[7] = __builtin_amdgcn_exp2f(WU1[7]); PU1[6] = __builtin_fmaf(slope2, 10.f, cb1_); PU1[7] = __builtin_fmaf(slope2, 11.f, cb1_); ATT_PIN(WU1); ATT_PIN(PU1); ATT_SB(); \
            ATT_PV_STEP(12); WU1[8] = __builtin_amdgcn_exp2f(WU1[8]); WU1[9] = __builtin_amdgcn_exp2f(WU1[9]); PU1[8] = __builtin_fmaf(slope2, 16.f, cb1_); PU1[9] = __builtin_fmaf(slope2, 17.f, cb1_); ATT_PIN(WU1); ATT_PIN(PU1); ATT_SB(); \
            ATT_PV_STEP(13); WU1[10] = __builtin_amdgcn_exp2f(WU1[10]); WU1[11] = __builtin_amdgcn_exp2f(WU1[11]); PU1[10] = __builtin_fmaf(slope2, 18.f, cb1_); PU1[11] = __builtin_fmaf(slope2, 19.f, cb1_); ATT_PIN(WU1); ATT_PIN(PU1); ATT_SB(); \
            ATT_PV_STEP(14); WU1[12] = __builtin_amdgcn_exp2f(WU1[12]); WU1[13] = __builtin_amdgcn_exp2f(WU1[13]); PU1[12] = __builtin_fmaf(slope2, 24.f, cb1_); PU1[13] = __builtin_fmaf(slope2, 25.f, cb1_); ATT_PIN(WU1); ATT_PIN(PU1); ATT_SB(); \
            ATT_PV_STEP(15); WU1[14] = __builtin_amdgcn_exp2f(WU1[14]); WU1[15] = __builtin_amdgcn_exp2f(WU1[15]); PU1[14] = __builtin_fmaf(slope2, 26.f, cb1_); PU1[15] = __builtin_fmaf(slope2, 27.f, cb1_); ATT_PIN(WU1); ATT_PIN(PU1); ATT_SB(); \
        } } while (0)
        if (active) { ATT_CINIT(a0, a1, c_top - i); ATT_QK(a0, a1, i & 3); ATT_EXP(a0, a1); ATT_CINIT(b0, b1, c_top - (i + 1)); }
        ATT_FAST_STEP(i, a0, a1, b0, b1); ++i;
        for (; i + 1 < n; ) { ATT_FAST_STEP(i, b0, b1, a0, a1); ++i; ATT_FAST_STEP(i, a0, a1, b0, b1); ++i; }
        ATT_STEP_BARRIER(i);
        if (active) { ATT_ROWSUM(b0, b1); ATT_PACK(b0, b1);
            { ATT_PV_HEAD(i & 3);
#pragma unroll
              for (int i_ = 0; i_ < 16; ++i_) { ATT_PV_STEP(i_); __builtin_amdgcn_sched_barrier(0); } } }
#undef ATT_FAST_STEP
#undef ATT_PIN
#undef ATT_ROWSUM
#undef ATT_EXP
#undef ATT_QK
#undef ATT_CINIT
    }
#undef ATT_PACK
#undef ATT_STEP_BARRIER
#undef ATT_PV_STEP
#undef ATT_PV_HEAD
#undef ATT_VLD
#undef ATT_SGB
#undef ATT_SB
    { auto rr = __builtin_amdgcn_permlane32_swap(__float_as_uint(l_reg), __float_as_uint(l_reg), false, false); l_reg = __uint_as_float(rr[0]) + __uint_as_float(rr[1]); }
    if (u.nseg == 2) {
        if (first) mhat = -1e30f;
        float* pb = T.part + (size_t)(u.pidx * 2 + u.seg) * PART_FLOATS;
#pragma unroll
        for (int r = 0; r < 16; ++r)
#pragma unroll
            for (int dq = 0; dq < 4; ++dq) pb[(unsigned)(((wid * 16 + r) * 4 + dq) * 64 + lane)] = o[dq][r];
        pb[(unsigned)(32768 + wid * 128 + lane)] = mhat; pb[(unsigned)(32768 + wid * 128 + 64 + lane)] = l_reg;
        volatile LAS unsigned* sw = (volatile LAS unsigned*)(shm + WS_OFF + 8 * 256);
        asm volatile("s_waitcnt vmcnt(0)" ::: "memory"); __syncthreads();
        if (tid == 0) { __builtin_amdgcn_fence(__ATOMIC_RELEASE, "agent"); asm volatile("s_waitcnt vmcnt(0)" ::: "memory");
            sw[0] = __hip_atomic_fetch_add(T.segcnt + 64 * u.pidx, 1u, __ATOMIC_RELAXED, __HIP_MEMORY_SCOPE_AGENT); }
        __syncthreads();
        const bool last = sw[0] == 1u;
        __syncthreads();
        if (!last) return;
        if (tid == 0) { __builtin_amdgcn_fence(__ATOMIC_ACQUIRE, "agent"); asm volatile("s_waitcnt vmcnt(0)" ::: "memory"); }
        __syncthreads();
        const float* ob = T.part + (size_t)(u.pidx * 2 + (1 - u.seg)) * PART_FLOATS;
        const float m_o = ob[(unsigned)(32768 + wid * 128 + lane)], l_o = ob[(unsigned)(32768 + wid * 128 + 64 + lane)];
        const float M = fmaxf(mhat, m_o), fs = __builtin_amdgcn_exp2f(mhat - M), fo = __builtin_amdgcn_exp2f(m_o - M);
        l_reg = l_reg * fs + l_o * fo; mhat = M;
        if (hi == 0) { wsf[r32] = fs; wsf[32 + r32] = fo; }
        asm volatile("s_waitcnt lgkmcnt(0)" ::: "memory");
#pragma unroll
        for (int r = 0; r < 16; ++r) { const float a_ = wsf[crow(r, hi)], b_ = wsf[32 + crow(r, hi)];
#pragma unroll
            for (int dq = 0; dq < 4; ++dq) o[dq][r] = o[dq][r] * a_ + ob[(unsigned)(((wid * 16 + r) * 4 + dq) * 64 + lane)] * b_; }
        asm volatile("s_waitcnt lgkmcnt(0)" ::: "memory");
    }
    if (hi == 0) wsf[32 + r32] = active ? 1.0f / l_reg : 0.f;
    asm volatile("s_waitcnt lgkmcnt(0)\n\ts_barrier" ::: "memory");
    float rli[16];
#pragma unroll
    for (int r = 0; r < 16; ++r) rli[r] = wsf[32 + crow(r, hi)];
    LAS float* stg = (LAS float*)shm + g * 32 * 128;
    if (mp == 1) {
#pragma unroll
        for (int r = 0; r < 16; ++r)
#pragma unroll
            for (int dq = 0; dq < 4; ++dq) stg[crow(r, hi) * 128 + dq * 32 + r32] = T.lam * o[dq][r] * rli[r];
    }
    asm volatile("s_waitcnt lgkmcnt(0)\n\ts_barrier" ::: "memory");
    if (mp == 0 && active) {
        float gn[4];
#pragma unroll
        for (int dq = 0; dq < 4; ++dq) gn[dq] = T.out_g[dq * 32 + r32] * T.lam_init_c;
#pragma unroll
        for (int r = 0; r < 16; ++r) { float ss = 0.f;
#pragma unroll
            for (int dq = 0; dq < 4; ++dq) { const float v = o[dq][r] * rli[r] - stg[crow(r, hi) * 128 + dq * 32 + r32]; o[dq][r] = v; ss += v * v; }
            ss = half_sum(ss);
            const float rn = 1.0f / sqrtf(ss * (1.f / 128.f) + EPS);
            bf16* mrow = T.MIX + (size_t)(u.qrow0 + 32 * g + crow(r, hi)) * DM + 1024 + h * 128 + r32;
#pragma unroll
            for (int dq = 0; dq < 4; ++dq) mrow[dq * 32] = (bf16)f2bf(o[dq][r] * rn * gn[dq]); }
    }
    asm volatile("s_waitcnt lgkmcnt(0)\n\ts_barrier" ::: "memory");
#undef ATT_DMA
}
}
constexpr int ATT_NITEMS = 800, ATT_NSPLIT = 160;
__device__ const unsigned att_items[ATT_NITEMS] = {1305598,1309694,1297398,1301494,1289198,1293294,1280998,1285094,1272798,1276894,1264598,1268694,1256398,1260494,1248198,1252294,1239998,1244094,1231798,1235894,1223598,1227694,1215398,1219494,1207198,1211294,1198998,1203094,1190798,1194894,1182598,1186694,1174398,1178494,1166198,1170294,1157998,1162094,1149798,1153894,1141598,1145694,1133398,1137494,1125198,1129294,1116998,1121094,1108798,1112894,1100598,1104694,1092398,1096494,1084198,1088294,1075998,1080094,1067798,1071894,1059598,1063694,1051398,1055494,380,382,1043198,1047294,1034998,1039094,372,374,1026798,1030894,1018598,1022694,364,366,1010398,1014494,1002198,1006294,356,358,993998,998094,985798,989894,348,350,977598,981694,969398,973494,340,342,961198,965294,952998,957094,332,334,944798,948894,936598,940694,324,326,928398,932494,920198,924294,316,318,911998,916094,903798,907894,308,310,895598,899694,887398,891494,300,302,879198,883294,870998,875094,292,294,862798,866894,854598,858694,284,286,846398,850494,838198,842294,276,278,829998,834094,821798,825894,166436,170532,174636,178732,182836,186932,191036,195132,199236,203332,207436,211532,215636,219732,223836,227932,232036,236132,240236,244332,248436,252532,256636,260732,264836,268932,273036,277132,281236,285332,289436,293532,297636,301732,305836,309932,314036,318132,322236,326332,330436,334532,338636,342732,346836,350932,355036,359132,363236,367332,371436,375532,379636,383732,387836,391932,396036,400132,404236,408332,412436,416532,420636,424732,428836,432932,437036,441132,445236,449332,453436,457532,461636,465732,469836,473932,478036,482132,486236,490332,494436,498532,502636,506732,510836,514932,519036,523132,527236,531332,535436,539532,543636,547732,551836,555932,560036,564132,568236,572332,576436,580532,584636,588732,592836,596932,601036,605132,609236,613332,617436,621532,625636,629732,633836,637932,642036,646132,650236,654332,268,158236,162332,270,813598,817694,150036,154132,805398,809494,260,141836,145932,262,797198,801294,133636,137732,788998,793094,252,125436,129532,254,780798,784894,117236,121332,772598,776694,244,109036,113132,246,764398,768494,100836,104932,756198,760294,236,92636,96732,238,747998,752094,84436,88532,739798,743894,228,76236,80332,230,731598,735694,68036,72132,723398,727494,220,59836,63932,222,715198,719294,51636,55732,706998,711094,212,43436,47532,214,698798,702894,35236,39332,690598,694694,204,27036,31132,206,682398,686494,18836,22932,674198,678294,196,10636,14732,198,665998,670094,2436,6532,657798,661894,188,190,180,182,172,174,164,166,156,158,148,150,138,146,154,162,170,178,186,194,202,210,218,226,234,242,250,258,266,274,282,290,298,306,314,322,330,338,346,354,362,370,378,386,394,402,410,418,426,434,442,450,458,466,474,482,490,498,506,514,522,530,538,546,554,562,570,578,586,594,602,610,618,626,634,642,650,658,666,674,682,690,698,706,714,722,730,738,746,754,762,770,778,786,794,802,810,818,826,834,842,850,858,866,874,882,890,898,906,914,922,930,938,946,954,962,970,978,986,994,1002,1010,1018,140,142,130,132,134,122,124,126,114,116,118,106,108,110,3,5,7,11,13,15,19,21,23,27,29,31,35,37,39,43,45,47,51,53,55,59,61,63,67,69,71,75,77,79,83,85,87,91,93,95,99,101,103,107,109,111,115,117,119,123,125,127,131,133,135,139,141,143,147,149,151,155,157,159,163,165,167,171,173,175,179,181,183,187,189,191,195,197,199,203,205,207,211,213,215,219,221,223,227,229,231,235,237,239,243,245,247,251,253,255,98,100,102,90,92,94,82,84,86,74,76,78,66,68,70,58,60,62,50,52,54,42,44,46,40,48,56,64,72,80,88,96,104,112,120,128,136,144,152,160,168,176,184,192,200,208,216,224,232,240,248,256,264,272,280,288,296,304,312,320,328,336,344,352,360,368,376,384,392,400,408,416,424,432,440,448,456,464,472,480,488,496,504,512,520,528,536,544,552,560,568,576,584,592,600,608,616,624,632,640,648,656,664,672,680,688,696,704,712,720,728,736,744,752,760,768,776,784,792,800,808,816,824,832,840,848,856,864,872,880,888,896,904,912,920,928,936,944,952,960,968,976,984,992,1000,1008,1016,32,34,36,38,24,26,28,30,1,9,17,25,33,41,49,57,65,73,81,89,97,105,113,121,129,137,145,153,161,169,177,185,193,201,209,217,225,233,241,249,16,18,20,22,8,10,12,14,0,2,4,6};
namespace ssdc {
using att::bf16x8; using att::s16x4; using att::f32x16; using att::lds_cptr; using att::vtr; using att::cvtpk; using att::crow;
constexpr int L_XS = 0, L_B = 65536, L_C = 81920, L_DT = 98304, L_CS = 100352, L_RED = 102400, L_ECS = 104448, L_RDT = 106496, LDS_NEED = 108544;
struct Args { const bf16* proj; const float* dtga; const float* dt_bias; const float* conv_state; const float* conv_w; const float* conv_b; const float* a_log; const float* dpar; const float* norm_g;
              bf16* states; float* decay; const bf16* hin; bf16* mix; int layer, pad; };
__device__ __forceinline__ void conv8(const Args& a, const bf16* pbase  , int s, int t, bool isS, int b, int col, const float (&w)[4][8], const float (&bias)[8], float (&y)[8]) {
#pragma unroll
    for (int e = 0; e < 8; ++e) y[e] = bias[e];
    if (!isS) {
        bf16x8 v[4];
#pragma unroll
        for (int j = 0; j < 4; ++j) v[j] = *(const bf16x8*)(pbase + (unsigned)(((t - 3 + j) >= 0 ? s + j : 3) * NPJ + col));
#pragma unroll
        for (int j = 0; j < 4; ++j) { const float m = (t - 3 + j) >= 0 ? 1.f : 0.f;
#pragma unroll
            for (int e = 0; e < 8; ++e) y[e] += (bf2f((bf16)v[j][e]) * m) * w[j][e]; }
#pragma unroll
        for (int e = 0; e < 8; ++e) y[e] = silu_f(y[e]);
        return; }
#pragma unroll
    for (int j = 0; j < 4; ++j) { const int tt = t - 3 + j; float u[8];
        if (tt >= 0) { const bf16x8 v = *(const bf16x8*)(pbase + (unsigned)((s + j) * NPJ + col));
#pragma unroll
            for (int e = 0; e < 8; ++e) u[e] = bf2f((bf16)v[e]); }
        else if (isS) { const float* cs = a.conv_state + ((size_t)(a.layer * DB + b) * 3 + (3 + tt)) * CONV_DIM + col;
#pragma unroll
            for (int e = 0; e < 8; ++e) u[e] = cs[e]; }
        else {
#pragma unroll
            for (int e = 0; e < 8; ++e) u[e] = 0.f; }
#pragma unroll
        for (int e = 0; e < 8; ++e) y[e] += u[e] * w[j][e]; }
#pragma unroll
    for (int e = 0; e < 8; ++e) y[e] = silu_f(y[e]);
}
__device__ __forceinline__ void conv8_load(const bf16* pbase, int s, int t, int col, bf16x8 (&v)[4]) {
#pragma unroll
    for (int j = 0; j < 4; ++j) v[j] = *(const bf16x8*)(pbase + (unsigned)(((t - 3 + j) >= 0 ? s + j : 3) * NPJ + col));
}
__device__ __forceinline__ void conv8_calc(const bf16x8 (&v)[4], int t, const float (&w)[4][8], const float (&bias)[8], float (&y)[8]) {
#pragma unroll
    for (int e = 0; e < 8; ++e) y[e] = bias[e];
#pragma unroll
    for (int j = 0; j < 4; ++j) { const float m = (t - 3 + j) >= 0 ? 1.f : 0.f;
#pragma unroll
        for (int e = 0; e < 8; ++e) y[e] += (bf2f((bf16)v[j][e]) * m) * w[j][e]; }
#pragma unroll
    for (int e = 0; e < 8; ++e) y[e] = silu_f(y[e]);
}
__device__ __forceinline__ void load_w8(const Args& a, int col, float (&w)[4][8], float (&bias)[8]) {
#pragma unroll
    for (int j = 0; j < 4; ++j)
#pragma unroll
        for (int e = 0; e < 8; ++e) w[j][e] = a.conv_w[(size_t)(a.layer * 4 + j) * CONV_DIM + col + e];
#pragma unroll
    for (int e = 0; e < 8; ++e) bias[e] = a.conv_b[(size_t)a.layer * CONV_DIM + col + e];
}
__device__ __forceinline__ u32x4 pack8(const float (&y)[8]) { u32x4 o; o.x = pk2(y[0], y[1]); o.y = pk2(y[2], y[3]); o.z = pk2(y[4], y[5]); o.w = pk2(y[6], y[7]); return o; }
template <bool PRE> __device__ __forceinline__ void stage_s(const Args& a, int chunk, int g, LAS unsigned char* shm, int tid_) {
    int tid = opaque_v(tid_);
    const bool isS = chunk >= SEQ / 64; const int b = isS ? chunk - SEQ / 64 : 0, row0 = chunk * 64, t0 = isS ? 0 : row0;
    LAS float* dtab = (LAS float*)(shm + L_DT); LAS float* cstab = (LAS float*)(shm + L_CS);
    const bf16* pbase = a.proj + ((long)row0 - 3) * NPJ + C_XBC;
    { const int s = tid >> 3, h8 = tid & 7; dtab[s * 8 + h8] = softplus_f(a.dtga[(size_t)(row0 + s) * 32 + g * 8 + h8] + a.dt_bias[a.layer * 16 + g * 8 + h8]); }
    __syncthreads();
    { const int w = __builtin_amdgcn_readfirstlane(tid >> 6), ln = tid & 63;
      const float A = -__expf(a.a_log[a.layer * 16 + g * 8 + w]); const float dtv = dtab[ln * 8 + w]; float v = dtv * A;
#pragma unroll
      for (int d = 1; d < 64; d <<= 1) { const float t2 = __builtin_bit_cast(float, __builtin_amdgcn_ds_bpermute(((ln - d) & 63) << 2, __builtin_bit_cast(int, v))); if (ln >= d) v += t2; }
      cstab[ln * 8 + w] = v;
      const float vend = __builtin_bit_cast(float, __builtin_amdgcn_readlane(__builtin_bit_cast(int, v), 63));
      ((LAS float*)(shm + L_ECS))[ln * 8 + w] = PRE ? dtv * __expf(vend - v) : __expf(v);
      ((LAS float*)(shm + L_RDT))[ln * 8 + w] = __builtin_amdgcn_rcpf(dtv); }
    __syncthreads();
    tid = opaque_v(tid);
    { const int cg = tid & 63, col = g * 512 + cg * 8, h8 = cg >> 3; float w[4][8], bias[8]; load_w8(a, col, w, bias);
      if (!isS) {
#pragma unroll 1
          for (int ib = 0; ib < 2; ++ib) { bf16x8 v[4][4];
#pragma unroll
              for (int i = 0; i < 4; ++i) { const int s = (tid >> 6) + 8 * (4 * ib + i); conv8_load(pbase, s, t0 + s, col, v[i]); }
#pragma unroll
              for (int i = 0; i < 4; ++i) { const int s = (tid >> 6) + 8 * (4 * ib + i); float y[8]; conv8_calc(v[i], t0 + s, w, bias, y);
                  const float f = PRE ? ((LAS float*)(shm + L_ECS))[s * 8 + h8] : dtab[s * 8 + h8];
#pragma unroll
                  for (int e = 0; e < 8; ++e) y[e] *= f;
                  *(LAS u32x4*)(shm + L_XS + h8 * 8192 + ((cg & 7) >> 2) * 4096 + s * 64 + (cg & 3) * 16) = pack8(y); } } }
      else {
#pragma unroll 2
      for (int i = 0; i < 8; ++i) { const int s = (tid >> 6) + 8 * i; float y[8]; conv8(a, pbase, s, t0 + s, isS, b, col, w, bias, y);
          const float f = PRE ? ((LAS float*)(shm + L_ECS))[s * 8 + h8] : dtab[s * 8 + h8];
#pragma unroll
          for (int e = 0; e < 8; ++e) y[e] *= f;
          *(LAS u32x4*)(shm + L_XS + h8 * 8192 + ((cg & 7) >> 2) * 4096 + s * 64 + (cg & 3) * 16) = pack8(y); } } }
    tid = opaque_v(tid);
    { const int cg = tid & 15, colB = 1024 + g * 128 + cg * 8; float w[4][8], bias[8]; load_w8(a, colB, w, bias);
#pragma unroll
      for (int i = 0; i < 2; ++i) { const int s = (tid >> 4) + 32 * i; float y[8]; conv8(a, pbase, s, t0 + s, isS, b, colB, w, bias, y);
          if (PRE) *(LAS u32x4*)(shm + L_B + (cg >> 2) * 4096 + s * 64 + (cg & 3) * 16) = pack8(y);
          else     *(LAS u32x4*)(shm + L_B + cg * 1024 + s * 16) = pack8(y); } }
    tid = opaque_v(tid);
    if (!PRE) { const int cg = tid & 15, colC = 1280 + g * 128 + cg * 8; float w[4][8], bias[8]; load_w8(a, colC, w, bias);
#pragma unroll
      for (int i = 0; i < 2; ++i) { const int s = (tid >> 4) + 32 * i; float y[8]; conv8(a, pbase, s, t0 + s, isS, b, colC, w, bias, y);
          *(LAS u32x4*)(shm + L_C + cg * 1024 + s * 16) = pack8(y); } }
    __syncthreads();
}
template <bool PRE> __device__ __forceinline__ void stage_p(const Args& a, int chunk, int g, LAS unsigned char* shm, int tid_) {
    const int tid = opaque_v(tid_); const int row0 = chunk * 64, t0 = row0;
    LAS float* dtab = (LAS float*)(shm + L_DT); LAS float* cstab = (LAS float*)(shm + L_CS);
    const bf16* pbase = a.proj + ((long)row0 - 3) * NPJ + C_XBC;
    const float dt_raw = a.dtga[(size_t)(row0 + (tid >> 3)) * 32 + g * 8 + (tid & 7)], dt_b = a.dt_bias[a.layer * 16 + g * 8 + (tid & 7)];
    const float a_l = a.a_log[a.layer * 16 + g * 8 + __builtin_amdgcn_readfirstlane(tid >> 6)];
    const int cgx = tid & 63, colx = g * 512 + cgx * 8, h8 = cgx >> 3, wv = tid >> 6; float wx[4][8], bx[8]; load_w8(a, colx, wx, bx);
    bf16x8 vx[4][4];
#pragma unroll
    for (int i = 0; i < 4; ++i) { const int s = wv + 8 * i; conv8_load(pbase, s, t0 + s, colx, vx[i]); }
    const int cgb = tid & 15, colB = 1024 + g * 128 + cgb * 8, sb0 = tid >> 4; float wB[4][8], bB[8]; load_w8(a, colB, wB, bB);
    bf16x8 vB[2][4];
#pragma unroll
    for (int i = 0; i < 2; ++i) { const int s = sb0 + 32 * i; conv8_load(pbase, s, t0 + s, colB, vB[i]); }
    { const int s = tid >> 3, hh = tid & 7; dtab[s * 8 + hh] = softplus_f(dt_raw + dt_b); }
    lds_barrier();
    { const int w = __builtin_amdgcn_readfirstlane(tid >> 6), ln = tid & 63;
      const float A = -__expf(a_l); const float dtv = dtab[ln * 8 + w]; float v = dtv * A;
#pragma unroll
      for (int d = 1; d < 64; d <<= 1) { const float t2 = __builtin_bit_cast(float, __builtin_amdgcn_ds_bpermute(((ln - d) & 63) << 2, __builtin_bit_cast(int, v))); if (ln >= d) v += t2; }
      cstab[ln * 8 + w] = v;
      const float vend = __builtin_bit_cast(float, __builtin_amdgcn_readlane(__builtin_bit_cast(int, v), 63));
      ((LAS float*)(shm + L_ECS))[ln * 8 + w] = PRE ? dtv * __expf(vend - v) : __expf(v);
      ((LAS float*)(shm + L_RDT))[ln * 8 + w] = __builtin_amdgcn_rcpf(dtv); }
    lds_barrier();
#pragma unroll
    for (int i = 0; i < 4; ++i) { const int s = wv + 8 * i; float y[8]; conv8_calc(vx[i], t0 + s, wx, bx, y);
        const float f = PRE ? ((LAS float*)(shm + L_ECS))[s * 8 + h8] : dtab[s * 8 + h8];
#pragma unroll
        for (int e = 0; e < 8; ++e) y[e] *= f;
        *(LAS u32x4*)(shm + L_XS + h8 * 8192 + ((cgx & 7) >> 2) * 4096 + s * 64 + (cgx & 3) * 16) = pack8(y); }
#pragma unroll
    for (int i = 0; i < 4; ++i) { const int s = wv + 8 * (4 + i); conv8_load(pbase, s, t0 + s, colx, vx[i]); }
#pragma unroll
    for (int i = 0; i < 2; ++i) { const int s = sb0 + 32 * i; float y[8]; conv8_calc(vB[i], t0 + s, wB, bB, y);
        if (PRE) *(LAS u32x4*)(shm + L_B + (cgb >> 2) * 4096 + s * 64 + (cgb & 3) * 16) = pack8(y);
        else     *(LAS u32x4*)(shm + L_B + cgb * 1024 + s * 16) = pack8(y); }
    if (!PRE) { const int colC = 1280 + g * 128 + cgb * 8; load_w8(a, colC, wB, bB);
#pragma unroll
        for (int i = 0; i < 2; ++i) { const int s = sb0 + 32 * i; conv8_load(pbase, s, t0 + s, colC, vB[i]); } }
#pragma unroll
    for (int i = 0; i < 4; ++i) { const int s = wv + 8 * (4 + i); float y[8]; conv8_calc(vx[i], t0 + s, wx, bx, y);
        const float f = PRE ? ((LAS float*)(shm + L_ECS))[s * 8 + h8] : dtab[s * 8 + h8];
#pragma unroll
        for (int e = 0; e < 8; ++e) y[e] *= f;
        *(LAS u32x4*)(shm + L_XS + h8 * 8192 + ((cgx & 7) >> 2) * 4096 + s * 64 + (cgx & 3) * 16) = pack8(y); }
    if (!PRE) {
#pragma unroll
        for (int i = 0; i < 2; ++i) { const int s = sb0 + 32 * i; float y[8]; conv8_calc(vB[i], t0 + s, wB, bB, y);
            *(LAS u32x4*)(shm + L_C + cgb * 1024 + s * 16) = pack8(y); } }
    lds_barrier();
}
template <bool PRE> __device__ __forceinline__ void stage(const Args& a, int chunk, int g, LAS unsigned char* shm, int tid_) {
    if (PRE && chunk < SEQ / 64) stage_p<PRE>(a, chunk, g, shm, tid_); else stage_s<PRE>(a, chunk, g, shm, tid_);
}
__device__ __forceinline__ bf16x8 trfrag_nat(lds_cptr blk, int ks, int lane) {
    const int hi = lane >> 5; lds_cptr p = blk + (16 * ks + 8 * hi + ((lane & 15) >> 2)) * 64 + ((lane >> 4) & 1) * 32 + (lane & 3) * 8;
    const s16x4 lo = vtr(p), hh = vtr(p + 256); return (bf16x8){lo[0], lo[1], lo[2], lo[3], hh[0], hh[1], hh[2], hh[3]};
}
__device__ __forceinline__ bf16x8 trfrag_acc(lds_cptr blk, int ks, int lane) {
    const int hi = lane >> 5; lds_cptr p = blk + (16 * ks + 4 * hi + ((lane & 15) >> 2)) * 64 + ((lane >> 4) & 1) * 32 + (lane & 3) * 8;
    const s16x4 lo = vtr(p), hh = vtr(p + 512); return (bf16x8){lo[0], lo[1], lo[2], lo[3], hh[0], hh[1], hh[2], hh[3]};
}
__device__ __forceinline__ void pre_unit(const Args& a, int chunk, int g, LAS unsigned char* shm, int tid_) {
    stage<true>(a, chunk, g, shm, tid_);
    const int tid = opaque_v(tid_);
    const int lane = tid & 63, r32 = lane & 31, hi = lane >> 5, wid = __builtin_amdgcn_readfirstlane(tid >> 6), h = g * 8 + wid;
    const lds_cptr shm3 = (lds_cptr)shm; const lds_cptr xs = shm3 + L_XS + wid * 8192, bi = shm3 + L_B;
    bf16x8 af[2][4];
#pragma unroll
    for (int pb = 0; pb < 2; ++pb)
#pragma unroll
        for (int ks = 0; ks < 4; ++ks) af[pb][ks] = trfrag_nat(xs + pb * 4096, ks, lane);
    bf16* st = a.states + ((size_t)(chunk * 16 + h) * 64) * 128;
#pragma unroll
    for (int nb = 0; nb < 4; ++nb) { bf16x8 bfr[4];
#pragma unroll
        for (int ks = 0; ks < 4; ++ks) bfr[ks] = trfrag_nat(bi + nb * 4096, ks, lane);
#pragma unroll
        for (int pb = 0; pb < 2; ++pb) { f32x16 acc = {0.f, 0.f, 0.f, 0.f, 0.f, 0.f, 0.f, 0.f, 0.f, 0.f, 0.f, 0.f, 0.f, 0.f, 0.f, 0.f};
#pragma unroll
            for (int ks = 0; ks < 4; ++ks) acc = ATT_MFMA(bfr[ks], af[pb][ks], acc);
            bf16* sp = st + (unsigned)((32 * pb + r32) * 128 + 32 * nb + 4 * hi);
#pragma unroll
            for (int q = 0; q < 4; ++q) { u32x2 w; w.x = cvtpk(acc[4 * q], acc[4 * q + 1]); w.y = cvtpk(acc[4 * q + 2], acc[4 * q + 3]); *(u32x2*)(sp + 8 * q) = w; } } }
    if (tid < 8) a.decay[chunk * 16 + g * 8 + tid] = __expf(((LAS float*)(shm + L_CS))[63 * 8 + tid]);
    lds_barrier();
}
__device__ __forceinline__ void post_unit(const Args& a, int chunk, int g, LAS unsigned char* shm, int tid_) {
    bf16x8 hf[2][8];
    { const int tq = opaque_v(tid_), lq = tq & 63, wq = __builtin_amdgcn_readfirstlane(tq >> 6); const bf16* hq = a.hin + ((size_t)(chunk * 16 + g * 8 + wq) * 64) * 128;
#pragma unroll
      for (int dq = 0; dq < 2; ++dq)
#pragma unroll
          for (int d0 = 0; d0 < 8; ++d0) hf[dq][d0] = *(const bf16x8*)(hq + (unsigned)((32 * dq + (lq & 31)) * 128 + 16 * d0 + 8 * (lq >> 5))); }
    stage<false>(a, chunk, g, shm, tid_);
    const int tid = opaque_v(tid_);
    const int lane0 = tid & 63, wid = __builtin_amdgcn_readfirstlane(tid >> 6), h = g * 8 + wid, row0 = chunk * 64;
    bf16x8 zv[8];
    { const bf16* zb = a.proj + (size_t)row0 * NPJ + C_Z + g * 512 + lane0 * 8;
#pragma unroll
      for (int i = 0; i < 8; ++i) zv[i] = *(const bf16x8*)(zb + (unsigned)((wid * 8 + i) * NPJ)); }
    const lds_cptr shm3 = (lds_cptr)shm; const lds_cptr xs = shm3 + L_XS + wid * 8192;
    const LAS float* cstab = (const LAS float*)(shm + L_CS); const LAS float* ecs = (const LAS float*)(shm + L_ECS); const LAS float* rdt = (const LAS float*)(shm + L_RDT);
    const float Dh = a.dpar[a.layer * 16 + h];
#pragma unroll 1
    for (int qb = 1; qb >= 0; --qb) {
        const int lane = opaque_v(lane0), r32 = lane & 31, hi = lane >> 5;
        bf16x8 qr[8];
#pragma unroll
        for (int d0 = 0; d0 < 8; ++d0) qr[d0] = *(const LAS bf16x8*)(shm + L_C + (2 * d0 + hi) * 1024 + (32 * qb + r32) * 16);
        f32x16 o[2];
#pragma unroll
        for (int dq = 0; dq < 2; ++dq) o[dq] = (f32x16){0.f, 0.f, 0.f, 0.f, 0.f, 0.f, 0.f, 0.f, 0.f, 0.f, 0.f, 0.f, 0.f, 0.f, 0.f, 0.f};
        const float cs_t = cstab[(32 * qb + r32) * 8 + wid], dd_t = Dh * rdt[(32 * qb + r32) * 8 + wid];
#pragma unroll 1
        for (int sb = 0; sb <= qb; ++sb) {
            f32x16 x = {0.f, 0.f, 0.f, 0.f, 0.f, 0.f, 0.f, 0.f, 0.f, 0.f, 0.f, 0.f, 0.f, 0.f, 0.f, 0.f};
#pragma unroll
            for (int d0 = 0; d0 < 8; ++d0) { const bf16x8 kf = *(const LAS bf16x8*)(shm + L_B + (2 * d0 + hi) * 1024 + (32 * sb + r32) * 16); x = ATT_MFMA(kf, qr[d0], x); }
#pragma unroll
            for (int r = 0; r < 16; ++r) { const int s = 32 * sb + crow(r, hi), t = 32 * qb + r32;
                x[r] = (s < t) ? x[r] * __expf(cs_t - cstab[s * 8 + wid]) : (s == t ? x[r] + dd_t : 0.f); }
            typedef unsigned u4 __attribute__((ext_vector_type(4)));
            const u4 w0 = {cvtpk(x[0], x[1]), cvtpk(x[2], x[3]), cvtpk(x[4], x[5]), cvtpk(x[6], x[7])}, w1 = {cvtpk(x[8], x[9]), cvtpk(x[10], x[11]), cvtpk(x[12], x[13]), cvtpk(x[14], x[15])};
            const bf16x8 pa0 = __builtin_bit_cast(bf16x8, w0), pa1 = __builtin_bit_cast(bf16x8, w1);
#pragma unroll
            for (int dq = 0; dq < 2; ++dq) { o[dq] = ATT_MFMA(pa0, trfrag_acc(xs + dq * 4096, 2 * sb, lane), o[dq]); o[dq] = ATT_MFMA(pa1, trfrag_acc(xs + dq * 4096, 2 * sb + 1, lane), o[dq]); }
        }
        const LAS float* ecs_l = ecs + (32 * qb + 4 * hi) * 8 + wid;
#pragma unroll
        for (int dq = 0; dq < 2; ++dq) { f32x16 acc = {0.f, 0.f, 0.f, 0.f, 0.f, 0.f, 0.f, 0.f, 0.f, 0.f, 0.f, 0.f, 0.f, 0.f, 0.f, 0.f};
#pragma unroll
            for (int d0 = 0; d0 < 8; ++d0) acc = ATT_MFMA(qr[d0], hf[dq][d0], acc);
            asm volatile("s_waitcnt lgkmcnt(0)" ::: "memory");
            LAS bf16* yw = (LAS bf16*)(shm + L_XS + wid * 8192 + dq * 4096 + (32 * qb + 4 * hi) * 64 + r32 * 2);
#pragma unroll
            for (int r = 0; r < 16; ++r) { const int tc = (r & 3) + 8 * (r >> 2); yw[tc * 32] = (bf16)f2bf(o[dq][r] + ecs_l[tc * 8] * acc[r]); } }
    }
    __syncthreads();
    { const int lane = opaque_v(lane0), h8 = lane >> 3; float gn[8];
      { const f32x4 g0 = *(const f32x4*)(a.norm_g + a.layer * 1024 + g * 512 + lane * 8), g1 = *(const f32x4*)(a.norm_g + a.layer * 1024 + g * 512 + lane * 8 + 4);
        gn[0] = g0.x; gn[1] = g0.y; gn[2] = g0.z; gn[3] = g0.w; gn[4] = g1.x; gn[5] = g1.y; gn[6] = g1.z; gn[7] = g1.w; }
      bf16* mb = a.mix + (size_t)row0 * DM + g * 512 + lane * 8;
      const LAS unsigned char* yb = shm + L_XS + h8 * 8192 + ((lane & 7) >> 2) * 4096 + (lane & 3) * 16;
#pragma unroll
      for (int i = 0; i < 8; ++i) { const int t = wid * 8 + i;
          const bf16x8 yv = *(const LAS bf16x8*)(yb + t * 64); float v[8], ss = 0.f;
#pragma unroll
          for (int e = 0; e < 8; ++e) { v[e] = bf2f((bf16)yv[e]) * silu_f(bf2f((bf16)zv[i][e])); ss += v[e] * v[e]; }
          const float rn = __builtin_amdgcn_rsqf(wave_sum(ss) * (1.f / 512.f) + EPS);
          u32x4 o; o.x = pk2(v[0] * rn * gn[0], v[1] * rn * gn[1]); o.y = pk2(v[2] * rn * gn[2], v[3] * rn * gn[3]); o.z = pk2(v[4] * rn * gn[4], v[5] * rn * gn[5]); o.w = pk2(v[6] * rn * gn[6], v[7] * rn * gn[7]);
          *(u32x4*)(mb + (unsigned)(t * DM)) = o; } }
    lds_barrier();
}
struct ScanArgs { const bf16* states; const float* decay; const float* state_in; bf16* hin; float* out; int layer, pad; };
__device__ __forceinline__ f32x4 ld_bf4(const bf16* p) { const u32x2 w = *(const u32x2*)p; return (f32x4){__builtin_bit_cast(float, w.x << 16), __builtin_bit_cast(float, w.x & 0xffff0000u), __builtin_bit_cast(float, w.y << 16), __builtin_bit_cast(float, w.y & 0xffff0000u)}; }
__device__ __forceinline__ f32x4 bf4_to_f32(const u32x2 w) { return (f32x4){__builtin_bit_cast(float, w.x << 16), __builtin_bit_cast(float, w.x & 0xffff0000u), __builtin_bit_cast(float, w.y << 16), __builtin_bit_cast(float, w.y & 0xffff0000u)}; }
__device__ __forceinline__ void scan_prompt(const ScanArgs& a, int e4) {
    const int h = e4 >> 11; f32x4 hv = {0.f, 0.f, 0.f, 0.f};
#pragma unroll 1
    for (int c0 = 0; c0 < SEQ / 64; c0 += 16) { u32x2 sr[16]; float dv[16];
#pragma unroll
        for (int j = 0; j < 16; ++j) { sr[j] = *(const u32x2*)(a.states + (size_t)(c0 + j) * 131072 + e4 * 4); dv[j] = a.decay[(c0 + j) * 16 + h]; }
#pragma unroll
        for (int j = 0; j < 16; ++j) { u32x2 o; o.x = pk2(hv.x, hv.y); o.y = pk2(hv.z, hv.w); *(u32x2*)(a.hin + (size_t)(c0 + j) * 131072 + e4 * 4) = o;
            hv = hv * dv[j] + bf4_to_f32(sr[j]); } }
    *(f32x4*)(a.out + O_HP + (size_t)a.layer * 131072 + e4 * 4) = hv;
}
__device__ __forceinline__ void scan_sample8(const ScanArgs& a, int b0, int e4) {
    const int h = e4 >> 11; f32x4 h0[8]; u32x2 sr[8]; float dv[8];
#pragma unroll
    for (int j = 0; j < 8; ++j) { const int b = b0 + j, c = SEQ / 64 + b; h0[j] = *(const f32x4*)(a.state_in + (size_t)(a.layer * DB + b) * 131072 + e4 * 4);
        sr[j] = *(const u32x2*)(a.states + (size_t)c * 131072 + e4 * 4); dv[j] = a.decay[c * 16 + h]; }
#pragma unroll
    for (int j = 0; j < 8; ++j) { const int b = b0 + j, c = SEQ / 64 + b;
        u32x2 o; o.x = pk2(h0[j].x, h0[j].y); o.y = pk2(h0[j].z, h0[j].w); *(u32x2*)(a.hin + (size_t)c * 131072 + e4 * 4) = o;
        *(f32x4*)(a.out + O_HS + (size_t)(a.layer * DB + b) * 131072 + e4 * 4) = h0[j] * dv[j] + bf4_to_f32(sr[j]); }
}
}
namespace glac {
using att::bf16x8; using att::f32x16; using att::lds_cptr; using att::cvtpk; using att::crow; using ssdc::trfrag_nat; using ssdc::trfrag_acc; using ssdc::pack8;
constexpr int L_B = 0, L_QT = 16384, L_KT = 24576, L_V = 32768, L_RED = 49152, LDS_NEED = 51200;
struct Args { const bf16* proj; const float* dtga; const float* wa2; const float* ba; const float* norm_g; float* btab; bf16* states; float* decay; const bf16* hin; bf16* mix; int layer, pad; };
__device__ __forceinline__ void btable(const Args& a, int row0, int h, LAS unsigned char* shm, int tid) {
    LAS float* bt = (LAS float*)(shm + L_B); LAS float* gs = (LAS float*)(shm + L_RED);
    const int tg = __builtin_amdgcn_readfirstlane(tid >> 6), k = tid & 63;
    float w[16];
#pragma unroll
    for (int r = 0; r < 16; ++r) w[r] = a.wa2[(size_t)(a.layer * 16 + r) * 256 + h * 64 + k];
    const float bias = a.ba[a.layer * 256 + h * 64 + k]; const float* ga = a.dtga + (size_t)(row0 + 8 * tg) * 32 + 16; float acc = 0.f;
#pragma unroll
    for (int j = 0; j < 8; ++j) { float x = bias;
#pragma unroll
        for (int r = 0; r < 16; ++r) x += ga[j * 32 + r] * w[r];
        acc += logsigmoid_f(x) * (1.f / 16.f); bt[(8 * tg + j) * 64 + k] = acc; }
    gs[tg * 64 + k] = acc;
    lds_barrier();
    float off = 0.f;
    for (int g2 = 0; g2 < tg; ++g2) off += gs[g2 * 64 + k];
#pragma unroll
    for (int j = 0; j < 8; ++j) bt[(8 * tg + j) * 64 + k] += off;
    lds_barrier();
}
__device__ __forceinline__ void stage_v(const Args& a, int row0, int h, LAS unsigned char* shm, int tid) {
    const bf16* vb = a.proj + (size_t)row0 * NPJ + C_GV + h * 128;
#pragma unroll
    for (int i = 0; i < 2; ++i) { const int it = tid + 512 * i, s = it >> 4, vg = it & 15;
        *(LAS u32x4*)(shm + L_V + (vg >> 2) * 4096 + s * 64 + (vg & 3) * 16) = *(const u32x4*)(vb + (unsigned)(s * NPJ + vg * 8)); }
}
__device__ __forceinline__ void pre_unit(const Args& a, int chunk, int h, LAS unsigned char* shm, int tid_) {
    const int tid = opaque_v(tid_), row0 = chunk * 64;
    const bf16x8 kv = *(const bf16x8*)(a.proj + (size_t)row0 * NPJ + C_GK + h * 64 + (unsigned)((tid >> 3) * NPJ + (tid & 7) * 8)); u32x4 vv[2];
    { const bf16* vbp = a.proj + (size_t)row0 * NPJ + C_GV + h * 128;
#pragma unroll
      for (int i = 0; i < 2; ++i) { const int it = tid + 512 * i, s = it >> 4, vg = it & 15; vv[i] = *(const u32x4*)(vbp + (unsigned)(s * NPJ + vg * 8)); } }
    btable(a, row0, h, shm, tid);
    const LAS float* bt = (const LAS float*)(shm + L_B);
    { float* bg = a.btab + (size_t)row0 * 256 + h * 64;
#pragma unroll
      for (int i = 0; i < 2; ++i) { const int it = tid + 512 * i, s = it >> 4, c4 = (it & 15) * 4; *(f32x4*)(bg + (unsigned)(s * 256 + c4)) = *(const LAS f32x4*)(bt + s * 64 + c4); } }
    { const int s = tid >> 3, kg = tid & 7; float y[8];
#pragma unroll
      for (int e = 0; e < 8; ++e) y[e] = bf2f((bf16)kv[e]) * __expf(bt[63 * 64 + kg * 8 + e] - bt[s * 64 + kg * 8 + e]);
      *(LAS u32x4*)(shm + L_QT + (kg >> 2) * 4096 + s * 64 + (kg & 3) * 16) = pack8(y); }
#pragma unroll
    for (int i = 0; i < 2; ++i) { const int it = tid + 512 * i, s = it >> 4, vg = it & 15; *(LAS u32x4*)(shm + L_V + (vg >> 2) * 4096 + s * 64 + (vg & 3) * 16) = vv[i]; }
    lds_barrier();
    const int lane = tid & 63, r32 = lane & 31, hi = lane >> 5, wid = __builtin_amdgcn_readfirstlane(tid >> 6), kb = wid & 1, vb = wid >> 1;
    const lds_cptr shm3 = (lds_cptr)shm;
    f32x16 acc = {0.f, 0.f, 0.f, 0.f, 0.f, 0.f, 0.f, 0.f, 0.f, 0.f, 0.f, 0.f, 0.f, 0.f, 0.f, 0.f};
#pragma unroll
    for (int ks = 0; ks < 4; ++ks) acc = ATT_MFMA(trfrag_nat(shm3 + L_QT + kb * 4096, ks, lane), trfrag_nat(shm3 + L_V + vb * 4096, ks, lane), acc);
    bf16* st = a.states + ((size_t)(chunk * 4 + h) * 128 + 32 * vb + r32) * 64 + 32 * kb + 4 * hi;
#pragma unroll
    for (int q = 0; q < 4; ++q) { u32x2 w; w.x = cvtpk(acc[4 * q], acc[4 * q + 1]); w.y = cvtpk(acc[4 * q + 2], acc[4 * q + 3]); *(u32x2*)(st + 8 * q) = w; }
    if (tid < 64) a.decay[(chunk * 4 + h) * 64 + tid] = __expf(bt[63 * 64 + tid]);
    lds_barrier();
}
__device__ __forceinline__ void post_unit(const Args& a, int chunk, int h, LAS unsigned char* shm, int tid_) {
    const int tid = opaque_v(tid_), row0 = chunk * 64;
    const int lane = tid & 63, r32 = lane & 31, hi = lane >> 5, wid = __builtin_amdgcn_readfirstlane(tid >> 6), tb = wid & 1, vb = wid >> 1, rs = lane >> 4, cg = lane & 15;
    const LAS float* bt = (const LAS float*)(shm + L_B);
    f32x4 btv[2]; u32x4 vv[2]; bf16x8 hf[4], gv[2];
    { const float* bg = a.btab + (size_t)row0 * 256 + h * 64;
#pragma unroll
      for (int i = 0; i < 2; ++i) { const int it = tid + 512 * i, s = it >> 4, c4 = (it & 15) * 4; btv[i] = *(const f32x4*)(bg + (unsigned)(s * 256 + c4)); } }
    const bf16* pr = a.proj + (size_t)row0 * NPJ + h * 64;
    const bf16x8 qv = *(const bf16x8*)(pr + (unsigned)((tid >> 3) * NPJ + C_GQ + (tid & 7) * 8)), kv = *(const bf16x8*)(pr + (unsigned)((tid >> 3) * NPJ + C_GK + (tid & 7) * 8));
    { const bf16* vbp = a.proj + (size_t)row0 * NPJ + C_GV + h * 128;
#pragma unroll
      for (int i = 0; i < 2; ++i) { const int it = tid + 512 * i, s = it >> 4, vg = it & 15; vv[i] = *(const u32x4*)(vbp + (unsigned)(s * NPJ + vg * 8)); } }
    { const bf16* hin = a.hin + ((size_t)(chunk * 4 + h) * 128 + 32 * vb + r32) * 64 + 8 * hi;
#pragma unroll
      for (int d0 = 0; d0 < 4; ++d0) hf[d0] = *(const bf16x8*)(hin + 16 * d0); }
#pragma unroll
    for (int i = 0; i < 2; ++i) gv[i] = *(const bf16x8*)(a.proj + (size_t)(row0 + wid * 8 + i * 4 + rs) * NPJ + C_GG + h * 128 + cg * 8);
    const f32x4 g0 = *(const f32x4*)(a.norm_g + a.layer * 128 + cg * 8), g1 = *(const f32x4*)(a.norm_g + a.layer * 128 + cg * 8 + 4);
#pragma unroll
    for (int i = 0; i < 2; ++i) { const int it = tid + 512 * i, s = it >> 4, c4 = (it & 15) * 4; *(LAS f32x4*)((LAS float*)(shm + L_B) + s * 64 + c4) = btv[i]; }
    lds_barrier();
    { const int s = tid >> 3, kg = tid & 7; float yq[8], yk[8];
#pragma unroll
      for (int e = 0; e < 8; ++e) { const float bb = bt[s * 64 + kg * 8 + e]; yq[e] = bf2f((bf16)qv[e]) * 0.125f * __expf(bb); yk[e] = bf2f((bf16)kv[e]) * __expf(-bb); }
      *(LAS u32x4*)(shm + L_QT + kg * 1024 + s * 16) = pack8(yq); *(LAS u32x4*)(shm + L_KT + kg * 1024 + s * 16) = pack8(yk); }
#pragma unroll
    for (int i = 0; i < 2; ++i) { const int it = tid + 512 * i, s = it >> 4, vg = it & 15; *(LAS u32x4*)(shm + L_V + (vg >> 2) * 4096 + s * 64 + (vg & 3) * 16) = vv[i]; }
    lds_barrier();
    const lds_cptr shm3 = (lds_cptr)shm;
    bf16x8 qr[4];
#pragma unroll
    for (int d0 = 0; d0 < 4; ++d0) qr[d0] = *(const LAS bf16x8*)(shm + L_QT + (2 * d0 + hi) * 1024 + (32 * tb + r32) * 16);
    f32x16 o = {0.f, 0.f, 0.f, 0.f, 0.f, 0.f, 0.f, 0.f, 0.f, 0.f, 0.f, 0.f, 0.f, 0.f, 0.f, 0.f};
#pragma unroll
    for (int d0 = 0; d0 < 4; ++d0) o = ATT_MFMA(qr[d0], hf[d0], o);
#pragma unroll 1
    for (int sb = 0; sb <= tb; ++sb) {
        f32x16 x = {0.f, 0.f, 0.f, 0.f, 0.f, 0.f, 0.f, 0.f, 0.f, 0.f, 0.f, 0.f, 0.f, 0.f, 0.f, 0.f};
#pragma unroll
        for (int d0 = 0; d0 < 4; ++d0) x = ATT_MFMA(*(const LAS bf16x8*)(shm + L_KT + (2 * d0 + hi) * 1024 + (32 * sb + r32) * 16), qr[d0], x);
#pragma unroll
        for (int r = 0; r < 16; ++r) { const int s = 32 * sb + crow(r, hi), t = 32 * tb + r32; x[r] = (s <= t) ? x[r] : 0.f; }
        typedef unsigned u4 __attribute__((ext_vector_type(4)));
        const u4 w0 = {cvtpk(x[0], x[1]), cvtpk(x[2], x[3]), cvtpk(x[4], x[5]), cvtpk(x[6], x[7])}, w1 = {cvtpk(x[8], x[9]), cvtpk(x[10], x[11]), cvtpk(x[12], x[13]), cvtpk(x[14], x[15])};
        o = ATT_MFMA(__builtin_bit_cast(bf16x8, w0), trfrag_acc(shm3 + L_V + vb * 4096, 2 * sb, lane), o);
        o = ATT_MFMA(__builtin_bit_cast(bf16x8, w1), trfrag_acc(shm3 + L_V + vb * 4096, 2 * sb + 1, lane), o);
    }
    lds_barrier();
    { LAS float* ot = (LAS float*)shm + (32 * tb + 4 * hi) * 128 + 32 * vb + r32;
#pragma unroll
      for (int r = 0; r < 16; ++r) ot[((r & 3) + 8 * (r >> 2)) * 128] = o[r]; }
    lds_barrier();
    { const float gn[8] = {g0.x, g0.y, g0.z, g0.w, g1.x, g1.y, g1.z, g1.w};
#pragma unroll
      for (int i = 0; i < 2; ++i) { const int t = wid * 8 + i * 4 + rs;
          const f32x4 a0 = *(const LAS f32x4*)((LAS float*)shm + t * 128 + cg * 8), a1 = *(const LAS f32x4*)((LAS float*)shm + t * 128 + cg * 8 + 4);
          float v[8] = {a0.x, a0.y, a0.z, a0.w, a1.x, a1.y, a1.z, a1.w}; float ss = 0.f;
#pragma unroll
          for (int e = 0; e < 8; ++e) ss += v[e] * v[e];
          ss += dpp_xor1(ss); ss += dpp_xor2(ss); ss += swz_xor4(ss); ss += swz_xor8(ss);
          const float rn = __builtin_amdgcn_rsqf(ss * (1.f / 128.f) + EPS);
#pragma unroll
          for (int e = 0; e < 8; ++e) v[e] = v[e] * rn * gn[e] * silu_f(bf2f((bf16)gv[i][e]));
          *(u32x4*)(a.mix + (size_t)(row0 + t) * DM + 1536 + h * 128 + cg * 8) = pack8(v); } }
    lds_barrier();
}
struct ScanArgs { const bf16* states; const float* decay; const float* state_in; bf16* hin; float* out; int layer, pad; };
__device__ __forceinline__ void scan_prompt(const ScanArgs& a, int e4) {
    const int h = e4 >> 11, k = (e4 * 4) & 63, v = (e4 >> 4) & 127; f32x4 sv = {0.f, 0.f, 0.f, 0.f};
#pragma unroll 1
    for (int c0 = 0; c0 < SEQ / 64; c0 += 8) { u32x2 sr[8]; f32x4 dv[8];
#pragma unroll
        for (int j = 0; j < 8; ++j) { sr[j] = *(const u32x2*)(a.states + (size_t)(c0 + j) * 32768 + e4 * 4); dv[j] = *(const f32x4*)(a.decay + ((c0 + j) * 4 + h) * 64 + k); }
#pragma unroll
        for (int j = 0; j < 8; ++j) { u32x2 o; o.x = pk2(sv.x, sv.y); o.y = pk2(sv.z, sv.w); *(u32x2*)(a.hin + (size_t)(c0 + j) * 32768 + e4 * 4) = o;
            sv = sv * dv[j] + ssdc::bf4_to_f32(sr[j]); } }
    float* op = a.out + O_SP + ((size_t)(a.layer * 4 + h) * 64 + k) * 128 + v; op[0] = sv.x; op[128] = sv.y; op[256] = sv.z; op[384] = sv.w;
}
__device__ __forceinline__ void scan_sample8(const ScanArgs& a, int b0, int e4) {
    const int h = e4 >> 11, k = (e4 * 4) & 63, v = (e4 >> 4) & 127; f32x4 s0[8], dv[8]; u32x2 sr[8];
#pragma unroll
    for (int j = 0; j < 8; ++j) { const int b = b0 + j, c = SEQ / 64 + b; const float* ip = a.state_in + ((size_t)((a.layer * DB + b) * 4 + h) * 64 + k) * 128 + v; s0[j] = (f32x4){ip[0], ip[128], ip[256], ip[384]};
        sr[j] = *(const u32x2*)(a.states + (size_t)c * 32768 + e4 * 4); dv[j] = *(const f32x4*)(a.decay + (c * 4 + h) * 64 + k); }
#pragma unroll
    for (int j = 0; j < 8; ++j) { const int b = b0 + j, c = SEQ / 64 + b;
        u32x2 o; o.x = pk2(s0[j].x, s0[j].y); o.y = pk2(s0[j].z, s0[j].w); *(u32x2*)(a.hin + (size_t)c * 32768 + e4 * 4) = o;
        const f32x4 sv = s0[j] * dv[j] + ssdc::bf4_to_f32(sr[j]);
        float* op = a.out + O_SS + ((size_t)((a.layer * DB + b) * 4 + h) * 64 + k) * 128 + v; op[0] = sv.x; op[128] = sv.y; op[256] = sv.z; op[384] = sv.w; }
}
}
__device__ __forceinline__ int win_orig_col(int n) {
    if (n < 2560) return n;
    if (n < 5120) return n + 16;
    if (n < 5632) return n + 32;
    if (n < 5648) return 2560 + (n - 5632);
    if (n < 5664) return 5136 + (n - 5648);
    return -1;
}
__device__ __forceinline__ void tw_load(const float* __restrict__ W, const float* __restrict__ gk, int N, int nblk, int mode, int item, int lane, f32x4 (&v)[8]) {
    const int kb = item / nblk, nb = item % nblk, k0 = 64 * kb, n0 = 32 * nb + (lane & 7) * 4; const int oc = mode ? win_orig_col(n0) : n0;
#pragma unroll
    for (int i = 0; i < 8; ++i) { const int kk = k0 + 8 * i + (lane >> 3);
        if (oc >= 0) { const f32x4 w = *(const f32x4*)(W + (size_t)kk * N + oc); v[i] = gk ? w * gk[kk] : w; } else v[i] = (f32x4){0.f, 0.f, 0.f, 0.f}; }
}
__device__ __forceinline__ void transpose_w(const float* __restrict__ W, const float* __restrict__ gk  , int K, int N, bf16* __restrict__ WT, int Nout, int mode, LAS float* scr, int gw, int ngw, int lane) {
    const int nblk = Nout / 32, nitems = (K / 64) * nblk;
    f32x4 cur[8], nxt[8];
    if (gw < nitems) tw_load(W, gk, N, nblk, mode, gw, lane, cur);
    for (int item = gw; item < nitems; item += ngw) {
        const bool more = item + ngw < nitems;
        if (more) tw_load(W, gk, N, nblk, mode, item + ngw, lane, nxt);
        const int kb = item / nblk, nb = item % nblk, k0 = 64 * kb, n0 = 32 * nb;
#pragma unroll
        for (int i = 0; i < 8; ++i) { LAS float* d = scr + (8 * i + (lane >> 3)) * 33 + (lane & 7) * 4; d[0] = cur[i].x; d[1] = cur[i].y; d[2] = cur[i].z; d[3] = cur[i].w; }
        __builtin_amdgcn_s_waitcnt(0xC07F); __builtin_amdgcn_wave_barrier();
        const int c = lane & 7;
#pragma unroll
        for (int j = 0; j < 4; ++j) { const int n = (lane >> 3) + 8 * j; const LAS float* s = scr + (8 * c) * 33 + n;
            u32x4 o; o.x = pk2(s[0 * 33], s[1 * 33]); o.y = pk2(s[2 * 33], s[3 * 33]); o.z = pk2(s[4 * 33], s[5 * 33]); o.w = pk2(s[6 * 33], s[7 * 33]);
            *(u32x4*)(WT + (size_t)(n0 + n) * K + k0 + 8 * c) = o; }
        __builtin_amdgcn_s_waitcnt(0xC07F); __builtin_amdgcn_wave_barrier();
        if (more) {
#pragma unroll
            for (int i = 0; i < 8; ++i) cur[i] = nxt[i]; }
    }
}
__device__ __forceinline__ void transpose_w4(const float* __restrict__ W, const float* __restrict__ gk, int K, int N, bf16* __restrict__ WT, int Nout, int mode, LAS float* scr, int gw, int ngw, int lane) {
    const int nblk = Nout / 32, nitems = (K / 64) * nblk;
    for (int base = gw; base < nitems; base += 4 * ngw) {
        f32x4 t[4][8]; float gv[4][8], msk[4];
#pragma unroll
        for (int q = 0; q < 4; ++q) { int item = base + q * ngw; if (item >= nitems) item = base;
            const int kb = item / nblk, nb = item % nblk, k0 = 64 * kb, n0 = 32 * nb + (lane & 7) * 4; const int oc = mode ? win_orig_col(n0) : n0; msk[q] = oc >= 0 ? 1.f : 0.f; const int ocs = oc >= 0 ? oc : 0;
#pragma unroll
            for (int i = 0; i < 8; ++i) { const int kk = k0 + 8 * i + (lane >> 3); t[q][i] = *(const f32x4*)(W + (size_t)kk * N + ocs); gv[q][i] = gk ? gk[kk] : 1.f; } }
#pragma unroll
        for (int q = 0; q < 4; ++q) { const int item = base + q * ngw; if (item >= nitems) break;
            const int kb = item / nblk, nb = item % nblk, k0 = 64 * kb, n0 = 32 * nb;
#pragma unroll
            for (int i = 0; i < 8; ++i) { LAS float* d = scr + (8 * i + (lane >> 3)) * 33 + (lane & 7) * 4; const float gg = gv[q][i] * msk[q]; d[0] = t[q][i].x * gg; d[1] = t[q][i].y * gg; d[2] = t[q][i].z * gg; d[3] = t[q][i].w * gg; }
            __builtin_amdgcn_s_waitcnt(0xC07F); __builtin_amdgcn_wave_barrier();
            const int c = lane & 7;
#pragma unroll
            for (int j = 0; j < 4; ++j) { const int n = (lane >> 3) + 8 * j; const LAS float* s = scr + (8 * c) * 33 + n;
                u32x4 o; o.x = pk2(s[0 * 33], s[1 * 33]); o.y = pk2(s[2 * 33], s[3 * 33]); o.z = pk2(s[4 * 33], s[5 * 33]); o.w = pk2(s[6 * 33], s[7 * 33]);
                *(u32x4*)(WT + (size_t)(n0 + n) * K + k0 + 8 * c) = o; }
            __builtin_amdgcn_s_waitcnt(0xC07F); __builtin_amdgcn_wave_barrier(); }
    }
}
__device__ __forceinline__ void scalars_body(const float* __restrict__ diff_lambda, float* ctlf, int l) {
    const float* p = diff_lambda + l * 256; float s1 = 0.f, s2 = 0.f;
    for (int i = 0; i < 64; ++i) { s1 += p[i] * p[64 + i]; s2 += p[128 + i] * p[192 + i]; }
    ctlf[l] = expf(s1) - expf(s2) + (0.8f - 0.6f * expf(-0.3f * (float)l));
}
__device__ __forceinline__ void xrow_to_bf16(const float* __restrict__ xa, const float* __restrict__ xb, bf16* __restrict__ XB, float* __restrict__ ssq, int row, int lane) {
    const float* x = row < SEQ ? xa + (size_t)row * DM : xb + (size_t)(row - SEQ) * DM;
    f32x4 v[8]; float s = 0.f;
#pragma unroll
    for (int j = 0; j < 8; ++j) { v[j] = ((const f32x4*)x)[lane + 64 * j]; s += (v[j].x * v[j].x + v[j].y * v[j].y) + (v[j].z * v[j].z + v[j].w * v[j].w); }
    s = wave_sum(s);
#pragma unroll
    for (int j = 0; j < 8; ++j) { u32x2 o; o.x = pk2(v[j].x, v[j].y); o.y = pk2(v[j].z, v[j].w); ((u32x2*)(XB + (size_t)row * DM))[lane + 64 * j] = o; }
    if (lane == 0) ssq[row] = s;
}
struct PrepArgs { const bf16* proj; const float* dtga; const float* conv_state; const float* conv_w; const float* conv_b; const float* dt_bias; const float* wa2; const float* ba;
                  const float* qn_g; const float* kn_g; float* xc; float* dt; float* loga; bf16* qn; bf16* kp; bf16* vp; bf16* kc; bf16* vc; float* out; int layer, pad; };
__device__ __forceinline__ float sum8(float v) { v += dpp_xor1(v); v += dpp_xor2(v); v += swz_xor4(v); return v; }
__device__ __forceinline__ void prep_row(const PrepArgs& a, int row, int lane, float& qmax2, float& kmax2) {
    typedef short bf16x8 __attribute__((ext_vector_type(8)));
    const int l = a.layer; const bool isS = row >= SEQ; const int b = isS ? (row - SEQ) >> 6 : 0, t = isS ? (row - SEQ) & 63 : row, L = isS ? DS : SEQ;
    const bf16* pr = a.proj + (size_t)row * NPJ; const int c0 = 8 * lane, d = c0 & 63;
    const bf16x8 qv = *(const bf16x8*)(pr + C_DQ + c0), kv = *(const bf16x8*)(pr + C_DK + c0); const u32x4 vv = *(const u32x4*)(pr + C_DV + c0);
    float q[8], k[8], sq = 0.f, sk = 0.f;
#pragma unroll
    for (int e = 0; e < 8; ++e) { q[e] = bf2f((bf16)qv[e]); k[e] = bf2f((bf16)kv[e]); sq += q[e] * q[e]; sk += k[e] * k[e]; }
    sq = sum8(sq); sk = sum8(sk);
    const float rq = __builtin_amdgcn_rsqf(sq * (1.f / 64.f) + EPS) * att::QSCALE, rk = __builtin_amdgcn_rsqf(sk * (1.f / 64.f) + EPS);
    const f32x4 gq0 = *(const f32x4*)(a.qn_g + l * 64 + d), gq1 = *(const f32x4*)(a.qn_g + l * 64 + d + 4), gk0 = *(const f32x4*)(a.kn_g + l * 64 + d), gk1 = *(const f32x4*)(a.kn_g + l * 64 + d + 4);
    const float gq[8] = {gq0.x, gq0.y, gq0.z, gq0.w, gq1.x, gq1.y, gq1.z, gq1.w}, gk[8] = {gk0.x, gk0.y, gk0.z, gk0.w, gk1.x, gk1.y, gk1.z, gk1.w};
    float nq = 0.f, nk = 0.f;
#pragma unroll
    for (int e = 0; e < 8; ++e) { q[e] *= rq * gq[e]; k[e] *= rk * gk[e]; const float qr = rbf(q[e]), kr = rbf(k[e]); nq += qr * qr; nk += kr * kr; }
    qmax2 = fmaxf(qmax2, sum8(nq)); kmax2 = fmaxf(kmax2, sum8(nk));
    u32x4 qo, ko; qo.x = pk2(q[0], q[1]); qo.y = pk2(q[2], q[3]); qo.z = pk2(q[4], q[5]); qo.w = pk2(q[6], q[7]); ko.x = pk2(k[0], k[1]); ko.y = pk2(k[2], k[3]); ko.z = pk2(k[4], k[5]); ko.w = pk2(k[6], k[7]);
    *(u32x4*)(a.qn + (size_t)row * 512 + c0) = qo;
    const size_t kvrow = isS ? (size_t)b * (PAST + DS) + PAST + t : (size_t)row; bf16* kd = isS ? a.kc : a.kp; bf16* vd = isS ? a.vc : a.vp;
    *(u32x4*)(kd + kvrow * 512 + c0) = ko; *(u32x4*)(vd + kvrow * 512 + c0) = vv;
    float* ko_f = a.out + (isS ? O_KS + ((size_t)(l * DB + b) * DS + t) * 512 : O_KP + ((size_t)l * SEQ + t) * 512) + c0;
    float* vo_f = a.out + (isS ? O_VS + ((size_t)(l * DB + b) * DS + t) * 512 : O_VP + ((size_t)l * SEQ + t) * 512) + c0;
    *(f32x4*)(ko_f) = (f32x4){k[0], k[1], k[2], k[3]}; *(f32x4*)(ko_f + 4) = (f32x4){k[4], k[5], k[6], k[7]};
    *(f32x4*)(vo_f) = (f32x4){bf2f((bf16)(vv.x & 0xffff)), bf2f((bf16)(vv.x >> 16)), bf2f((bf16)(vv.y & 0xffff)), bf2f((bf16)(vv.y >> 16))};
    *(f32x4*)(vo_f + 4) = (f32x4){bf2f((bf16)(vv.z & 0xffff)), bf2f((bf16)(vv.z >> 16)), bf2f((bf16)(vv.w & 0xffff)), bf2f((bf16)(vv.w >> 16))};
    if (t >= L - 3) { const int idx = t - (L - 3);
        float* dst = a.out + (isS ? O_CS + ((size_t)(l * DB + b) * 3 + idx) * CONV_DIM : O_CP + (size_t)(l * 3 + idx) * CONV_DIM);
        for (int c = lane; c < CONV_DIM; c += 64) dst[c] = bf2f(pr[C_XBC + c]); }
}
__device__ __forceinline__ void cache_convert(const float* __restrict__ ck, const float* __restrict__ cv, bf16* __restrict__ kc, bf16* __restrict__ vc, int layer, int gtid, int ngt, float& kmax2) {
    const size_t n8 = (size_t)DB * PAST * 512 / 8; const float* sk = ck + (size_t)layer * DB * PAST * 512; const float* sv = cv + (size_t)layer * DB * PAST * 512;
    for (size_t i = gtid; i < n8; i += ngt) { const size_t e = i * 8, row = e >> 9, col = e & 511, b = row / PAST, pos = row % PAST; const size_t d = (b * (PAST + DS) + pos) * 512 + col;
        const f32x4 a0 = *(const f32x4*)(sk + e), a1 = *(const f32x4*)(sk + e + 4), b0 = *(const f32x4*)(sv + e), b1 = *(const f32x4*)(sv + e + 4);
        u32x4 o; o.x = pk2(a0.x, a0.y); o.y = pk2(a0.z, a0.w); o.z = pk2(a1.x, a1.y); o.w = pk2(a1.z, a1.w); *(u32x4*)(kc + d) = o;
        { float ss = 0.f; const float v8[8] = {a0.x, a0.y, a0.z, a0.w, a1.x, a1.y, a1.z, a1.w};
#pragma unroll
          for (int j = 0; j < 8; ++j) { const float r = rbf(v8[j]); ss += r * r; }
          ss += dpp_xor1(ss); ss += dpp_xor2(ss); ss += swz_xor4(ss); kmax2 = fmaxf(kmax2, ss); }
        o.x = pk2(b0.x, b0.y); o.y = pk2(b0.z, b0.w); o.z = pk2(b1.x, b1.y); o.w = pk2(b1.z, b1.w); *(u32x4*)(vc + d) = o; }
}
__device__ __forceinline__ void cache_convert_queue(const float* __restrict__ ck, const float* __restrict__ cv, bf16* __restrict__ kc, bf16* __restrict__ vc, int layer, unsigned* qword, unsigned* kmax_word,
                                                    volatile LAS unsigned* qw, int tid, int lane, unsigned ch0 = 0u, unsigned nch = 512u) {
    const float* sk = ck + (size_t)layer * DB * PAST * 512; const float* sv = cv + (size_t)layer * DB * PAST * 512; float kmax2 = 0.f;
    for (;;) {
        if (tid == 0) qw[0] = atomicAdd(qword, 1u);
        __syncthreads(); const unsigned cq = qw[0]; __syncthreads();
        if (cq >= nch) break;
        const unsigned ch = ch0 + cq;
#pragma unroll 1
        for (int it0 = 0; it0 < 16; it0 += 4) { f32x4 A0[4], A1[4], B0[4], B1[4];
#pragma unroll
            for (int j = 0; j < 4; ++j) { const size_t e = ((size_t)ch * 8192 + (it0 + j) * 512 + tid) * 8; A0[j] = *(const f32x4*)(sk + e); A1[j] = *(const f32x4*)(sk + e + 4); B0[j] = *(const f32x4*)(sv + e); B1[j] = *(const f32x4*)(sv + e + 4); }
#pragma unroll
            for (int j = 0; j < 4; ++j) { const size_t e = ((size_t)ch * 8192 + (it0 + j) * 512 + tid) * 8, row = e >> 9, col = e & 511, b = row / PAST, pos = row % PAST; const size_t d = (b * (PAST + DS) + pos) * 512 + col;
                const f32x4 a0 = A0[j], a1 = A1[j], b0 = B0[j], b1 = B1[j];
                u32x4 o; o.x = pk2(a0.x, a0.y); o.y = pk2(a0.z, a0.w); o.z = pk2(a1.x, a1.y); o.w = pk2(a1.z, a1.w); *(u32x4*)(kc + d) = o;
                { float ss = 0.f; const float v8[8] = {a0.x, a0.y, a0.z, a0.w, a1.x, a1.y, a1.z, a1.w};
#pragma unroll
                  for (int q = 0; q < 8; ++q) { const float r = rbf(v8[q]); ss += r * r; }
                  ss += dpp_xor1(ss); ss += dpp_xor2(ss); ss += swz_xor4(ss); kmax2 = fmaxf(kmax2, ss); }
                o.x = pk2(b0.x, b0.y); o.y = pk2(b0.z, b0.w); o.z = pk2(b1.x, b1.y); o.w = pk2(b1.z, b1.w); *(u32x4*)(vc + d) = o; } }
    }
    kmax2 = wave_max(kmax2); if (lane == 0 && kmax2 > 0.f) atomicMax(kmax_word, __float_as_uint(kmax2));
}
constexpr int NCONV = 160;
#ifndef WGM_IN
#define WGM_IN 4
#endif
#ifndef WGM_M1
#define WGM_M1 4
#endif
constexpr int RING_OFF = 0, RING_BYTES = 131072, LDSCTL_OFF = RING_BYTES, MISC_OFF = LDSCTL_OFF + 320, LDS_BYTES = 147456;
constexpr int CW_GSL = 65536;
constexpr int CW_TMO = 0, CW_CODE = 1, CW_BAR = 4096, CW_LAM = 8192, CW_QMAX = 8320, CW_KMAX = 8448, CW_QSCAN = 8576, CW_QATT = 8704, CW_QCONV = 12288  , CW_QPRE = 8832  , CW_SEG = 16384;
constexpr int NWAVES = 8;
__device__ int probe_reps[12] = {1, 1, 1, 1, 1, 1, 1, 1, 1, 1, 1, 1};
#define REPS(k) __builtin_amdgcn_readfirstlane(probe_reps[k])
__device__ int probe_scan = 1;
struct Params { const float* in[26]; float* out; unsigned char* ws; };
enum { I_XP = 0, I_XS, I_CK, I_CV, I_STCONV, I_STSSD, I_STGLA, I_N1G, I_WIN, I_CONVW, I_CONVB, I_DTB, I_ALOG, I_SSDD, I_SSDNG, I_QNG, I_KNG, I_DLAM, I_DOUTG, I_WA2, I_GBA, I_GLANG, I_WOUT, I_N2G, I_W1, I_W2, I_OUT, I_WS };
typedef const float* cfp;
typedef const __attribute__((address_space(4))) cfp* kargp;
__device__ __forceinline__ kargp kargs_opaque() { kargp p = (kargp)__builtin_amdgcn_kernarg_segment_ptr(); asm volatile("" : "+s"(p)); return p; }
#define PHASE_ENTER() \
    const kargp ka = kargs_opaque(); const int wave = opaque_s(wave_s), lane = opaque_v(lane_id()), tid = wave * 64 + lane; \
    const int bx = opaque_s((int)blockIdx.x), G = (int)gridDim.x; const int gw = bx * NWAVES + wave, ngw = G * NWAVES, vb = tid >> 8, vt = tid & 255, nvb = 2 * G; \
    unsigned char* const ws = (unsigned char*)ka[I_WS]; float* const out = (float*)ka[I_OUT]; \
    (void)lane; (void)gw; (void)ngw; (void)vb; (void)vt; (void)nvb; (void)ws; (void)out
#define WSP(T, off) ((T*)(ws + (off)))

__global__ void __launch_bounds__(NWAVES * 64, 2) fwd_kernel(Params P) {
    extern __shared__ __attribute__((aligned(16))) unsigned char lds[];
    LAS unsigned char* const ldsp = (LAS unsigned char*)lds;
    XcdBarrier bar;
    const int wave_s = __builtin_amdgcn_readfirstlane((int)threadIdx.x >> 6);
    {
        PHASE_ENTER();
        volatile LAS unsigned* const MISC = (volatile LAS unsigned*)(ldsp + MISC_OFF);
        for (int u = tid; u < (LDS_BYTES - LDSCTL_OFF) / 4; u += NWAVES * 64) ((LAS unsigned*)(ldsp + LDSCTL_OFF))[u] = 0u;
        __syncthreads();
        bar = xcd_barrier_post((unsigned*)(WSP(unsigned, WS_CTL) + CW_BAR), MISC + 8);
        LAS float* scr = (LAS float*)(ldsp + RING_OFF + wave * 16384);
        for (int rep = REPS(0) - 1; rep >= 0; --rep) {
        transpose_w(ka[I_WIN], ka[I_N1G], DM, IN_COLS, WSP(bf16, WS_WIN), NPAD, 1, scr, gw, ngw, lane);
        if (gw == 0 && lane < DEPTH) scalars_body(ka[I_DLAM], WSP(float, WS_CTL) + CW_LAM, lane);
        for (int row = gw; row < NROW; row += ngw) xrow_to_bf16(ka[I_XP], ka[I_XS], WSP(bf16, WS_H), WSP(float, WS_SUMSQ), row, lane);
        }
        for (int i = bx * (NWAVES * 64) + tid; i < 3 * NROW; i += G * NWAVES * 64) (WSP(float, WS_SUMSQ) + NROW)[i] = 0.f;
    }
#define GRID_BAR() do { XcdBarrier b_ = bar; asm volatile("" : "+s"(b_.bar), "+s"(b_.x)); xcd_barrier(b_); } while (0)
    GRID_BAR();
    for (int rep = REPS(3) - 1; rep > 0; --rep) GRID_BAR();
    for (int l = 0; l < DEPTH; ++l) {
        for (int rep = REPS(1) - 1; rep >= 0; --rep) {
        { PHASE_ENTER();
          pg8::Gemm g{WSP(bf16, WS_H), WSP(bf16, WS_WIN) + (size_t)l * NPAD * DM, NROW, NPAD, DM}; pg8::StaticOrder S; S.init(NROW, NPAD, G, bx, DM); S.wgm = WGM_IN;
          pg8::EpiInProj E{WSP(bf16, WS_PROJ), WSP(float, WS_DTGA), WSP(float, WS_SUMSQ) + (size_t)(2 * l) * NROW};
          pg8::gemm_phase<pg8::EpiInProj, pg8::StaticOrder, true, true>(ldsp + RING_OFF, g, S, E, tid);
          if (rep == 0) { if (l == 0) cache_convert_queue(ka[I_CK], ka[I_CV], WSP(bf16, WS_KC), WSP(bf16, WS_VC), 0, WSP(unsigned, WS_CTL) + CW_QCONV, WSP(unsigned, WS_CTL) + CW_KMAX,
                                                      (volatile LAS unsigned*)(ldsp + MISC_OFF) + 12, tid, lane);
                          else cache_convert_queue(ka[I_CK], ka[I_CV], WSP(bf16, WS_KC), WSP(bf16, WS_VC), l, WSP(unsigned, WS_CTL) + CW_QCONV + 16 * l + 8, WSP(unsigned, WS_CTL) + CW_KMAX + 64 * l,
                                                      (volatile LAS unsigned*)(ldsp + MISC_OFF) + 12, tid, lane, 256u, 256u); } }
                if (rep > 0) GRID_BAR(); }
        GRID_BAR();
        { PHASE_ENTER();
          PrepArgs pa; pa.proj = WSP(bf16, WS_PROJ); pa.dtga = WSP(float, WS_DTGA); pa.conv_state = ka[I_STCONV]; pa.conv_w = ka[I_CONVW]; pa.conv_b = ka[I_CONVB]; pa.dt_bias = ka[I_DTB]; pa.wa2 = ka[I_WA2]; pa.ba = ka[I_GBA];
          pa.qn_g = ka[I_QNG]; pa.kn_g = ka[I_KNG]; pa.xc = nullptr; pa.dt = nullptr; pa.loga = nullptr; pa.qn = WSP(bf16, WS_QN); pa.kp = WSP(bf16, WS_KP); pa.vp = WSP(bf16, WS_VP); pa.kc = WSP(bf16, WS_KC); pa.vc = WSP(bf16, WS_VC); pa.out = out; pa.layer = l; pa.pad = 0;
          float qmax2 = 0.f, kmax2 = 0.f;
          for (int rep = REPS(6) - 1; rep >= 0; --rep)
#pragma unroll 3
          for (int row = gw; row < NROW; row += ngw) prep_row(pa, row, lane, qmax2, kmax2);
          qmax2 = wave_max(qmax2); kmax2 = wave_max(kmax2);
          if (lane == 0) { atomicMax(WSP(unsigned, WS_CTL) + CW_QMAX + 64 * l, __float_as_uint(qmax2)); atomicMax(WSP(unsigned, WS_CTL) + CW_KMAX + 64 * l, __float_as_uint(kmax2)); } }
        { PHASE_ENTER();
          ssdc::Args sa; sa.proj = WSP(bf16, WS_PROJ); sa.dtga = WSP(float, WS_DTGA); sa.dt_bias = ka[I_DTB]; sa.conv_state = ka[I_STCONV]; sa.conv_w = ka[I_CONVW]; sa.conv_b = ka[I_CONVB]; sa.a_log = ka[I_ALOG]; sa.dpar = ka[I_SSDD];
          sa.norm_g = ka[I_SSDNG]; sa.states = WSP(bf16, WS_SSTATE); sa.decay = WSP(float, WS_SDECAY); sa.hin = WSP(bf16, WS_HIN); sa.mix = WSP(bf16, WS_MIX); sa.layer = l; sa.pad = 0;
          for (int rep = REPS(8) - 1; rep >= 0; --rep)
          { volatile LAS unsigned* qw = (volatile LAS unsigned*)(ldsp + MISC_OFF) + 12;
            for (;;) { if (tid == 0) qw[0] = atomicAdd(WSP(unsigned, WS_CTL) + CW_QPRE + 0 + 64 * l + 1024 * rep, 1u);
                lds_barrier(); const int u = (int)qw[0]; lds_barrier(); if (u >= 576) break; ssdc::pre_unit(sa, u >> 1, u & 1, ldsp + RING_OFF, tid); } } }
        { PHASE_ENTER();
          glac::Args ga; ga.proj = WSP(bf16, WS_PROJ); ga.dtga = WSP(float, WS_DTGA); ga.wa2 = ka[I_WA2]; ga.ba = ka[I_GBA]; ga.norm_g = ka[I_GLANG]; ga.btab = out  ; ga.states = WSP(bf16, WS_GSTATE); ga.decay = WSP(float, WS_GDECAY); ga.hin = WSP(bf16, WS_GHIN); ga.mix = WSP(bf16, WS_MIX); ga.layer = l; ga.pad = 0;
          for (int rep = REPS(9) - 1; rep >= 0; --rep)
          { volatile LAS unsigned* qw = (volatile LAS unsigned*)(ldsp + MISC_OFF) + 12;
            for (;;) { if (tid == 0) qw[0] = atomicAdd(WSP(unsigned, WS_CTL) + CW_QPRE + 16 + 64 * l + 1024 * rep, 1u);
                lds_barrier(); const int u = (int)qw[0]; lds_barrier(); if (u >= 1152) break; glac::pre_unit(ga, u >> 2, u & 3, ldsp + RING_OFF, tid); } } }
        GRID_BAR();
        for (int rep = (int)__builtin_amdgcn_readfirstlane(probe_scan) - 1; rep >= 0; --rep) {
        { PHASE_ENTER();
          ssdc::ScanArgs sc; sc.states = WSP(bf16, WS_SSTATE); sc.decay = WSP(float, WS_SDECAY); sc.state_in = ka[I_STSSD]; sc.hin = WSP(bf16, WS_HIN); sc.out = out; sc.layer = l; sc.pad = 0;
          glac::ScanArgs gc; gc.states = WSP(bf16, WS_GSTATE); gc.decay = WSP(float, WS_GDECAY); gc.state_in = ka[I_STGLA]; gc.hin = WSP(bf16, WS_GHIN); gc.out = out; gc.layer = l; gc.pad = 0;
          volatile LAS unsigned* qw = (volatile LAS unsigned*)(ldsp + MISC_OFF) + 12;
          for (;;) {
              if (tid == 0) qw[0] = atomicAdd(WSP(unsigned, WS_CTL) + CW_QSCAN + 64 * l + 32 * rep, 1u);
              lds_barrier(); const int it = (int)qw[0]; lds_barrier();
              if (it >= 160) break;
              if (it < 64) ssdc::scan_prompt(sc, it * 512 + tid);
              else if (it < 80) glac::scan_prompt(gc, (it - 64) * 512 + tid);
              else if (it < 144) { for (int b = 0; b < DB; b += 8) ssdc::scan_sample8(sc, b, (it - 80) * 512 + tid); }
              else { for (int b = 0; b < DB; b += 8) glac::scan_sample8(gc, b, (it - 144) * 512 + tid); } } }
        if (rep > 0) GRID_BAR(); }
        for (;;) { int conv_item = -1;
        { PHASE_ENTER();
          att::Tensors T; T.QN = WSP(bf16, WS_QN); T.MIX = WSP(bf16, WS_MIX); T.out_g = ka[I_DOUTG] + l * 128; T.lam = (WSP(float, WS_CTL) + CW_LAM)[l]; T.lam_init_c = 1.f - (0.8f - 0.6f * expf(-0.3f * (float)l));
          T.part = WSP(float, WS_APART); T.segcnt = WSP(unsigned, WS_CTL) + CW_SEG + 16384 * l; T.bound = sqrtf((WSP(float, WS_CTL) + CW_QMAX)[64 * l] * (WSP(float, WS_CTL) + CW_KMAX)[64 * l]) * 1.01f + 0.01f; T.kmax = sqrtf((WSP(float, WS_CTL) + CW_KMAX)[64 * l]);
          volatile LAS unsigned* qw = (volatile LAS unsigned*)(ldsp + MISC_OFF) + 12;
          for (;;) {
              if (tid == 0) qw[0] = atomicAdd(WSP(unsigned, WS_CTL) + CW_QATT + 64 * l, 1u);
              lds_barrier(); int it = (int)qw[0]; lds_barrier();
              if (it >= ATT_NITEMS + (l == 0 ? NCONV : 0)) break;
              if (l == 0) { if (it < 5 * NCONV) { if (it % 5 == 4) { conv_item = it / 5; break; } it -= it / 5; } else it -= NCONV; }
              const unsigned w = att_items[it]; const int jb = (w >> 3) & 255;
              att::Unit u; u.h = (w >> 1) & 3; u.nseg = 1 + ((w >> 11) & 1); u.seg = (w >> 12) & 1; u.pidx = (w >> 13) & 255; u.pad = 0;
              if (w & 1) { u.K = WSP(bf16, WS_KC) + (size_t)jb * (PAST + DS) * 512; u.V = WSP(bf16, WS_VC) + (size_t)jb * (PAST + DS) * 512; u.qrow0 = SEQ + DS * jb; u.chunkA = PAST / 64; u.chunkB = -1; }
              else { u.K = WSP(bf16, WS_KP); u.V = WSP(bf16, WS_VP); u.qrow0 = 128 * jb; u.chunkA = 2 * jb; u.chunkB = 2 * jb + 1; }
              att::attn_unit(u, T, ldsp + RING_OFF, tid); } }
        if (conv_item < 0) break;
        { PHASE_ENTER();
          const int cg = conv_item * NWAVES + wave, cn = NCONV * NWAVES; LAS float* scr = (LAS float*)(ldsp + RING_OFF + wave * 16384);
          transpose_w4(ka[I_WOUT], nullptr, DM, DM, WSP(bf16, WS_WOUT), DM, 0, scr, cg, cn, lane);
          transpose_w4(ka[I_W1], ka[I_N2G], DM, DFF, WSP(bf16, WS_W1), DFF, 0, scr, cg, cn, lane);
          transpose_w4(ka[I_W2], nullptr, DFF, DM, WSP(bf16, WS_W2), DM, 0, scr, cg, cn, lane);
          transpose_w4(ka[I_WIN] + (size_t)DM * IN_COLS, ka[I_N1G] + DM, DM, IN_COLS, WSP(bf16, WS_WIN) + (size_t)NPAD * DM, NPAD, 1, scr, cg, cn, lane);
          transpose_w4(ka[I_WOUT] + (size_t)DM * DM, nullptr, DM, DM, WSP(bf16, WS_WOUT) + (size_t)DM * DM, DM, 0, scr, cg, cn, lane);
          transpose_w4(ka[I_W1] + (size_t)DM * DFF, ka[I_N2G] + DM, DM, DFF, WSP(bf16, WS_W1) + (size_t)DFF * DM, DFF, 0, scr, cg, cn, lane);
          transpose_w4(ka[I_W2] + (size_t)DFF * DM, nullptr, DFF, DM, WSP(bf16, WS_W2) + (size_t)DM * DFF, DM, 0, scr, cg, cn, lane);
          __syncthreads(); } }
        GRID_BAR();
        { PHASE_ENTER();
          ssdc::Args sa; sa.proj = WSP(bf16, WS_PROJ); sa.dtga = WSP(float, WS_DTGA); sa.dt_bias = ka[I_DTB]; sa.conv_state = ka[I_STCONV]; sa.conv_w = ka[I_CONVW]; sa.conv_b = ka[I_CONVB]; sa.a_log = ka[I_ALOG]; sa.dpar = ka[I_SSDD];
          sa.norm_g = ka[I_SSDNG]; sa.states = WSP(bf16, WS_SSTATE); sa.decay = WSP(float, WS_SDECAY); sa.hin = WSP(bf16, WS_HIN); sa.mix = WSP(bf16, WS_MIX); sa.layer = l; sa.pad = 0;
          for (int rep = REPS(10) - 1; rep >= 0; --rep)
          { volatile LAS unsigned* qw = (volatile LAS unsigned*)(ldsp + MISC_OFF) + 12;
            for (;;) { if (tid == 0) qw[0] = atomicAdd(WSP(unsigned, WS_CTL) + CW_QPRE + 32 + 64 * l + 1024 * rep, 1u);
                lds_barrier(); const int u = (int)qw[0]; lds_barrier(); if (u >= 576) break; ssdc::post_unit(sa, u >> 1, u & 1, ldsp + RING_OFF, tid); } } }
        { PHASE_ENTER();
          glac::Args ga; ga.proj = WSP(bf16, WS_PROJ); ga.dtga = WSP(float, WS_DTGA); ga.wa2 = ka[I_WA2]; ga.ba = ka[I_GBA]; ga.norm_g = ka[I_GLANG]; ga.btab = out  ; ga.states = WSP(bf16, WS_GSTATE); ga.decay = WSP(float, WS_GDECAY); ga.hin = WSP(bf16, WS_GHIN); ga.mix = WSP(bf16, WS_MIX); ga.layer = l; ga.pad = 0;
          for (int rep = REPS(11) - 1; rep >= 0; --rep)
          { volatile LAS unsigned* qw = (volatile LAS unsigned*)(ldsp + MISC_OFF) + 12;
            for (;;) { if (tid == 0) qw[0] = atomicAdd(WSP(unsigned, WS_CTL) + CW_QPRE + 48 + 64 * l + 1024 * rep, 1u);
                lds_barrier(); const int u = (int)qw[0]; lds_barrier(); if (u >= 1152) break; glac::post_unit(ga, u >> 2, u & 3, ldsp + RING_OFF, tid); } } }
        GRID_BAR();
        for (int rep = REPS(2) - 1; rep >= 0; --rep) {
        { PHASE_ENTER();
          pg8::Gemm g{WSP(bf16, WS_MIX), WSP(bf16, WS_WOUT) + (size_t)l * DM * DM, NROW, DM, DM}; pg8::StaticOrder S; S.init(NROW, DM, G, bx, DM, (float*)(ws + 623 * MiB)  , WSP(unsigned, WS_CTL) + CW_GSL + (4 * l + 1) * 8192 + (rep > 0 ? 65536 : 0));
          pg8::EpiResid E{ka[I_XP], ka[I_XS], l == 0 ? nullptr : WSP(bf16, WS_H), nullptr, rep > 0 ? (bf16*)(ws + 623 * MiB) : WSP(bf16, WS_H), WSP(float, WS_SUMSQ) + (size_t)(2 * l + 1) * NROW, nullptr};
          pg8::gemm_phase<pg8::EpiResid, pg8::StaticOrder, true, true>(ldsp + RING_OFF, g, S, E, tid);
          if (l + 1 < DEPTH && rep == 0) cache_convert_queue(ka[I_CK], ka[I_CV], WSP(bf16, WS_KC), WSP(bf16, WS_VC), l + 1, WSP(unsigned, WS_CTL) + CW_QCONV + 16 * (l + 1), WSP(unsigned, WS_CTL) + CW_KMAX + 64 * (l + 1),
                                                              (volatile LAS unsigned*)(ldsp + MISC_OFF) + 12, tid, lane, 0u, 256u); }
                if (rep > 0) GRID_BAR(); }
        GRID_BAR();
        for (int rep = REPS(4) - 1; rep >= 0; --rep) {
        { PHASE_ENTER();
          pg8::Gemm g{WSP(bf16, WS_H), WSP(bf16, WS_W1) + (size_t)l * DFF * DM, NROW, DFF, DM}; pg8::StaticOrder S; S.init(NROW, DFF, G, bx, DM); S.wgm = WGM_M1;
          pg8::EpiRelu2 E{WSP(bf16, WS_HID), (long)DFF};
          pg8::gemm_phase<pg8::EpiRelu2, pg8::StaticOrder, true, true>(ldsp + RING_OFF, g, S, E, tid); }
                if (rep > 0) GRID_BAR(); }
        GRID_BAR();
        for (int rep = REPS(5) - 1; rep >= 0; --rep) {
        { PHASE_ENTER();
          pg8::Gemm g{WSP(bf16, WS_HID), WSP(bf16, WS_W2) + (size_t)l * DM * DFF, NROW, DM, DFF}; pg8::StaticOrder S; S.init(NROW, DM, G, bx, DFF, (float*)(ws + 623 * MiB)  , WSP(unsigned, WS_CTL) + CW_GSL + (4 * l + 3) * 8192 + (rep > 0 ? 65536 : 0));
          pg8::EpiResid E{nullptr, nullptr, WSP(bf16, WS_H), l + 1 == DEPTH ? out : nullptr, l + 1 == DEPTH ? nullptr : (rep > 0 ? WSP(bf16, WS_MIX) : WSP(bf16, WS_H)), WSP(float, WS_SUMSQ) + (size_t)(2 * l + 2) * NROW, WSP(float, WS_SUMSQ) + (size_t)(2 * l + 1) * NROW};
          pg8::gemm_phase<pg8::EpiResid, pg8::StaticOrder, true, true>(ldsp + RING_OFF, g, S, E, tid); }
        if (rep > 0) GRID_BAR(); }
        if (l + 1 < DEPTH) GRID_BAR();
    }
}

extern "C" void kernel_launch(void* const* d_in, const int* in_sizes, int n_in, void* d_out, int out_size, void* d_ws, size_t ws_size, hipStream_t stream) {
    static int grid = 0;
    if (grid == 0) {
        if (n_in != 26 || out_size != (int)O_END || ws_size < WS_END) { fprintf(stderr, "kernel_launch: unexpected shapes (n_in %d out %d ws %zu)\n", n_in, out_size, ws_size); grid = -1; return; }
        int dev = 0, cus = 0, per_cu = 0;
        if (hipGetDevice(&dev) != hipSuccess || hipDeviceGetAttribute(&cus, hipDeviceAttributeMultiprocessorCount, dev) != hipSuccess) { grid = -1; return; }
        if (hipFuncSetAttribute((const void*)fwd_kernel, hipFuncAttributeMaxDynamicSharedMemorySize, LDS_BYTES) != hipSuccess) { fprintf(stderr, "kernel_launch: hipFuncSetAttribute failed\n"); grid = -1; return; }
        if (hipOccupancyMaxActiveBlocksPerMultiprocessor(&per_cu, (const void*)fwd_kernel, NWAVES * 64, LDS_BYTES) != hipSuccess || per_cu < 1) fprintf(stderr, "kernel_launch: occupancy query says %d\n", per_cu);
        (void)hipGetLastError();
        grid = cus;
    }
    if (grid < 0) return;
    (void)hipMemsetAsync((char*)d_ws + WS_CTL, 0, 1 * MiB, stream);
    Params p{};
    for (int i = 0; i < 26; ++i) p.in[i] = (const float*)d_in[i];
    p.out = (float*)d_out; p.ws = (unsigned char*)d_ws;
    hipLaunchKernelGGL(fwd_kernel, dim3(grid), dim3(NWAVES * 64), LDS_BYTES, stream, p);
}
```
